# Optimizing an MI355X kernel written in HIP

```python
import jax, jax.numpy as jnp
from jax import lax
import numpy as np

D_MODEL = 2048
BATCH = 2
SEQ = 4096
DEPTH = 1

GRID_W = 64
CTX_LEN = 256
HEAD_DIM = 128
NA_HEADS = 8
RET_HEADS = 8
NA_WIDTH = NA_HEADS * HEAD_DIM
RET_WIDTH = RET_HEADS * HEAD_DIM
MIX_WIDTH = NA_WIDTH + RET_WIDTH
WIN_ROWS = 8
WIN_COLS = 16
RET_CHUNK = 128
ROPE_BASE = 10000.0
N_EXPERTS = 16
EXPERT_FF = 1024
CAPACITY_FACTOR = 2
N_MOD = 6
EPS = 1e-6
NEG_INF = -1e30
KV_COLS = 2 * NA_WIDTH + 2 * RET_WIDTH
IN_COLS = KV_COLS + NA_WIDTH + 2 * RET_WIDTH
LAT_SPLITS = (NA_WIDTH, 2 * NA_WIDTH, 2 * NA_WIDTH + RET_WIDTH, KV_COLS, KV_COLS + NA_WIDTH, KV_COLS + NA_WIDTH + RET_WIDTH)
CTX_KV_SPLITS = (NA_WIDTH, 2 * NA_WIDTH, 2 * NA_WIDTH + RET_WIDTH)
CTX_Q_SPLITS = (NA_WIDTH, NA_WIDTH + RET_WIDTH)

kernel_name = 'hybrid_natten_retention_ecmoe_dit_block'


def rms_norm(x, w):
    xf = x.astype(jnp.float32)
    y = xf * lax.rsqrt(jnp.mean(xf * xf, axis=-1, keepdims=True) + EPS)
    return (y * w.astype(jnp.float32)).astype(x.dtype)


def modulate(h, shift, scale):
    return h * (1.0 + scale) + shift


def to_heads(x):
    b, l, w = x.shape
    return x.reshape(b, l, w // HEAD_DIM, HEAD_DIM).transpose(0, 2, 1, 3)


def from_heads(x):
    b, h, l, d = x.shape
    return x.transpose(0, 2, 1, 3).reshape(b, l, h * d)


def _rotate_pairs(x, ang):
    cos, sin = jnp.cos(ang), jnp.sin(ang)
    x1, x2 = jnp.split(x, 2, axis=-1)
    return jnp.concatenate([x1 * cos - x2 * sin, x2 * cos + x1 * sin], axis=-1)


def axial_rope(x, row_pos, col_pos):
    axis_dim = HEAD_DIM // 2
    inv_freq = ROPE_BASE ** (-jnp.arange(0, axis_dim, 2, dtype=jnp.float32) / axis_dim)
    ang_r = row_pos.astype(jnp.float32)[:, None] * inv_freq
    ang_c = col_pos.astype(jnp.float32)[:, None] * inv_freq
    xf = x.astype(jnp.float32)
    out = jnp.concatenate([_rotate_pairs(xf[..., :axis_dim], ang_r), _rotate_pairs(xf[..., axis_dim:], ang_c)], axis=-1)
    return out.astype(x.dtype)


def neighbourhood_attention(q, k, v, k_ctx, v_ctx, rpb, rows):
    b, h, l, dh = q.shape
    kh = min(WIN_ROWS, rows)
    kw = WIN_COLS
    scale = dh ** -0.5
    qg = q.reshape(b, h, rows, GRID_W, dh)
    kg = k.reshape(b, h, rows, GRID_W, dh)
    vg = v.reshape(b, h, rows, GRID_W, dh)
    r = jnp.arange(rows)
    row_start = jnp.clip(r - kh // 2, 0, rows - kh)
    key_rows = row_start[:, None] + jnp.arange(kh)[None, :]
    k_blk = kg[:, :, key_rows]
    v_blk = vg[:, :, key_rows]
    cq = jnp.arange(GRID_W)
    col_start = jnp.clip(cq - kw // 2, 0, GRID_W - kw)
    col_ok = (cq[None, :] >= col_start[:, None]) & (cq[None, :] < col_start[:, None] + kw)
    row_off = key_rows - r[:, None] + (WIN_ROWS - 1)
    col_off = jnp.clip(cq[None, :] - cq[:, None], -(kw - 1), kw - 1) + (WIN_COLS - 1)
    bias = rpb[:, row_off[:, None, :, None], col_off[None, :, None, :]]
    s_win = jnp.einsum('bhrcd,bhrikd->bhrcik', qg, k_blk).astype(jnp.float32) * scale + bias[None].astype(jnp.float32)
    s_win = jnp.where(col_ok[:, None, :], s_win, NEG_INF).reshape(b, h, rows, GRID_W, kh * GRID_W)
    s_ctx = jnp.einsum('bhrcd,bhnd->bhrcn', qg, k_ctx).astype(jnp.float32) * scale
    p = jax.nn.softmax(jnp.concatenate([s_win, s_ctx], axis=-1), axis=-1)
    p_win = p[..., :kh * GRID_W].reshape(b, h, rows, GRID_W, kh, GRID_W).astype(v.dtype)
    p_ctx = p[..., kh * GRID_W:].astype(v.dtype)
    out = jnp.einsum('bhrcik,bhrikd->bhrcd', p_win, v_blk) + jnp.einsum('bhrcn,bhnd->bhrcd', p_ctx, v_ctx)
    return out.reshape(b, h, l, dh)


def context_self_attention(q, k, v):
    s = jnp.einsum('bhnd,bhmd->bhnm', q, k).astype(jnp.float32) * HEAD_DIM ** -0.5
    p = jax.nn.softmax(s, axis=-1).astype(v.dtype)
    return jnp.einsum('bhnm,bhmd->bhnd', p, v)


def retention_chunkwise(q, k, v, log_gamma, state0):
    b, h, l, d = q.shape
    n = l // RET_CHUNK
    pos = jnp.arange(RET_CHUNK, dtype=jnp.float32)
    diff = pos[:, None] - pos[None, :]
    intra = jnp.where(diff >= 0, jnp.exp(log_gamma[:, None, None] * jnp.maximum(diff, 0.0)), 0.0)
    q_decay = jnp.exp(log_gamma[:, None] * (pos + 1.0))
    k_decay = jnp.exp(log_gamma[:, None] * (RET_CHUNK - 1.0 - pos))
    chunk_decay = jnp.exp(log_gamma * RET_CHUNK)[None, :, None, None]
    qc = q.astype(jnp.float32).reshape(b, h, n, RET_CHUNK, d)
    kc = k.astype(jnp.float32).reshape(b, h, n, RET_CHUNK, d)
    vc = v.astype(jnp.float32).reshape(b, h, n, RET_CHUNK, d)
    scores = jnp.einsum('bhnid,bhnjd->bhnij', qc, kc) * intra[None, :, None]
    inner = jnp.einsum('bhnij,bhnje->bhnie', scores, vc)
    chunk_kv = jnp.einsum('bhnjd,bhnje->nbhde', kc * k_decay[None, :, None, :, None], vc)

    def step(state, kv_n):
        return state * chunk_decay + kv_n, state

    _, prev_states = lax.scan(step, state0.astype(jnp.float32), chunk_kv)
    cross = jnp.einsum('bhnid,nbhde->bhnie', qc * q_decay[None, :, None, :, None], prev_states)
    return (inner + cross).reshape(b, h, l, d)


def context_state(k, v, log_gamma, reverse):
    l = k.shape[2]
    m = jnp.arange(l, dtype=jnp.float32)
    dist = m if reverse else (l - 1.0 - m)
    w = jnp.exp(log_gamma[:, None] * dist)
    return jnp.einsum('bhmd,bhme->bhde', k.astype(jnp.float32) * w[None, :, :, None], v.astype(jnp.float32))


def bidirectional_retention(q, k, v, lg_f, lg_b, s_f, s_b):
    fwd = retention_chunkwise(q, k, v, lg_f, s_f)
    bwd = jnp.flip(retention_chunkwise(jnp.flip(q, 2), jnp.flip(k, 2), jnp.flip(v, 2), lg_b, s_b), 2)
    return fwd + bwd


def retention_output(o, g, gn_w):
    mu = jnp.mean(o, axis=-1, keepdims=True)
    var = jnp.mean(jnp.square(o - mu), axis=-1, keepdims=True)
    o = from_heads((o - mu) * lax.rsqrt(var + EPS)) * gn_w.astype(jnp.float32)
    return o.astype(g.dtype) * jax.nn.silu(g)


def expert_choice_ffn(h, w_router, w_gate, w_up, w_down):
    b, n, d = h.shape
    cap = CAPACITY_FACTOR * n // N_EXPERTS
    logits = jnp.einsum('bnd,de->ben', h, w_router).astype(jnp.float32)
    affinity = jax.nn.softmax(logits, axis=1)
    gates, idx = lax.top_k(affinity, cap)
    xe = jax.vmap(lambda hb, ib: hb[ib])(h, idx)
    hid = jax.nn.silu(jnp.einsum('becd,edf->becf', xe, w_gate)) * jnp.einsum('becd,edf->becf', xe, w_up)
    ye = jnp.einsum('becf,efd->becd', hid, w_down) * gates[..., None].astype(h.dtype)

    def combine(idx_b, y_b):
        return jnp.zeros((n, d), y_b.dtype).at[idx_b.reshape(-1)].add(y_b.reshape(-1, d))

    return jax.vmap(combine)(idx, ye)


def setup_inputs(seed: int = 0) -> dict:
    key = jax.random.key(seed)
    ks = jax.random.split(key, 24)
    f32 = jnp.float32

    def nrm(k, shape, scale):
        return jax.random.normal(k, shape, f32) * scale

    gamma0 = 1.0 - 2.0 ** (-5.0 - jnp.arange(RET_HEADS, dtype=f32))
    decay_logit = jnp.log(gamma0) - jnp.log1p(-gamma0)
    return {
        'x': nrm(ks[0], (BATCH, SEQ, D_MODEL), 1.0),
        'c': nrm(ks[1], (BATCH, D_MODEL), 1.0),
        'ctx': nrm(ks[2], (BATCH, CTX_LEN, D_MODEL), 1.0),
        'c_ctx': nrm(ks[3], (D_MODEL,), 1.0),
        'w_mod': nrm(ks[4], (DEPTH, D_MODEL, N_MOD * D_MODEL), 0.5 * D_MODEL ** -0.5),
        'b_mod': nrm(ks[5], (DEPTH, N_MOD * D_MODEL), 0.02),
        'norm_mix_w': 1.0 + nrm(ks[6], (DEPTH, D_MODEL), 0.02),
        'norm_ffn_w': 1.0 + nrm(ks[7], (DEPTH, D_MODEL), 0.02),
        'w_in': nrm(ks[8], (DEPTH, D_MODEL, IN_COLS), D_MODEL ** -0.5),
        'na_rpb': nrm(ks[9], (DEPTH, NA_HEADS, 2 * WIN_ROWS - 1, 2 * WIN_COLS - 1), 0.1),
        'ret_decay_fwd': decay_logit[None] + nrm(ks[10], (DEPTH, RET_HEADS), 0.1),
        'ret_decay_bwd': decay_logit[None] + nrm(ks[11], (DEPTH, RET_HEADS), 0.1),
        'ret_gn_w': 1.0 + nrm(ks[12], (DEPTH, RET_WIDTH), 0.02),
        'w_out': nrm(ks[13], (DEPTH, MIX_WIDTH, D_MODEL), MIX_WIDTH ** -0.5),
        'w_router': nrm(ks[14], (DEPTH, D_MODEL, N_EXPERTS), D_MODEL ** -0.5),
        'w_gate': nrm(ks[15], (DEPTH, N_EXPERTS, D_MODEL, EXPERT_FF), D_MODEL ** -0.5),
        'w_up': nrm(ks[16], (DEPTH, N_EXPERTS, D_MODEL, EXPERT_FF), D_MODEL ** -0.5),
        'w_down': nrm(ks[17], (DEPTH, N_EXPERTS, EXPERT_FF, D_MODEL), EXPERT_FF ** -0.5),
        'final_norm_w': 1.0 + nrm(ks[18], (D_MODEL,), 0.02),
    }


def reference(x, c, ctx, c_ctx, w_mod, b_mod, norm_mix_w, norm_ffn_w, w_in, na_rpb, ret_decay_fwd, ret_decay_bwd, ret_gn_w, w_out, w_router, w_gate, w_up, w_down, final_norm_w):
    seq = x.shape[1]
    rows = seq // GRID_W
    t = jnp.arange(seq)
    row_pos, col_pos = t // GRID_W, t % GRID_W
    h_lat, h_ctx = x, ctx
    for layer in range(DEPTH):
        ctx_out = layer < DEPTH - 1
        mod_lat = jnp.split((jax.nn.silu(c) @ w_mod[layer] + b_mod[layer])[:, None, :], N_MOD, axis=-1)
        mod_ctx = jnp.split(jax.nn.silu(c_ctx) @ w_mod[layer] + b_mod[layer], N_MOD, axis=-1)
        lg_f = jax.nn.log_sigmoid(ret_decay_fwd[layer].astype(jnp.float32))
        lg_b = jax.nn.log_sigmoid(ret_decay_bwd[layer].astype(jnp.float32))

        u_lat = modulate(rms_norm(h_lat, norm_mix_w[layer]), mod_lat[0], mod_lat[1])
        u_ctx = modulate(rms_norm(h_ctx, norm_mix_w[layer]), mod_ctx[0], mod_ctx[1])
        k_na, v_na, k_ret, v_ret, q_na, q_ret, g_ret = jnp.split(u_lat @ w_in[layer], LAT_SPLITS, axis=-1)
        ck_na, cv_na, ck_ret, cv_ret = [to_heads(a) for a in jnp.split(u_ctx @ w_in[layer][:, :KV_COLS], CTX_KV_SPLITS, axis=-1)]
        ck_ret = ck_ret * HEAD_DIM ** -0.5
        s_f = context_state(ck_ret, cv_ret, lg_f, reverse=False)
        s_b = context_state(ck_ret, cv_ret, lg_b, reverse=True)

        na = neighbourhood_attention(to_heads(q_na), to_heads(k_na), to_heads(v_na), ck_na, cv_na, na_rpb[layer], rows)
        q_r = axial_rope(to_heads(q_ret), row_pos, col_pos)
        k_r = axial_rope(to_heads(k_ret), row_pos, col_pos) * HEAD_DIM ** -0.5
        ret = bidirectional_retention(q_r, k_r, to_heads(v_ret), lg_f, lg_b, s_f, s_b)
        mix_lat = jnp.concatenate([from_heads(na), retention_output(ret, g_ret, ret_gn_w[layer])], axis=-1) @ w_out[layer]
        if ctx_out:
            cq_na, cq_ret, cg_ret = jnp.split(u_ctx @ w_in[layer][:, KV_COLS:], CTX_Q_SPLITS, axis=-1)
            zero_state = jnp.zeros_like(s_f)
            na_c = context_self_attention(to_heads(cq_na), ck_na, cv_na)
            ret_c = bidirectional_retention(to_heads(cq_ret), ck_ret, cv_ret, lg_f, lg_b, zero_state, zero_state)
            mix_ctx = jnp.concatenate([from_heads(na_c), retention_output(ret_c, cg_ret, ret_gn_w[layer])], axis=-1) @ w_out[layer]
            h_ctx = h_ctx + mod_ctx[2] * mix_ctx
        h_lat = h_lat + mod_lat[2] * mix_lat

        u2_lat = modulate(rms_norm(h_lat, norm_ffn_w[layer]), mod_lat[3], mod_lat[4])
        h_lat = h_lat + mod_lat[5] * expert_choice_ffn(u2_lat, w_router[layer], w_gate[layer], w_up[layer], w_down[layer])
        if ctx_out:
            u2_ctx = modulate(rms_norm(h_ctx, norm_ffn_w[layer]), mod_ctx[3], mod_ctx[4])
            h_ctx = h_ctx + mod_ctx[5] * expert_choice_ffn(u2_ctx, w_router[layer], w_gate[layer], w_up[layer], w_down[layer])
    return rms_norm(h_lat, final_norm_w)
```

```cpp
#include <hip/hip_runtime.h>
#include <hip/hip_bf16.h>
#include <cstdio>
#include <cstdint>
#include <cmath>
#define MK_N_LAUNCHES 13
namespace pg8 {
#define PG8_LAS __attribute__((address_space(3)))
typedef unsigned short bf16_t;
typedef short bf16x8 __attribute__((ext_vector_type(8)));
typedef float f32x4 __attribute__((ext_vector_type(4)));
typedef unsigned u32x4 __attribute__((ext_vector_type(4)));
constexpr int BM = 256, BK = 64, HALF = 128, HTB = HALF * BK * 2  , STAGE_BYTES = 8 * HTB, NXCD = 8, WGM = 8;

__host__ __device__ __forceinline__ int lds_byte(int r, int c) { const int st = (r >> 4) * 2 + (c >> 5), rr = r & 15, cc = c & 31, ob = rr * 64 + cc * 2; return st * 1024 + (ob ^ (((ob >> 9) & 1) << 5)); }
__host__ __device__ __forceinline__ void stage_rc(int b, int& R, int& C) { const int st = b / 1024, sb = b % 1024, swz = sb ^ (((sb >> 9) & 1) << 5); R = (st >> 1) * 16 + swz / 64; C = (st & 1) * 32 + (swz % 64) / 2; }
__host__ __device__ __forceinline__ int perm32(int rho) { const int n = rho >> 4, i = rho & 15; return 8 * (i >> 2) + 4 * n + (i & 3); }

struct Unit { int pm, pn; };
struct Gemm { const bf16_t* A; const bf16_t* Bt; int M, N, K; int gshift; size_t gstride;
    __device__ __forceinline__ size_t bofs(int pm, int pn) const { return (size_t)(pm >> gshift) * gstride + (size_t)pn * (size_t)(256 * 2) * (size_t)K; } };

struct StaticOrder {
    int nM, nN, nwg, G, c;
    __host__ __device__ void init(int M, int N, int G_, int c_) { nM = M / BM; nN = N / BM; nwg = nM * nN; G = G_; c = c_; }
    __host__ __device__ bool next(int i, Unit& u) const {
        const long L = (long)i * G + c; if (L >= nwg) return false;
        int wgid = (int)L; { const int q = nwg / NXCD, r = nwg % NXCD, xcd = wgid % NXCD, off = wgid / NXCD; wgid = (xcd < r ? xcd * (q + 1) : r * (q + 1) + (xcd - r) * q) + off; }
        const int nig = WGM * nN, gid = wgid / nig, fm = gid * WGM, gsz = (nM - fm) < WGM ? (nM - fm) : WGM;
        u.pm = fm + ((wgid % nig) % gsz); u.pn = (wgid % nig) / gsz; return true;
    }
    __device__ __forceinline__ void a_ready(const Unit&) const {}
    __device__ __forceinline__ void done(const Unit&) const {}
};


__device__ __forceinline__ unsigned cvt_pk_bf16(float lo, float hi) { unsigned r; asm volatile("v_cvt_pk_bf16_f32 %0, %1, %2" : "=v"(r) : "v"(lo), "v"(hi)); return r; }
__device__ __forceinline__ float silu_f(float x) { return x * __builtin_amdgcn_rcpf(1.0f + __expf(-x)); }
__device__ __forceinline__ f32x4 silu4(f32x4 v) { return (f32x4){silu_f(v[0]), silu_f(v[1]), silu_f(v[2]), silu_f(v[3])}; }
__device__ __forceinline__ u32x4 pack8(f32x4 v0, f32x4 v1) { u32x4 w; w.x = cvt_pk_bf16(v0[0], v0[1]); w.y = cvt_pk_bf16(v0[2], v0[3]); w.z = cvt_pk_bf16(v1[0], v1[1]); w.w = cvt_pk_bf16(v1[2], v1[3]); return w; }

struct EpiQKV {
    static constexpr bool PERM = true, AFTER_DRAIN = false;
    bf16_t* O; const float* rc; const float* rs;
    __device__ __forceinline__ void operator()(const f32x4 (&acc)[2][2][4][2], const Unit& u, int wr, int wc, int fr, int fq) const {
        const int colt = u.pn * BM, t = colt >> 10; const bool lat = u.pm < 32;
        const int col0 = colt + wc * 32 + 8 * fq;
        const bool rope = lat && (t == 2 || t == 5);
        const int i0 = (wc & 1) * 16 + 4 * fq;
#pragma unroll
        for (int ai = 0; ai < 2; ++ai)
#pragma unroll
            for (int m = 0; m < 4; ++m) {
                const int row = u.pm * BM + ai * HALF + wr * 64 + m * 16 + fr;
                bf16_t* rowp = O + (size_t)row * 7168 + col0;
                f32x4 c4 = (f32x4){1.f, 1.f, 1.f, 1.f}, s4 = (f32x4){0.f, 0.f, 0.f, 0.f};
                if (rope) { const int tok = row & 4095; const int pos = (wc >> 1) ? (tok & 63) : (tok >> 6); c4 = *(const f32x4*)(rc + pos * 32 + i0); s4 = *(const f32x4*)(rs + pos * 32 + i0); }
#pragma unroll
                for (int bj = 0; bj < 2; ++bj) {
                    f32x4 v0 = acc[ai][bj][m][0], v1 = acc[ai][bj][m][1];
                    if (rope) { const f32x4 a = v0 * c4 - v1 * s4, b = v1 * c4 + v0 * s4; v0 = a; v1 = b; }
                    if (t == 2) { v0 = v0 * 0.08838834764831845f; v1 = v1 * 0.08838834764831845f; }
                    if (t == 6) { v0 = silu4(v0); v1 = silu4(v1); }
                    *(u32x4*)(rowp + bj * HALF) = pack8(v0, v1);
                }
            }
    }
};
struct EpiOut {
    static constexpr bool PERM = false, AFTER_DRAIN = false;
    const float* x; float* out; const float* mod;
    __device__ __forceinline__ void operator()(const f32x4 (&acc)[2][2][4][2], const Unit& u, int wr, int wc, int fr, int fq) const {
        const int b = u.pm >> 4; const float* g2 = mod + b * 12288 + 2 * 2048;
        const int col0 = u.pn * BM + wc * 32 + 4 * fq;
        f32x4 gv[2][2];
#pragma unroll
        for (int bj = 0; bj < 2; ++bj)
#pragma unroll
            for (int n = 0; n < 2; ++n) gv[bj][n] = *(const f32x4*)(g2 + col0 + bj * HALF + n * 16);
#pragma unroll
        for (int ai = 0; ai < 2; ++ai)
#pragma unroll
            for (int m = 0; m < 4; ++m) {
                const size_t off = (size_t)(u.pm * BM + ai * HALF + wr * 64 + m * 16 + fr) * 2048 + col0;
#pragma unroll
                for (int bj = 0; bj < 2; ++bj)
#pragma unroll
                    for (int n = 0; n < 2; ++n) { const f32x4 xv = *(const f32x4*)(x + off + bj * HALF + n * 16); *(f32x4*)(out + off + bj * HALF + n * 16) = xv + gv[bj][n] * acc[ai][bj][m][n]; }
            }
    }
};
struct EpiGU {
    static constexpr bool PERM = true, AFTER_DRAIN = false;
    bf16_t* H;
    __device__ __forceinline__ void operator()(const f32x4 (&acc)[2][2][4][2], const Unit& u, int wr, int wc, int fr, int fq) const {
        const int col0 = u.pn * HALF + wc * 32 + 8 * fq;
#pragma unroll
        for (int ai = 0; ai < 2; ++ai)
#pragma unroll
            for (int m = 0; m < 4; ++m) {
                const int row = u.pm * BM + ai * HALF + wr * 64 + m * 16 + fr;
                const f32x4 h0 = silu4(acc[ai][0][m][0]) * acc[ai][1][m][0], h1 = silu4(acc[ai][0][m][1]) * acc[ai][1][m][1];
                *(u32x4*)(H + (size_t)row * 1024 + col0) = pack8(h0, h1);
            }
    }
};
struct EpiDown {
    static constexpr bool PERM = true, AFTER_DRAIN = false;
    bf16_t* Y; const float* gate;
    __device__ __forceinline__ void operator()(const f32x4 (&acc)[2][2][4][2], const Unit& u, int wr, int wc, int fr, int fq) const {
        const int col0 = u.pn * BM + wc * 32 + 8 * fq;
#pragma unroll
        for (int ai = 0; ai < 2; ++ai)
#pragma unroll
            for (int m = 0; m < 4; ++m) {
                const int row = u.pm * BM + ai * HALF + wr * 64 + m * 16 + fr;
                const float gt = gate[row];
#pragma unroll
                for (int bj = 0; bj < 2; ++bj) *(u32x4*)(Y + (size_t)row * 2048 + col0 + bj * HALF) = pack8(acc[ai][bj][m][0] * gt, acc[ai][bj][m][1] * gt);
            }
    }
};
struct QkvOrder {
    StaticOrder so; int G, c;
    __host__ __device__ void init(int G_, int c_) { so.init(8192, 7168, G_, c_); G = G_; c = c_; }
    __host__ __device__ bool next(int i, Unit& u) const {
        const long L = (long)i * G + c; if (L < so.nwg) return so.next(i, u);
        const int l = (int)(L - so.nwg); if (l >= 32) return false;
        u.pm = 32 + (l & 1); u.pn = l >> 1; return true;
    }
    __device__ __forceinline__ void a_ready(const Unit&) const {}
    __device__ __forceinline__ void done(const Unit&) const {}
};
template <class Epi, class Sched, bool ALIGN_EPI = false, bool SP2 = false>
__device__ __forceinline__ void gemm_phase(PG8_LAS unsigned char* lds, const Gemm g, const Sched& S, const Epi& E) {
    int tid_ = threadIdx.x; asm volatile("" : "+v"(tid_));
    const int tid = tid_, wid = __builtin_amdgcn_readfirstlane(tid >> 6), lane = tid & 63, wr = wid >> 2, wc = wid & 3, fr = lane & 15, fq = lane >> 4;
    const int K = g.K, nt = K / BK;
    unsigned voffA[2], voffB[2];
#pragma unroll
    for (int i = 0; i < 2; ++i) { int R, C; stage_rc(tid * 16 + i * 8192, R, C); const int Rb = Epi::PERM ? ((R & ~31) + perm32(R & 31)) : R;
        voffA[i] = (unsigned)(R * K + C) * 2u; voffB[i] = (unsigned)(Rb * K + C) * 2u; }
    const size_t kstep = (size_t)(BK * 2);
    const size_t hstep = (size_t)HALF * K * 2;
    const size_t tstep = 2 * hstep;
    const unsigned ldsw = (unsigned)wid * 1024u;
    const int aoff = lds_byte(wr * 64 + fr, fq * 8), boff = lds_byte(wc * 32 + fr, fq * 8);
#define PG8_SA(b, h) (((b) * 2 + (h)) * HTB)
#define PG8_SB(b, h) ((4 + (b) * 2 + (h)) * HTB)
#define PG8_STAGE(bufoff, gbase, voff) do { _Pragma("unroll") for (int _i = 0; _i < 2; ++_i) \
        __builtin_amdgcn_global_load_lds((const unsigned*)((const char*)(gbase) + (voff)[_i]), (PG8_LAS unsigned*)(lds + (bufoff) + ldsw + _i * 8192), 16, 0, 0); } while (0)
#define PG8_LDA(dst, b, h) do { _Pragma("unroll") for (int m = 0; m < 4; ++m) _Pragma("unroll") for (int k = 0; k < 2; ++k) dst[m][k] = *(const PG8_LAS bf16x8*)(lds + PG8_SA(b, h) + aoff + m * 2048 + k * 1024); } while (0)
#define PG8_LDB(dst, b, h) do { _Pragma("unroll") for (int n = 0; n < 2; ++n) _Pragma("unroll") for (int k = 0; k < 2; ++k) dst[n][k] = *(const PG8_LAS bf16x8*)(lds + PG8_SB(b, h) + boff + n * 2048 + k * 1024); } while (0)
#define PG8_MMA(ai, bj, At, Bt) do { __builtin_amdgcn_s_setprio(1); _Pragma("unroll") for (int m = 0; m < 4; ++m) _Pragma("unroll") for (int n = 0; n < 2; ++n) _Pragma("unroll") for (int k = 0; k < 2; ++k) \
        acc[ai][bj][m][n] = __builtin_amdgcn_mfma_f32_16x16x32_bf16(Bt[n][k], At[m][k], acc[ai][bj][m][n], 0, 0, 0); __builtin_amdgcn_s_setprio(0); } while (0)
#define PG8_WAIT_V(n) asm volatile("s_waitcnt vmcnt(" #n ")" ::: "memory")
#define PG8_WAIT_L(n) asm volatile("s_waitcnt lgkmcnt(" #n ")" ::: "memory")
#define PG8_BAR __builtin_amdgcn_s_barrier()
#define PG8_SCHED __builtin_amdgcn_sched_barrier(0)
    Unit cur, nxt; int ui = 0;
    if (!S.next(0, cur)) return;
    f32x4 acc[2][2][4][2];
#pragma unroll
    for (int a = 0; a < 2; ++a)
#pragma unroll
        for (int b = 0; b < 2; ++b)
#pragma unroll
            for (int m = 0; m < 4; ++m)
#pragma unroll
                for (int n = 0; n < 2; ++n) acc[a][b][m][n] = (f32x4){0.f, 0.f, 0.f, 0.f};
    bf16x8 At[4][2], B0[2][2], B1[2][2];
    const char* cA = (const char*)g.A + (size_t)cur.pm * tstep; const char* cB = (const char*)g.Bt + g.bofs(cur.pm, cur.pn);
    S.a_ready(cur);
    if constexpr (SP2) {
        PG8_STAGE(PG8_SB(0, 0), cB, voffB); PG8_STAGE(PG8_SB(0, 1), cB + hstep, voffB); PG8_STAGE(PG8_SA(0, 0), cA, voffA); PG8_STAGE(PG8_SA(0, 1), cA + hstep, voffA);
        if (wr == 1) PG8_BAR;
        PG8_WAIT_V(2); PG8_BAR;
        PG8_STAGE(PG8_SB(1, 0), cB + kstep, voffB); PG8_STAGE(PG8_SA(1, 0), cA + kstep, voffA); PG8_STAGE(PG8_SB(1, 1), cB + hstep + kstep, voffB);
        PG8_WAIT_V(6); PG8_BAR;
    } else {
        PG8_STAGE(PG8_SB(0, 0), cB, voffB); PG8_STAGE(PG8_SA(0, 0), cA, voffA); PG8_STAGE(PG8_SB(0, 1), cB + hstep, voffB); PG8_STAGE(PG8_SA(0, 1), cA + hstep, voffA);
        if (wr == 1) PG8_BAR;
        PG8_WAIT_V(4); PG8_BAR;
        PG8_STAGE(PG8_SB(1, 0), cB + kstep, voffB); PG8_STAGE(PG8_SA(1, 0), cA + kstep, voffA); PG8_STAGE(PG8_SB(1, 1), cB + hstep + kstep, voffB);
        PG8_WAIT_V(6); PG8_BAR;
    }
    for (;;) {
        const bool has_next = S.next(ui + 1, nxt);
        const char* nA = has_next ? (const char*)g.A + (size_t)nxt.pm * tstep : cA; const char* nB = has_next ? (const char*)g.Bt + g.bofs(nxt.pm, nxt.pn) : cB;
        for (int t = 0; t < nt; t += 2) {
            const bool last = (t == nt - 2);
            const char* a1 = cA + (size_t)(t + 1) * kstep;
            const char* a2 = last ? nA : cA + (size_t)(t + 2) * kstep; const char* b2 = last ? nB : cB + (size_t)(t + 2) * kstep;
            const char* a3 = a2 + kstep; const char* b3 = b2 + kstep;
            if (last && has_next) S.a_ready(nxt);
            if constexpr (SP2) {
            PG8_LDB(B0, 0, 0); PG8_LDB(B1, 0, 1); PG8_SCHED; PG8_LDA(At, 0, 0); PG8_STAGE(PG8_SA(1, 1), a1 + hstep, voffA);
            PG8_WAIT_V(8); PG8_WAIT_L(0); PG8_BAR; PG8_MMA(0, 0, At, B0); PG8_MMA(0, 1, At, B1); PG8_BAR; PG8_SCHED;
            PG8_LDA(At, 0, 1); PG8_STAGE(PG8_SB(0, 0), b2, voffB); PG8_STAGE(PG8_SB(0, 1), b2 + hstep, voffB); PG8_STAGE(PG8_SA(0, 0), a2, voffA);
            PG8_WAIT_V(8); PG8_WAIT_L(0); PG8_BAR; PG8_MMA(1, 0, At, B0); PG8_MMA(1, 1, At, B1); PG8_BAR; PG8_SCHED;
            PG8_LDB(B0, 1, 0); PG8_LDB(B1, 1, 1); PG8_SCHED; PG8_LDA(At, 1, 0); PG8_STAGE(PG8_SA(0, 1), a2 + hstep, voffA);
            PG8_WAIT_V(8); PG8_WAIT_L(0); PG8_BAR; PG8_MMA(0, 0, At, B0); PG8_MMA(0, 1, At, B1); PG8_BAR; PG8_SCHED;
            PG8_LDA(At, 1, 1); PG8_STAGE(PG8_SB(1, 0), b3, voffB); PG8_STAGE(PG8_SB(1, 1), b3 + hstep, voffB); PG8_STAGE(PG8_SA(1, 0), a3, voffA);
            PG8_WAIT_V(8); PG8_WAIT_L(0); PG8_BAR; PG8_MMA(1, 0, At, B0); PG8_MMA(1, 1, At, B1); PG8_BAR; PG8_SCHED;
            } else {
            PG8_LDB(B0, 0, 0); PG8_SCHED; PG8_LDA(At, 0, 0); PG8_STAGE(PG8_SA(1, 1), a1 + hstep, voffA);
            PG8_WAIT_L(8); PG8_BAR; PG8_WAIT_L(0); PG8_MMA(0, 0, At, B0); PG8_BAR; PG8_SCHED;
            PG8_LDB(B1, 0, 1); PG8_STAGE(PG8_SB(0, 0), b2, voffB);
            PG8_BAR; PG8_WAIT_L(0); PG8_MMA(0, 1, At, B1); PG8_BAR;
            PG8_LDA(At, 0, 1); PG8_STAGE(PG8_SA(0, 0), a2, voffA);
            PG8_BAR; PG8_WAIT_L(0); PG8_MMA(1, 0, At, B0); PG8_BAR; PG8_SCHED;
            PG8_STAGE(PG8_SB(0, 1), b2 + hstep, voffB);
            PG8_WAIT_V(6); PG8_BAR; PG8_MMA(1, 1, At, B1); PG8_BAR;
            PG8_LDB(B0, 1, 0); PG8_SCHED; PG8_LDA(At, 1, 0); PG8_STAGE(PG8_SA(0, 1), a2 + hstep, voffA);
            PG8_WAIT_L(8); PG8_BAR; PG8_WAIT_L(0); PG8_MMA(0, 0, At, B0); PG8_BAR; PG8_SCHED;
            PG8_LDB(B1, 1, 1); PG8_STAGE(PG8_SB(1, 0), b3, voffB);
            PG8_BAR; PG8_WAIT_L(0); PG8_MMA(0, 1, At, B1); PG8_BAR;
            PG8_LDA(At, 1, 1); PG8_STAGE(PG8_SA(1, 0), a3, voffA);
            PG8_BAR; PG8_WAIT_L(0); PG8_MMA(1, 0, At, B0); PG8_BAR; PG8_SCHED;
            PG8_STAGE(PG8_SB(1, 1), b3 + hstep, voffB);
            PG8_WAIT_V(6); PG8_BAR; PG8_MMA(1, 1, At, B1); PG8_BAR;
            }
        }
        if constexpr (ALIGN_EPI) { if (wr == 0) PG8_BAR; }
        if constexpr (!Epi::AFTER_DRAIN) { E(acc, cur, wr, wc, fr, fq); S.done(cur); }
        if (!has_next) break;
#pragma unroll
        for (int a = 0; a < 2; ++a)
#pragma unroll
            for (int b = 0; b < 2; ++b)
#pragma unroll
                for (int m = 0; m < 4; ++m)
#pragma unroll
                    for (int n = 0; n < 2; ++n) acc[a][b][m][n] = (f32x4){0.f, 0.f, 0.f, 0.f};
        cur = nxt; cA = nA; cB = nB; ++ui;
        if constexpr (ALIGN_EPI) { if (wr == 1) PG8_BAR; }
    }
    PG8_WAIT_V(0);
    if constexpr (!ALIGN_EPI) { if (wr == 0) PG8_BAR; }
    PG8_BAR;
    if constexpr (Epi::AFTER_DRAIN) { E.fused(acc, cur, wr, wc, fr, fq, lds, wid, lane); S.done(cur); }
#undef PG8_SA
#undef PG8_SB
#undef PG8_STAGE
#undef PG8_LDA
#undef PG8_LDB
#undef PG8_MMA
#undef PG8_WAIT_V
#undef PG8_WAIT_L
#undef PG8_BAR
#undef PG8_SCHED
}
}

constexpr int NWAVES = 8;
#ifndef MK_N_LAUNCHES
#define MK_N_LAUNCHES 1
#endif
constexpr int PER_PHASE = 13;
constexpr int N_LAUNCHES = MK_N_LAUNCHES;

constexpr int DM = 2048, NB = 2, SEQ = 4096, CTXL = 256, NEXP = 16, FF = 1024, CAP = 512;
constexpr int MLAT = NB * SEQ, MALL = MLAT + NB * CTXL, NIN = 7168, NMOD = 6 * DM;
constexpr float EPS = 1e-6f;

constexpr size_t MiB = 1u << 20, KiB = 1u << 10;
constexpr size_t WS_CTL = 0, CTL_ZERO_BYTES = 64 * KiB;
constexpr size_t WS_MODP = 1 * MiB;
constexpr size_t WS_MOD = 2 * MiB + 512 * KiB;
constexpr size_t WS_ROPE = 2 * MiB + 768 * KiB;
constexpr size_t WS_AFF = 3 * MiB;
constexpr size_t WS_SLOT = 3 * MiB + 512 * KiB;
constexpr size_t WS_IDX = 4 * MiB, WS_GATE = 4 * MiB + 64 * KiB;
constexpr size_t WS_WIN = 8 * MiB, WS_WOUT = 36 * MiB, WS_WGU = 44 * MiB, WS_WDN = 172 * MiB;
constexpr size_t WS_U = 236 * MiB;
constexpr size_t WS_QKV = 270 * MiB;
constexpr size_t WS_XE = 270 * MiB, WS_HID = 334 * MiB;
constexpr size_t WS_MIX = 389 * MiB;
constexpr size_t WS_KV = 421 * MiB;
constexpr size_t WS_YE = 421 * MiB;
constexpr size_t WS_ST = 489 * MiB;
constexpr size_t WS_END = 521 * MiB;
constexpr int CW_BAR = 1024;

constexpr int RING_BYTES = 131072;
constexpr int LDSCTL_OFF = 143360, MISC_OFF = LDSCTL_OFF + 320;
constexpr int LDS_BYTES = 147456;

#define GAS __attribute__((address_space(1)))
#define LAS __attribute__((address_space(3)))
typedef unsigned short bf16;
typedef unsigned v4u __attribute__((ext_vector_type(4)));
typedef unsigned v2u __attribute__((ext_vector_type(2)));
typedef float f32x4 __attribute__((ext_vector_type(4)));
typedef float f32x2 __attribute__((ext_vector_type(2)));
typedef float f32x16 __attribute__((ext_vector_type(16)));
typedef short bf16x8 __attribute__((ext_vector_type(8)));
typedef short s16x4 __attribute__((ext_vector_type(4)));
#define RLX_AGENT __ATOMIC_RELAXED, __HIP_MEMORY_SCOPE_AGENT
#define LDS_WAIT() asm volatile("s_waitcnt lgkmcnt(0)" ::: "memory")
#define VM_WAIT() asm volatile("s_waitcnt vmcnt(0)" ::: "memory")
#define SBAR() __builtin_amdgcn_sched_barrier(0)
__device__ __forceinline__ unsigned cvtpk(float lo, float hi) { unsigned r; asm volatile("v_cvt_pk_bf16_f32 %0, %1, %2" : "=v"(r) : "v"(lo), "v"(hi)); return r; }
__device__ __forceinline__ float bf2f(unsigned short b) { return __builtin_bit_cast(float, (unsigned)b << 16); }
__device__ __forceinline__ float silu_f(float x) { return x / (1.0f + __expf(-x)); }
__device__ __forceinline__ float log_sigmoid_f(float x) { return -log1pf(expf(-x)); }
__device__ __forceinline__ float wave_sum(float v) {
#pragma unroll
    for (int o = 1; o < 64; o <<= 1) v += __shfl_xor(v, o);
    return v;
}
__device__ __forceinline__ int opq(int v) { asm volatile("" : "+v"(v)); return v; }
__device__ __forceinline__ int crow(int r, int hi) { return (r & 3) + 8 * (r >> 2) + 4 * hi; }

#define XB_TMO      128
#define XB_XCNT(j)  (256  + 64 * (j))
#define XB_XSUB(j)  (1280 + 64 * (j))
#define XB_XGEN(j)  (2304 + 64 * (j))
#define XB_TOP      3328
#define XB_TOPGEN   3392
#define XCD_BAR_WORDS 3456
#define XB_SPIN_CAP (1u << 18)

__device__ __forceinline__ unsigned xb_ld(unsigned* p)              { return __hip_atomic_load(p, __ATOMIC_RELAXED, __HIP_MEMORY_SCOPE_AGENT); }
__device__ __forceinline__ unsigned xb_add(unsigned* p, unsigned v) { return __hip_atomic_fetch_add(p, v, __ATOMIC_RELAXED, __HIP_MEMORY_SCOPE_AGENT); }
__device__ __forceinline__ unsigned xb_xcc_id() { return (unsigned)__builtin_amdgcn_s_getreg((3 << 11) | 20) & 0xFu; }
#define XB_SPIN(cond, bar) do { unsigned _sp = 0; while (cond) { __builtin_amdgcn_s_sleep(1); \
    if ((++_sp & 255u) == 0u) { if (xb_ld(&(bar)[XB_TMO])) break; if (_sp > XB_SPIN_CAP) { atomicAdd(&(bar)[XB_TMO], 1u); break; } } } } while (0)

struct XcdBarrier {
    unsigned* bar; unsigned x;
    volatile LAS unsigned* st;
};

__device__ __forceinline__ XcdBarrier xcd_barrier_post(unsigned* bar, volatile LAS unsigned* st) {
    XcdBarrier b; b.bar = bar; b.x = xb_xcc_id(); b.st = st;
    if (threadIdx.x == 0) (void)xb_add(&bar[XB_XCNT(b.x)], 1u);
    return b;
}
__device__ __forceinline__ void xcd_barrier_complete(unsigned* bar, unsigned x, unsigned& nloc, unsigned& nx) {
    const unsigned G = gridDim.x * gridDim.y * gridDim.z;
    unsigned sum, cnt, mine, sp = 0u;
    for (;;) {
        sum = 0u; cnt = 0u; mine = 0u;
#pragma unroll
        for (unsigned j = 0; j < 16; ++j) { const unsigned c = xb_ld(&bar[XB_XCNT(j)]); sum += c; cnt += (c > 0u) ? 1u : 0u; mine = (j == x) ? c : mine; }
        if (sum == G) break;
        __builtin_amdgcn_s_sleep(1);
        if ((++sp & 255u) == 0u) { if (xb_ld(&bar[XB_TMO])) break; if (sp > XB_SPIN_CAP) { atomicAdd(&bar[XB_TMO], 1u); break; } }
    }
    nloc = mine > 0u ? mine : 1u; nx = cnt > 0u ? cnt : 1u;
}

__device__ __forceinline__ void xcd_barrier(const XcdBarrier& b) {
    asm volatile("s_waitcnt vmcnt(0)" ::: "memory");
    __syncthreads();
    if (threadIdx.x == 0) {
        unsigned* bar = b.bar;
        __builtin_amdgcn_s_waitcnt(0);
        unsigned nloc = b.st[0], nx = b.st[1];
        if (nloc == 0u) { xcd_barrier_complete(bar, b.x, nloc, nx); b.st[0] = nloc; b.st[1] = nx; }
        const unsigned old = xb_add(&bar[XB_XSUB(b.x)], 1u);
        const unsigned gen = old / nloc;
        if (old + 1u == (gen + 1u) * nloc) {
            __builtin_amdgcn_fence(__ATOMIC_RELEASE, "agent");
            asm volatile("s_waitcnt vmcnt(0)" ::: "memory");
            const unsigned og = xb_add(&bar[XB_TOP], 1u);
            const unsigned tg = og / nx;
            if (og + 1u == (tg + 1u) * nx) xb_add(&bar[XB_TOPGEN], 1u);
            else XB_SPIN(xb_ld(&bar[XB_TOPGEN]) == tg, bar);
            __builtin_amdgcn_fence(__ATOMIC_ACQUIRE, "agent");
            xb_add(&bar[XB_XGEN(b.x)], 1u);
            asm volatile("s_waitcnt vmcnt(0)" ::: "memory");
        } else {
            XB_SPIN(xb_ld(&bar[XB_XGEN(b.x)]) == gen, bar);
            __builtin_amdgcn_fence(__ATOMIC_ACQUIRE, "agent");
            asm volatile("s_waitcnt vmcnt(0)" ::: "memory");
        }
    }
    __syncthreads();
}

struct Args { const float* in[19]; float* out; unsigned char* ws; int ph_lo, ph_hi, li, pad; };
struct Ctx {
    const Args* a; unsigned char* lds;
    int wave;
    __device__ __forceinline__ int G() const { return (int)gridDim.x; }
    __device__ __forceinline__ int vcu() const { const int g = (int)gridDim.x, bx = (int)blockIdx.x; return (g % 8 == 0) ? (bx % 8) * (g / 8) + bx / 8 : bx; }
    __device__ __forceinline__ int gw() const { return vcu() * 8 + wave; }
    __device__ __forceinline__ int NGW() const { return (int)gridDim.x * 8; }
    __device__ __forceinline__ const float* x() const { return a->in[0]; } __device__ __forceinline__ const float* c() const { return a->in[1]; } __device__ __forceinline__ const float* ctxt() const { return a->in[2]; } __device__ __forceinline__ const float* c_ctx() const { return a->in[3]; } __device__ __forceinline__ const float* w_mod() const { return a->in[4]; } __device__ __forceinline__ const float* b_mod() const { return a->in[5]; } __device__ __forceinline__ const float* nmix() const { return a->in[6]; } __device__ __forceinline__ const float* nffn() const { return a->in[7]; } __device__ __forceinline__ const float* w_in() const { return a->in[8]; } __device__ __forceinline__ const float* rpb() const { return a->in[9]; } __device__ __forceinline__ const float* dec_f() const { return a->in[10]; } __device__ __forceinline__ const float* dec_b() const { return a->in[11]; } __device__ __forceinline__ const float* gn_w() const { return a->in[12]; } __device__ __forceinline__ const float* w_out() const { return a->in[13]; } __device__ __forceinline__ const float* w_router() const { return a->in[14]; } __device__ __forceinline__ const float* w_gate() const { return a->in[15]; } __device__ __forceinline__ const float* w_up() const { return a->in[16]; } __device__ __forceinline__ const float* w_down() const { return a->in[17]; } __device__ __forceinline__ const float* fin_w() const { return a->in[18]; }
    __device__ __forceinline__ float* out() const { return a->out; } __device__ __forceinline__ unsigned char* ws() const { return a->ws; }
};

__device__ __forceinline__ void p0_modpart(const Ctx& C) {
    const int TID_ = opq((int)threadIdx.x), LANE_ = TID_ & 63;
    float* sv = (float*)(C.lds + C.wave * 16384);
    float* modp = (float*)(C.ws() + WS_MODP);
    for (int unit = C.gw(); unit < 768; unit += C.NGW()) {
        const int nc = unit % 96, kc = unit / 96, n0 = nc * 128 + LANE_ * 2, k0 = kc * 256;
#pragma unroll
        for (int i = 0; i < 4; ++i) { const int kk = LANE_ + 64 * i, k = k0 + kk;
            sv[kk] = silu_f(C.c()[k]); sv[256 + kk] = silu_f(C.c()[2048 + k]); sv[512 + kk] = silu_f(C.c_ctx()[k]); }
        LDS_WAIT();
        f32x2 a0 = {0.f, 0.f}, a1 = {0.f, 0.f}, a2 = {0.f, 0.f};
        const float* wp = C.w_mod() + (size_t)k0 * NMOD + n0;
#pragma unroll 16
        for (int kk = 0; kk < 256; ++kk) { const f32x2 w = *(const f32x2*)(wp + (size_t)kk * NMOD); const float s0 = sv[kk], s1 = sv[256 + kk], s2 = sv[512 + kk];
            a0 += w * s0; a1 += w * s1; a2 += w * s2; }
        *(f32x2*)(modp + (size_t)(kc * 3 + 0) * NMOD + n0) = a0; *(f32x2*)(modp + (size_t)(kc * 3 + 1) * NMOD + n0) = a1; *(f32x2*)(modp + (size_t)(kc * 3 + 2) * NMOD + n0) = a2;
        LDS_WAIT();
    }
}
template <int MODE> __device__ __forceinline__ int orow_map(int n) {
    if (MODE == 1) { const int t = n >> 10; if (t == 2 || t == 5) { const int d = n & 127, a = d >> 6, nn = (d >> 5) & 1, i = d & 31; return (n & ~127) + 32 * (2 * a + (i >> 4)) + 8 * ((i >> 2) & 3) + 4 * nn + (i & 3); } return n; }
    if (MODE == 2) return (n >> 7) * 256 + (n & 127);
    if (MODE == 3) return (n >> 7) * 256 + 128 + (n & 127);
    return n;
}
template <int MODE> __device__ __forceinline__ void p0_transpose_item(const float* W, int K, int N, bf16* WT, float* scr, int item, int lane) {
    const int nblk = N / 32, kb = item / nblk, nb = item % nblk, k0 = 64 * kb, n0 = 32 * nb;
#pragma unroll 8
    for (int i = 0; i < 32; ++i) { const int kk = 2 * i + (lane >> 5); scr[kk * 33 + (lane & 31)] = W[(size_t)(k0 + kk) * N + n0 + (lane & 31)]; }
    LDS_WAIT();
    const int c = lane & 7;
#pragma unroll
    for (int j = 0; j < 4; ++j) { const int n = (lane >> 3) + 8 * j; const float* s = scr + (8 * c) * 33 + n;
        v4u o; o.x = cvtpk(s[0 * 33], s[1 * 33]); o.y = cvtpk(s[2 * 33], s[3 * 33]); o.z = cvtpk(s[4 * 33], s[5 * 33]); o.w = cvtpk(s[6 * 33], s[7 * 33]);
        *(v4u*)(WT + (size_t)orow_map<MODE>(n0 + n) * K + k0 + 8 * c) = o; }
    LDS_WAIT();
}
__device__ __forceinline__ void p0_prologue(const Ctx& C) {
    const int TID_ = opq((int)threadIdx.x), LANE_ = TID_ & 63;
    p0_modpart(C);
    float* scr = (float*)(C.lds + C.wave * 16384);
    constexpr int I_IN = 32 * 224, I_OUT = 32 * 64, I_E = 1024, I_GU = 16 * I_E;
    constexpr int NITEMS = I_IN + I_OUT + 3 * I_GU;
    bf16* WIN = (bf16*)(C.ws() + WS_WIN); bf16* WOUT = (bf16*)(C.ws() + WS_WOUT); bf16* WGU = (bf16*)(C.ws() + WS_WGU); bf16* WDN = (bf16*)(C.ws() + WS_WDN);
    for (int it = C.gw(); it < NITEMS; it += C.NGW()) {
        int r = it;
        if (r < I_IN) { p0_transpose_item<1>(C.w_in(), 2048, NIN, WIN, scr, r, LANE_); continue; } r -= I_IN;
        if (r < I_OUT) { p0_transpose_item<0>(C.w_out(), 2048, 2048, WOUT, scr, r, LANE_); continue; } r -= I_OUT;
        if (r < I_GU) { const int e = r >> 10; p0_transpose_item<2>(C.w_gate() + (size_t)e * 2048 * 1024, 2048, 1024, WGU + (size_t)e * 2048 * 2048, scr, r & 1023, LANE_); continue; } r -= I_GU;
        if (r < I_GU) { const int e = r >> 10; p0_transpose_item<3>(C.w_up() + (size_t)e * 2048 * 1024, 2048, 1024, WGU + (size_t)e * 2048 * 2048, scr, r & 1023, LANE_); continue; } r -= I_GU;
        { const int e = r >> 10; p0_transpose_item<0>(C.w_down() + (size_t)e * 1024 * 2048, 1024, 2048, WDN + (size_t)e * 2048 * 1024, scr, r & 1023, LANE_); }
    }
    if (blockIdx.x == 0) { float* rc = (float*)(C.ws() + WS_ROPE); float* rs = rc + 2048;
        for (int i = TID_; i < 2048; i += NWAVES * 64) { const int pos = i >> 5, f = i & 31; const float inv = powf(10000.0f, -(float)(2 * f) / 64.0f); const float ang = (float)pos * inv; rc[i] = cosf(ang); rs[i] = sinf(ang); } }
}

__device__ __forceinline__ void p1_rows(const Ctx& C) {
    const int TID_ = opq((int)threadIdx.x), LANE_ = TID_ & 63;
    float* tab = (float*)C.lds;
    const float* modp = (const float*)(C.ws() + WS_MODP);
    for (int idx = TID_; idx < 3 * 4096; idx += NWAVES * 64) { const int r = idx >> 12, n = idx & 4095; float v = C.b_mod()[n];
#pragma unroll
        for (int kc = 0; kc < 8; ++kc) v += modp[(size_t)(kc * 3 + r) * NMOD + n];
        tab[idx] = v; }
    { const int g = blockIdx.x * (NWAVES * 64) + TID_; float* mod = (float*)(C.ws() + WS_MOD);
      for (int q = g; q < 3 * NMOD; q += C.G() * NWAVES * 64) { const int r = q / NMOD, n = q % NMOD; float v = C.b_mod()[n];
#pragma unroll
          for (int kc = 0; kc < 8; ++kc) v += modp[(size_t)(kc * 3 + r) * NMOD + n];
          mod[q] = v; } }
    __syncthreads();
    bf16* U = (bf16*)(C.ws() + WS_U);
    for (int m = C.gw(); m < MALL; m += C.NGW()) {
        const float* src = m < MLAT ? C.x() + (size_t)m * DM : C.ctxt() + (size_t)(m - MLAT) * DM; const int r = m < MLAT ? (m >> 12) : 2;
        f32x4 v[8]; float s = 0.f;
#pragma unroll
        for (int j = 0; j < 8; ++j) { v[j] = ((const f32x4*)src)[LANE_ + 64 * j]; s += (v[j].x * v[j].x + v[j].y * v[j].y) + (v[j].z * v[j].z + v[j].w * v[j].w); }
        const float rstd = 1.0f / sqrtf(wave_sum(s) * (1.0f / DM) + EPS);
#pragma unroll
        for (int j = 0; j < 8; ++j) { const int col = (LANE_ + 64 * j) * 4; const f32x4 nw = *(const f32x4*)(C.nmix() + col), sh = *(const f32x4*)(tab + r * 4096 + col), sc = *(const f32x4*)(tab + r * 4096 + 2048 + col);
            const f32x4 u = (v[j] * rstd * nw) * (sc + 1.0f) + sh; v2u o; o.x = cvtpk(u.x, u.y); o.y = cvtpk(u.z, u.w); *(v2u*)(U + (size_t)m * DM + col) = o; }
    }
    __syncthreads();
}

namespace na {
constexpr float SCALE = 0.088388347648318440f, THR = 8.f;
constexpr int LD = NIN, KVBLK = 64, NT = 16;
constexpr int SHM_V = 16384, SHM_K = 16384, OFF_WS = 65536, OFF_TAB = 65536 + 2048;
#define KSWZ(row, colB) ((row) * 256 + ((colB) ^ (((row) & 7) << 4)))
__device__ __forceinline__ bf16x8 ld8(const bf16* p) { return *reinterpret_cast<const bf16x8*>(p); }
__device__ __forceinline__ void partialSM(f32x16& p0, f32x16& p1, float& m_reg, float& mn, float& alpha) {
  constexpr float C = SCALE * 1.4426950408889634f;
  float pmax = p0[0];
#pragma unroll
  for (int r = 1; r < 16; ++r) pmax = fmaxf(pmax, p0[r]);
#pragma unroll
  for (int r = 0; r < 16; ++r) pmax = fmaxf(pmax, p1[r]);
  { auto rr = __builtin_amdgcn_permlane32_swap(__float_as_uint(pmax), __float_as_uint(pmax), false, false);
    pmax = fmaxf(__uint_as_float(rr[0]), __uint_as_float(rr[1])); }
  if (__builtin_expect(__all(pmax - m_reg <= THR / SCALE), 1)) { mn = m_reg; alpha = 1.f; }
  else { mn = fmaxf(m_reg, pmax); alpha = __builtin_amdgcn_exp2f((m_reg - mn) * C); m_reg = mn; }
  float mnC = -mn * C;
#pragma unroll
  for (int r = 0; r < 16; ++r) p0[r] = fmaf(p0[r], C, mnC);
#pragma unroll
  for (int r = 0; r < 16; ++r) p1[r] = fmaf(p1[r], C, mnC);
#pragma unroll
  for (int r = 0; r < 16; ++r) p0[r] = __builtin_amdgcn_exp2f(p0[r]);
}
#define NA_PK4(P, BASE, OUT) do { unsigned a0 = cvtpk(P[BASE + 0], P[BASE + 1]), a1 = cvtpk(P[BASE + 2], P[BASE + 3]);   \
    unsigned b0 = cvtpk(P[BASE + 4], P[BASE + 5]), b1 = cvtpk(P[BASE + 6], P[BASE + 7]);                              \
    auto r0 = __builtin_amdgcn_permlane32_swap(a0, b0, false, false); auto r1 = __builtin_amdgcn_permlane32_swap(a1, b1, false, false); \
    v4u w = {r0[0], r1[0], r0[1], r1[1]}; OUT = *reinterpret_cast<bf16x8*>(&w); } while (0)
__device__ __forceinline__ void finishSM(f32x16& p0, f32x16& p1, float alpha, float& l_reg, bf16x8& pa0, bf16x8& pa1, bf16x8& pa2, bf16x8& pa3) {
#pragma unroll
  for (int r = 0; r < 16; ++r) p1[r] = __builtin_amdgcn_exp2f(p1[r]);
  float ps = 0;
#pragma unroll
  for (int r = 0; r < 16; ++r) ps += p0[r];
#pragma unroll
  for (int r = 0; r < 16; ++r) ps += p1[r];
  { auto rr = __builtin_amdgcn_permlane32_swap(__float_as_uint(ps), __float_as_uint(ps), false, false);
    ps = __uint_as_float(rr[0]) + __uint_as_float(rr[1]); }
  l_reg = l_reg * alpha + ps;
  NA_PK4(p0, 0, pa0); NA_PK4(p0, 8, pa1); NA_PK4(p1, 0, pa2); NA_PK4(p1, 8, pa3);
}
__device__ __forceinline__ void qkt(f32x16& p0, f32x16& p1, const bf16* Ks, const bf16x8* qr, int r32, int hi) {
  p0 = f32x16{}; p1 = f32x16{};
#pragma unroll
  for (int d0 = 0; d0 < 8; ++d0) { int cb = (d0 * 16 + hi * 8) * 2;
    bf16x8 b0 = *reinterpret_cast<const bf16x8*>((const char*)Ks + KSWZ(r32, cb));
    bf16x8 b1 = *reinterpret_cast<const bf16x8*>((const char*)Ks + KSWZ(32 + r32, cb));
    p0 = __builtin_amdgcn_mfma_f32_32x32x16_bf16(b0, qr[d0], p0, 0, 0, 0);
    p1 = __builtin_amdgcn_mfma_f32_32x32x16_bf16(b1, qr[d0], p1, 0, 0, 0); }
}
__device__ __forceinline__ int v_st(int k, int c) { const int kk = (k & ~0xC) | ((k & 4) << 1) | ((k & 8) >> 1); return ((kk >> 3) * 4 + (c >> 5)) * 512 + ((kk & 7) * 32 + (c & 31)) * 2; }
__device__ __forceinline__ int v_rd_base(int lane) { return ((lane & 3) << 3) | (((lane >> 2) & 3) << 6) | (((lane >> 4) & 1) << 5) | (((lane >> 5) & 1) << 8); }
constexpr int v_rd_off(int d0, int ks, int half) { return d0 * 512 + ks * 4096 + half * 2048; }
template <int OFF> __device__ __forceinline__ s16x4 tr_read(int vb) {
  s16x4 r; asm volatile("ds_read_b64_tr_b16 %0, %1 offset:%2" : "=&v"(r) : "v"(vb), "i"(OFF) : "memory"); return r;
}
template <int D0> __device__ __forceinline__ void pv_one(f32x16& od, int vb, bf16x8 pa0, bf16x8 pa1, bf16x8 pa2, bf16x8 pa3) {
  const s16x4 l0 = tr_read<v_rd_off(D0, 0, 0)>(vb), h0 = tr_read<v_rd_off(D0, 0, 1)>(vb), l1 = tr_read<v_rd_off(D0, 1, 0)>(vb), h1 = tr_read<v_rd_off(D0, 1, 1)>(vb);
  const s16x4 l2 = tr_read<v_rd_off(D0, 2, 0)>(vb), h2 = tr_read<v_rd_off(D0, 2, 1)>(vb), l3 = tr_read<v_rd_off(D0, 3, 0)>(vb), h3 = tr_read<v_rd_off(D0, 3, 1)>(vb);
  asm volatile("s_waitcnt lgkmcnt(0)" ::: "memory"); SBAR();
#define NA_PK(L, H) (bf16x8){L[0], L[1], L[2], L[3], H[0], H[1], H[2], H[3]}
  od = __builtin_amdgcn_mfma_f32_32x32x16_bf16(pa0, NA_PK(l0, h0), od, 0, 0, 0);
  od = __builtin_amdgcn_mfma_f32_32x32x16_bf16(pa1, NA_PK(l1, h1), od, 0, 0, 0);
  od = __builtin_amdgcn_mfma_f32_32x32x16_bf16(pa2, NA_PK(l2, h2), od, 0, 0, 0);
  od = __builtin_amdgcn_mfma_f32_32x32x16_bf16(pa3, NA_PK(l3, h3), od, 0, 0, 0);
}
__device__ __forceinline__ void pv_d0(f32x16* o, int vb, bf16x8 pa0, bf16x8 pa1, bf16x8 pa2, bf16x8 pa3) {
  pv_one<0>(o[0], vb, pa0, pa1, pa2, pa3); pv_one<1>(o[1], vb, pa0, pa1, pa2, pa3); pv_one<2>(o[2], vb, pa0, pa1, pa2, pa3); pv_one<3>(o[3], vb, pa0, pa1, pa2, pa3);
}
__device__ __forceinline__ void na_bias(f32x16& p0, f32x16& p1, int j, int kr_lo, int r, int rs, int cq, int cs, int hi, const float* tab) {
  if (j < 4) return;
  const int kr = kr_lo + j - 4; const bool inwin = (kr >= rs) && (kr < rs + 8); const float NEG = -1e30f;
  if (inwin) {
    const float* brow = tab + (kr - r + 7) * 128 + 63 - cq + 4 * hi;
    int tcs = 4 * hi - cs; asm volatile("" : "+v"(tcs));
#pragma unroll
    for (int e = 0; e < 16; ++e) { const int k0 = (e & 3) + 8 * (e >> 2); const bool v0 = (unsigned)(k0 + tcs) < 16u; p0[e] = v0 ? p0[e] + brow[k0] : NEG; }
    SBAR();
#pragma unroll
    for (int e = 0; e < 16; ++e) { const int k0 = (e & 3) + 8 * (e >> 2); const bool v1 = (unsigned)(k0 + 32 + tcs) < 16u; p1[e] = v1 ? p1[e] + brow[k0 + 32] : NEG; }
  } else {
#pragma unroll
    for (int e = 0; e < 16; ++e) { p0[e] = NEG; p1[e] = NEG; }
  }
}
__device__ __forceinline__ void na_unit(const bf16* __restrict__ QKV, bf16* __restrict__ MIX, const float* __restrict__ rpb, int b, int h, int rg, char* lds) {
  const int tid = opq((int)threadIdx.x), wid = __builtin_amdgcn_readfirstlane(tid >> 6), lane = tid & 63, r32 = lane & 31, hi = lane >> 5;
  bf16* V_lds = (bf16*)lds; bf16* K_lds = (bf16*)(lds + 2 * SHM_V);
  float* ws = (float*)(lds + OFF_WS) + wid * 64; float* li_l = ws; float* al_l = ws + 32;
  float* tab = (float*)(lds + OFF_TAB);
  for (int i = tid; i < 15 * 128; i += 512) { const int ro = i >> 7, xx = (i & 127) - 48; tab[i] = (xx >= 0 && xx <= 30) ? rpb[h * 465 + ro * 31 + xx] * (1.f / SCALE) : 0.f; }
  const int r = 4 * rg + (wid >> 1), cq = 32 * (wid & 1) + r32;
  const int rs = min(max(r - 4, 0), 56), cs = min(max(cq - 8, 0), 48), kr_lo = min(max(4 * rg - 4, 0), 52);
  const long rowc = MLAT + b * CTXL, rowl = (long)b * SEQ + kr_lo * 64;
#define NA_TROW(j) ((j) < 4 ? rowc + 64 * (j) : rowl + 64 * ((j) - 4))
  const bf16* Kh = QKV + h * 128; const bf16* Vh = QKV + 1024 + h * 128;
  float m_reg = -1e30f, l_reg = 0; f32x16 o[4] = {}; bf16x8 qr[8];
  const bf16* Qw = QKV + (long)(b * SEQ + rg * 256 + wid * 32 + r32) * LD + 4096 + h * 128 + hi * 8;
#pragma unroll
  for (int d0 = 0; d0 < 8; ++d0) qr[d0] = ld8(Qw + d0 * 16);
  const int sr = tid >> 4, sc = (tid & 15) * 8, vst0 = v_st(sr, sc), vst1 = v_st(32 + sr, sc);
  const int vb0 = (int)(uintptr_t)V_lds + v_rd_base(lane);
  struct { bf16x8 vs0, vs1, ks0, ks1; } sr_[1];
#define NA_SLOAD(i, j) do { const long t0_ = NA_TROW(j); sr_[i].vs0 = ld8(&Vh[(t0_ + sr) * LD + sc]); sr_[i].vs1 = ld8(&Vh[(t0_ + 32 + sr) * LD + sc]); \
    sr_[i].ks0 = ld8(&Kh[(t0_ + sr) * LD + sc]); sr_[i].ks1 = ld8(&Kh[(t0_ + 32 + sr) * LD + sc]); } while (0)
#define NA_SWRITE(bb, i) do { *(bf16x8*)((char*)V_lds + (bb) * SHM_V + vst0) = sr_[i].vs0;          \
    *(bf16x8*)((char*)V_lds + (bb) * SHM_V + vst1) = sr_[i].vs1; int kc = sc * 2;               \
    *(bf16x8*)((char*)K_lds + (bb) * SHM_K + KSWZ(sr, kc)) = sr_[i].ks0;                       \
    *(bf16x8*)((char*)K_lds + (bb) * SHM_K + KSWZ(32 + sr, kc)) = sr_[i].ks1; } while (0)
#define NA_SWAIT() asm volatile("s_waitcnt vmcnt(0)" ::: "memory")
#define NA_RESC(a) do { if (__any((a) < 1.f)) { if (hi == 0) al_l[r32] = (a); asm volatile("s_waitcnt lgkmcnt(0)" ::: "memory"); \
    _Pragma("unroll") for (int d = 0; d < 4; ++d) _Pragma("unroll") for (int rr_ = 0; rr_ < 16; ++rr_) o[d][rr_] *= al_l[crow(rr_, hi)]; } } while (0)
#define NA_BIAS(P0, P1, j) do { SBAR(); na_bias(P0, P1, (j), kr_lo, r, rs, cq, cs, hi, tab); SBAR(); } while (0)
  f32x16 pA0, pA1, pB0, pB1; float mnA, mnB, alA, alB; bf16x8 pa0, pa1, pa2, pa3;
  constexpr int SE = 0, SO = 0;
  NA_SLOAD(SE, 0); asm volatile("s_waitcnt vmcnt(0)" ::: "memory"); NA_SWRITE(0, SE); __syncthreads();
  qkt(pA0, pA1, K_lds, qr, r32, hi); partialSM(pA0, pA1, m_reg, mnA, alA);
  NA_SLOAD(SO, 1);
  NA_SWAIT(); NA_SWRITE(1, SO); __syncthreads();
  for (int j = 1; j + 1 < NT; j += 2) {
    SBAR(); qkt(pB0, pB1, (bf16*)((char*)K_lds + SHM_K), qr, r32, hi);
    finishSM(pA0, pA1, alA, l_reg, pa0, pa1, pa2, pa3); SBAR();
    NA_SLOAD(SO, j + 1); SBAR();
    pv_d0(o, vb0, pa0, pa1, pa2, pa3); NA_BIAS(pB0, pB1, j); partialSM(pB0, pB1, m_reg, mnB, alB);
    __syncthreads(); NA_SWAIT(); NA_SWRITE(0, SE);
    NA_RESC(alB); __syncthreads();
    SBAR(); qkt(pA0, pA1, K_lds, qr, r32, hi);
    finishSM(pB0, pB1, alB, l_reg, pa0, pa1, pa2, pa3); SBAR();
    NA_SLOAD(SE, j + 2); SBAR();
    pv_d0(o, vb0 + SHM_V, pa0, pa1, pa2, pa3); NA_BIAS(pA0, pA1, j + 1); partialSM(pA0, pA1, m_reg, mnA, alA);
    __syncthreads(); NA_SWAIT(); NA_SWRITE(1, SO);
    NA_RESC(alA); __syncthreads();
  }
  SBAR(); qkt(pB0, pB1, (bf16*)((char*)K_lds + SHM_K), qr, r32, hi);
  finishSM(pA0, pA1, alA, l_reg, pa0, pa1, pa2, pa3); SBAR();
  pv_d0(o, vb0, pa0, pa1, pa2, pa3); NA_BIAS(pB0, pB1, NT - 1); partialSM(pB0, pB1, m_reg, mnB, alB);
  __syncthreads(); NA_RESC(alB);
  finishSM(pB0, pB1, alB, l_reg, pa0, pa1, pa2, pa3); SBAR();
  pv_d0(o, vb0 + SHM_V, pa0, pa1, pa2, pa3);
  if (hi == 0) li_l[r32] = l_reg; asm volatile("s_waitcnt lgkmcnt(0)" ::: "memory");
  float rli[16];
#pragma unroll
  for (int rr_ = 0; rr_ < 16; ++rr_) rli[rr_] = __builtin_amdgcn_rcpf(li_l[crow(rr_, hi)]);
  bf16* Ow = MIX + (long)(b * SEQ + rg * 256 + wid * 32) * DM + h * 128;
#pragma unroll
  for (int rr_ = 0; rr_ < 16; ++rr_) { const int orow = crow(rr_, hi);
#pragma unroll
    for (int d0 = 0; d0 < 4; d0 += 1) { const unsigned pk = cvtpk(o[d0][rr_] * rli[rr_], 0.f); Ow[(long)orow * DM + d0 * 32 + r32] = (bf16)(pk & 0xffffu); } }
  __syncthreads();
#undef NA_SLOAD
#undef NA_SWRITE
#undef NA_SWAIT
#undef NA_RESC
#undef NA_BIAS
#undef NA_TROW
}
}

namespace ret {
typedef const LAS char* lds_cptr;
typedef short v4i16_t __attribute__((ext_vector_type(4)));
__device__ __forceinline__ s16x4 vtr(lds_cptr p) { return __builtin_bit_cast(s16x4, __builtin_amdgcn_ds_read_tr16_b64_v4i16((LAS v4i16_t*)p)); }
__device__ __forceinline__ bf16x8 tr_frag(lds_cptr base, int pitchB, int t0, int c0, int lane) {
    const int g = lane >> 4, q = (lane & 15) >> 2, p = lane & 3;
    lds_cptr a = base + (t0 + 8 * (g >> 1) + q) * pitchB + (c0 + 16 * (g & 1) + 4 * p) * 2;
    const s16x4 lo = vtr(a), hi4 = vtr(a + 4 * pitchB);
    return (bf16x8){lo[0], lo[1], lo[2], lo[3], hi4[0], hi4[1], hi4[2], hi4[3]};
}
__device__ __forceinline__ bf16x8 scale_frag8(bf16x8 a, f32x4 w0, f32x4 w1) {
    const v4u x = __builtin_bit_cast(v4u, a); v4u o;
    o.x = cvtpk(__builtin_bit_cast(float, x.x << 16) * w0.x, __builtin_bit_cast(float, x.x & 0xffff0000u) * w0.y);
    o.y = cvtpk(__builtin_bit_cast(float, x.y << 16) * w0.z, __builtin_bit_cast(float, x.y & 0xffff0000u) * w0.w);
    o.z = cvtpk(__builtin_bit_cast(float, x.z << 16) * w1.x, __builtin_bit_cast(float, x.z & 0xffff0000u) * w1.y);
    o.w = cvtpk(__builtin_bit_cast(float, x.w << 16) * w1.z, __builtin_bit_cast(float, x.w & 0xffff0000u) * w1.w);
    return __builtin_bit_cast(bf16x8, o);
}
__device__ __forceinline__ bf16x8 scale_frag1(bf16x8 a, float w) { const f32x4 w4 = {w, w, w, w}; return scale_frag8(a, w4, w4); }

constexpr int KV_PITCH = 320;
constexpr int KV_OFF_K = 0, KV_OFF_V = 128 * KV_PITCH, KV_OFF_W = 2 * 128 * KV_PITCH;
__device__ __forceinline__ void kv_item(const Ctx& C, int b, int h, int c) {
    const int TID_ = opq((int)threadIdx.x), LANE_ = TID_ & 63;
    const bf16* QKV = (const bf16*)(C.ws() + WS_QKV); float* KVB = (float*)(C.ws() + WS_KV);
    char* lds = (char*)C.lds; const int tid = TID_, lane = LANE_, wid = C.wave, r32 = lane & 31, hi = lane >> 5;
    const long rowbase = c < 2 ? (long)MLAT + b * CTXL + c * 128 : (long)b * SEQ + (c - 2) * 128;
    float* wt = (float*)(lds + KV_OFF_W);
    if (tid < 256) { const int d = tid >> 7, t = tid & 127; const float lg = log_sigmoid_f(d ? C.dec_b()[h] : C.dec_f()[h]); wt[tid] = expf(lg * (float)(d ? t : 127 - t)); }
#pragma unroll
    for (int i = 0; i < 4; ++i) { const int piece = tid + 512 * i, row = piece >> 4, cc = piece & 15;
        const bf16* src = QKV + (rowbase + row) * NIN + h * 128 + cc * 8;
        const v4u kx = *(const v4u*)(src + 2048), vx = *(const v4u*)(src + 3072);
        *(v4u*)(lds + KV_OFF_K + row * KV_PITCH + cc * 16) = kx; *(v4u*)(lds + KV_OFF_V + row * KV_PITCH + cc * 16) = vx; }
    __syncthreads();
    const lds_cptr Kb = (lds_cptr)(lds + KV_OFF_K), Vb = (lds_cptr)(lds + KV_OFF_V);
    const int dvb = wid & 3, dk0 = 2 * (wid >> 2);
    f32x16 acc[2][2] = {};
#pragma unroll
    for (int ks = 0; ks < 8; ++ks) {
        const bf16x8 a = tr_frag(Vb, KV_PITCH, 16 * ks, 32 * dvb, lane);
        const f32x4 wf0 = *(const f32x4*)(wt + 16 * ks + 8 * hi), wf1 = *(const f32x4*)(wt + 16 * ks + 8 * hi + 4);
        const f32x4 wb0 = *(const f32x4*)(wt + 128 + 16 * ks + 8 * hi), wb1 = *(const f32x4*)(wt + 128 + 16 * ks + 8 * hi + 4);
        const bf16x8 af = scale_frag8(a, wf0, wf1), ab = scale_frag8(a, wb0, wb1);
#pragma unroll
        for (int d = 0; d < 2; ++d) { const bf16x8 bk = tr_frag(Kb, KV_PITCH, 16 * ks, 32 * (dk0 + d), lane);
            acc[0][d] = __builtin_amdgcn_mfma_f32_32x32x16_bf16(af, bk, acc[0][d], 0, 0, 0);
            acc[1][d] = __builtin_amdgcn_mfma_f32_32x32x16_bf16(ab, bk, acc[1][d], 0, 0, 0); }
    }
#pragma unroll
    for (int dir = 0; dir < 2; ++dir)
#pragma unroll
        for (int d = 0; d < 2; ++d) { float* dst = KVB + ((size_t)(((b * 8 + h) * 2 + dir) * 34 + c)) * 16384 + 32 * (dk0 + d) + r32;
#pragma unroll
            for (int e = 0; e < 16; ++e) dst[(32 * dvb + crow(e, hi)) * 128] = acc[dir][d][e]; }
    __syncthreads();
}

__device__ __forceinline__ void scan_phase(const Ctx& C) {
    const int TID_ = opq((int)threadIdx.x), LANE_ = TID_ & 63;
    const float* KVB = (const float*)(C.ws() + WS_KV); bf16* ST = (bf16*)(C.ws() + WS_ST);
    for (int g = blockIdx.x * (NWAVES * 64) + TID_; g < 32 * 4096; g += C.G() * NWAVES * 64) {
        const int grp = g >> 12, e4 = g & 4095, h = (grp >> 1) & 7, dir = grp & 1;
        const float G = expf(128.0f * log_sigmoid_f(dir ? C.dec_b()[h] : C.dec_f()[h]));
        const f32x4* kv = (const f32x4*)(KVB + (size_t)grp * 34 * 16384) + e4;
        bf16* st = ST + (size_t)grp * 32 * 16384 + e4 * 4;
        f32x4 S;
        if (dir == 0) {
            S = kv[0] * G + kv[4096]; { v2u o; o.x = cvtpk(S.x, S.y); o.y = cvtpk(S.z, S.w); *(v2u*)(st) = o; }
#pragma unroll 4
            for (int n = 0; n < 31; ++n) { S = S * G + kv[(size_t)(n + 2) * 4096]; v2u o; o.x = cvtpk(S.x, S.y); o.y = cvtpk(S.z, S.w); *(v2u*)(st + (size_t)(n + 1) * 16384) = o; }
        } else {
            S = kv[0] + kv[4096] * G; { v2u o; o.x = cvtpk(S.x, S.y); o.y = cvtpk(S.z, S.w); *(v2u*)(st + (size_t)31 * 16384) = o; }
#pragma unroll 4
            for (int n = 31; n >= 1; --n) { S = S * G + kv[(size_t)(n + 2) * 4096]; v2u o; o.x = cvtpk(S.x, S.y); o.y = cvtpk(S.z, S.w); *(v2u*)(st + (size_t)(n - 1) * 16384) = o; }
        }
    }
}

constexpr int RO_OFF_K = 0, RO_OFF_V = 32768, RO_OFF_ST = 65536;
__device__ __forceinline__ void ro_item(const Ctx& C, int b, int h, int n) {
    const int TID_ = opq((int)threadIdx.x), LANE_ = TID_ & 63;
    const bf16* QKV = (const bf16*)(C.ws() + WS_QKV); const bf16* ST = (const bf16*)(C.ws() + WS_ST); bf16* MIX = (bf16*)(C.ws() + WS_MIX);
    char* lds = (char*)C.lds; const int tid = TID_, lane = LANE_, wid = C.wave, r32 = lane & 31, hi = lane >> 5;
    const long rowbase = (long)b * SEQ + n * 128;
    { const int sr = tid >> 4, sc = (tid & 15) * 8;
#pragma unroll
      for (int i = 0; i < 4; ++i) { const int row = sr + 32 * i; const bf16* src = QKV + (rowbase + row) * NIN + h * 128 + sc;
          const bf16x8 kx = *(const bf16x8*)(src + 2048), vx = *(const bf16x8*)(src + 3072);
          *(bf16x8*)(lds + RO_OFF_K + KSWZ(row, sc * 2)) = kx; *(bf16x8*)(lds + RO_OFF_V + (row >> 6) * 16384 + na::v_st(row & 63, sc)) = vx; } }
    __syncthreads();
    const int ib = wid & 3, dh = wid >> 2, iq = 32 * ib + r32;
    const float L2E = 1.4426950408889634f; const float lf2 = log_sigmoid_f(C.dec_f()[h]) * L2E, lb2 = log_sigmoid_f(C.dec_b()[h]) * L2E;
    bf16x8 qr[8];
    { const bf16* Qw = QKV + (rowbase + iq) * NIN + 5120 + h * 128 + hi * 8;
#pragma unroll
      for (int d0 = 0; d0 < 8; ++d0) qr[d0] = *(const bf16x8*)(Qw + d0 * 16); }
    f32x16 o[2] = {};
#pragma unroll
    for (int tile = 0; tile < 2; ++tile) {
        f32x16 p0 = {}, p1 = {};
        const char* Ks = lds + RO_OFF_K;
#pragma unroll
        for (int d0 = 0; d0 < 8; ++d0) { const int cb = (d0 * 16 + hi * 8) * 2;
            const bf16x8 k0 = *(const bf16x8*)(Ks + KSWZ(64 * tile + r32, cb)), k1 = *(const bf16x8*)(Ks + KSWZ(64 * tile + 32 + r32, cb));
            p0 = __builtin_amdgcn_mfma_f32_32x32x16_bf16(k0, qr[d0], p0, 0, 0, 0);
            p1 = __builtin_amdgcn_mfma_f32_32x32x16_bf16(k1, qr[d0], p1, 0, 0, 0); }
        SBAR();
        { int dbi = iq - 64 * tile - 4 * hi; asm volatile("" : "+v"(dbi)); const float dbase = (float)dbi;
#pragma unroll
          for (int e = 0; e < 16; ++e) {
            const float d0_ = dbase - (float)((e & 3) + 8 * (e >> 2)), d1_ = d0_ - 32.0f;
            float f0 = __builtin_amdgcn_exp2f(lf2 * fmaxf(d0_, 0.f) + lb2 * fmaxf(-d0_, 0.f)), f1 = __builtin_amdgcn_exp2f(lf2 * fmaxf(d1_, 0.f) + lb2 * fmaxf(-d1_, 0.f));
            f0 = fmaf(f0, fmaxf(1.0f - fabsf(d0_), 0.f), f0); f1 = fmaf(f1, fmaxf(1.0f - fabsf(d1_), 0.f), f1);
            p0[e] *= f0; p1[e] *= f1; } }
        SBAR();
        bf16x8 pa0, pa1, pa2, pa3;
        NA_PK4(p0, 0, pa0); NA_PK4(p0, 8, pa1); NA_PK4(p1, 0, pa2); NA_PK4(p1, 8, pa3);
        const int vb = (int)(uintptr_t)(lds + RO_OFF_V + tile * 16384) + na::v_rd_base(lane);
        if (dh == 0) { na::pv_one<0>(o[0], vb, pa0, pa1, pa2, pa3); na::pv_one<1>(o[1], vb, pa0, pa1, pa2, pa3); }
        else         { na::pv_one<2>(o[0], vb, pa0, pa1, pa2, pa3); na::pv_one<3>(o[1], vb, pa0, pa1, pa2, pa3); }
    }
    {
        const float cf = __builtin_amdgcn_exp2f(lf2 * (float)(iq + 1)), cb_ = __builtin_amdgcn_exp2f(lb2 * (float)(128 - iq));
        const bf16* Sf = ST + ((size_t)(((b * 8 + h) * 2 + 0) * 32 + n)) * 16384; const bf16* Sb = ST + ((size_t)(((b * 8 + h) * 2 + 1) * 32 + n)) * 16384;
#pragma unroll
        for (int ks = 0; ks < 8; ++ks) { SBAR(); const bf16x8 qf = scale_frag1(qr[ks], cf), qb = scale_frag1(qr[ks], cb_);
#pragma unroll
            for (int d = 0; d < 2; ++d) { const size_t so = (size_t)(32 * (2 * dh + d) + r32) * 128 + 16 * ks + 8 * hi;
                const bf16x8 sf = *(const bf16x8*)(Sf + so), sb = *(const bf16x8*)(Sb + so);
                o[d] = __builtin_amdgcn_mfma_f32_32x32x16_bf16(qf, sf, o[d], 0, 0, 0);
                o[d] = __builtin_amdgcn_mfma_f32_32x32x16_bf16(qb, sb, o[d], 0, 0, 0); } }
    }
    float* stats = (float*)(lds + RO_OFF_ST);
#pragma unroll
    for (int e = 0; e < 16; ++e) { float s1 = o[0][e] + o[1][e], s2 = o[0][e] * o[0][e] + o[1][e] * o[1][e];
#pragma unroll
        for (int m = 1; m < 32; m <<= 1) { s1 += __shfl_xor(s1, m); s2 += __shfl_xor(s2, m); }
        if (r32 == 0) { float* sp = stats + ((ib * 2 + dh) * 32 + crow(e, hi)) * 2; sp[0] = s1; sp[1] = s2; } }
    __syncthreads();
    const float* gnw = C.gn_w() + h * 128 + 32 * (2 * dh) + r32;
#pragma unroll
    for (int e = 0; e < 16; ++e) { const int q = crow(e, hi); const float* sa = stats + ((ib * 2 + 0) * 32 + q) * 2; const float* sb = stats + ((ib * 2 + 1) * 32 + q) * 2;
        const float mean = (sa[0] + sb[0]) * (1.0f / 128.0f), var = (sa[1] + sb[1]) * (1.0f / 128.0f) - mean * mean, rstd = 1.0f / sqrtf(fmaxf(var, 0.f) + EPS);
        const long row = rowbase + 32 * ib + q;
#pragma unroll
        for (int d = 0; d < 2; ++d) { const int dv = 32 * (2 * dh + d) + r32;
            const float gs = bf2f(QKV[row * NIN + 6144 + h * 128 + dv]);
            const float y = (o[d][e] - mean) * rstd * gnw[32 * d] * gs;
            MIX[row * DM + 1024 + h * 128 + dv] = (bf16)(cvtpk(y, 0.f) & 0xffffu); } }
    __syncthreads();
}
}

__device__ __forceinline__ void p7_rows(const Ctx& C) {
    const int TID_ = opq((int)threadIdx.x), LANE_ = TID_ & 63;
    float* wrT = (float*)C.lds;
    for (int idx = TID_; idx < DM * NEXP; idx += NWAVES * 64) wrT[(idx & 15) * DM + (idx >> 4)] = C.w_router()[idx];
    __syncthreads();
    const float* mod = (const float*)(C.ws() + WS_MOD); bf16* U2 = (bf16*)(C.ws() + WS_U); float* AFF = (float*)(C.ws() + WS_AFF);
    for (int m = C.gw(); m < MLAT; m += C.NGW()) {
        const int b = m >> 12, n = m & 4095; const float* src = C.out() + (size_t)m * DM;
        f32x4 v[8]; float s = 0.f;
#pragma unroll
        for (int j = 0; j < 8; ++j) { v[j] = ((const f32x4*)src)[LANE_ + 64 * j]; s += (v[j].x * v[j].x + v[j].y * v[j].y) + (v[j].z * v[j].z + v[j].w * v[j].w); }
        const float rstd = 1.0f / sqrtf(wave_sum(s) * (1.0f / DM) + EPS);
#pragma unroll
        for (int j = 0; j < 8; ++j) { const int col = (LANE_ + 64 * j) * 4; const f32x4 nw = *(const f32x4*)(C.nffn() + col), sh = *(const f32x4*)(mod + b * NMOD + 3 * DM + col), sc = *(const f32x4*)(mod + b * NMOD + 4 * DM + col);
            v[j] = (v[j] * rstd * nw) * (sc + 1.0f) + sh; v2u o; o.x = cvtpk(v[j].x, v[j].y); o.y = cvtpk(v[j].z, v[j].w); *(v2u*)(U2 + (size_t)m * DM + col) = o; }
        float lg[NEXP];
#pragma unroll
        for (int e = 0; e < NEXP; ++e) { float a = 0.f;
#pragma unroll
            for (int j = 0; j < 8; ++j) { const f32x4 w = *(const f32x4*)(wrT + e * DM + (LANE_ + 64 * j) * 4); a += (v[j].x * w.x + v[j].y * w.y) + (v[j].z * w.z + v[j].w * w.w); }
            lg[e] = wave_sum(a); }
        float mx = lg[0];
#pragma unroll
        for (int e = 1; e < NEXP; ++e) mx = fmaxf(mx, lg[e]);
        float sum = 0.f;
#pragma unroll
        for (int e = 0; e < NEXP; ++e) { lg[e] = expf(lg[e] - mx); sum += lg[e]; }
        const float inv = 1.0f / sum; float mine = 0.f;
#pragma unroll
        for (int e = 0; e < NEXP; ++e) mine = (LANE_ == e) ? lg[e] * inv : mine;
        if (LANE_ < NEXP) AFF[(size_t)(b * NEXP + LANE_) * SEQ + n] = mine;
    }
    __syncthreads();
}

__device__ __forceinline__ void p8_topk(const Ctx& C, int b, int e) {
    const int TID_ = opq((int)threadIdx.x), LANE_ = TID_ & 63;
    unsigned* hist = (unsigned*)C.lds;
    unsigned* scal = hist + 256; unsigned* wtot = hist + 288;
    const float* aff = (const float*)(C.ws() + WS_AFF) + (size_t)(b * NEXP + e) * SEQ;
    int* SLOT = (int*)(C.ws() + WS_SLOT) + (size_t)(b * NEXP + e) * SEQ; int* IDX = (int*)(C.ws() + WS_IDX) + (e * 2 + b) * CAP; float* GATE = (float*)(C.ws() + WS_GATE) + (e * 2 + b) * CAP;
    const int tid = TID_, base = tid * 8;
    unsigned key[8]; { const v4u a = *(const v4u*)(aff + base), c2 = *(const v4u*)(aff + base + 4); key[0] = a.x; key[1] = a.y; key[2] = a.z; key[3] = a.w; key[4] = c2.x; key[5] = c2.y; key[6] = c2.z; key[7] = c2.w; }
    unsigned prefix = 0u, remaining = CAP;
#pragma unroll
    for (int pass = 0; pass < 4; ++pass) {
        const int shift = 24 - 8 * pass;
        if (tid < 256) hist[tid] = 0u;
        __syncthreads();
#pragma unroll
        for (int i = 0; i < 8; ++i) { const bool match = (pass == 0) || ((key[i] >> (shift + 8)) == (prefix >> (shift + 8))); if (match) atomicAdd(&hist[(key[i] >> shift) & 255u], 1u); }
        __syncthreads();
        if (tid == 0) { unsigned cum = 0u; int d = 255; for (; d > 0; --d) { const unsigned hcnt = hist[d]; if (cum + hcnt >= remaining) break; cum += hcnt; } scal[0] = prefix | ((unsigned)d << shift); scal[1] = remaining - cum; }
        __syncthreads();
        prefix = scal[0]; remaining = scal[1];
        __syncthreads();
    }
    unsigned cg = 0u, ce = 0u;
#pragma unroll
    for (int i = 0; i < 8; ++i) { cg += key[i] > prefix ? 1u : 0u; ce += key[i] == prefix ? 1u : 0u; }
    unsigned pk = cg | (ce << 16), inc = pk;
#pragma unroll
    for (int o = 1; o < 64; o <<= 1) { const unsigned t = __shfl_up(inc, o); if (LANE_ >= o) inc += t; }
    if (LANE_ == 63) wtot[C.wave] = inc;
    __syncthreads();
    unsigned woff = 0u;
    for (int w = 0; w < C.wave; ++w) woff += wtot[w];
    const unsigned excl = woff + inc - pk; unsigned rg_ = excl & 0xffffu, re_ = excl >> 16;
    const unsigned ngt = CAP - remaining;
#pragma unroll
    for (int i = 0; i < 8; ++i) { int slot = -1;
        if (key[i] > prefix) { slot = (int)rg_; ++rg_; }
        else if (key[i] == prefix) { if (re_ < remaining) slot = (int)(ngt + re_); ++re_; }
        SLOT[base + i] = slot;
        if (slot >= 0) { IDX[slot] = base + i; GATE[slot] = __builtin_bit_cast(float, key[i]); } }
    __syncthreads();
}

__device__ __forceinline__ void p9_gather(const Ctx& C) {
    const int TID_ = opq((int)threadIdx.x), LANE_ = TID_ & 63;
    const bf16* U2 = (const bf16*)(C.ws() + WS_U); bf16* XE = (bf16*)(C.ws() + WS_XE); const int* IDX = (const int*)(C.ws() + WS_IDX);
    for (int R = C.gw(); R < NEXP * NB * CAP; R += C.NGW()) {
        const int b = (R >> 9) & 1; const int tok = IDX[R];
        const v4u* src = (const v4u*)(U2 + (size_t)(b * SEQ + tok) * DM) + LANE_; v4u* dst = (v4u*)(XE + (size_t)R * DM) + LANE_;
        const v4u a0 = src[0], a1 = src[64], a2 = src[128], a3 = src[192];
        dst[0] = a0; dst[64] = a1; dst[128] = a2; dst[192] = a3;
    }
}

__device__ __forceinline__ void p12_final(const Ctx& C) {
    const int TID_ = opq((int)threadIdx.x), LANE_ = TID_ & 63;
    const float* mod = (const float*)(C.ws() + WS_MOD); const bf16* YE = (const bf16*)(C.ws() + WS_YE); const int* SLOT = (const int*)(C.ws() + WS_SLOT);
    for (int m = C.gw(); m < MLAT; m += C.NGW()) {
        const int b = m >> 12, n = m & 4095; float* row = C.out() + (size_t)m * DM;
        f32x4 acc[8];
#pragma unroll
        for (int j = 0; j < 8; ++j) acc[j] = (f32x4){0.f, 0.f, 0.f, 0.f};
        for (int e = 0; e < NEXP; ++e) {
            const int s = __builtin_amdgcn_readfirstlane(SLOT[(size_t)(b * NEXP + e) * SEQ + n]);
            if (s >= 0) { const v2u* yr = (const v2u*)(YE + (size_t)((e * 2 + b) * CAP + s) * DM) + LANE_;
#pragma unroll
                for (int j = 0; j < 8; ++j) { const v2u y = yr[64 * j]; acc[j].x += __builtin_bit_cast(float, y.x << 16); acc[j].y += __builtin_bit_cast(float, y.x & 0xffff0000u); acc[j].z += __builtin_bit_cast(float, y.y << 16); acc[j].w += __builtin_bit_cast(float, y.y & 0xffff0000u); } }
        }
        f32x4 v[8]; float s2 = 0.f;
#pragma unroll
        for (int j = 0; j < 8; ++j) { const int col = (LANE_ + 64 * j) * 4; const f32x4 g5 = *(const f32x4*)(mod + b * NMOD + 5 * DM + col);
            v[j] = ((const f32x4*)row)[LANE_ + 64 * j] + g5 * acc[j]; s2 += (v[j].x * v[j].x + v[j].y * v[j].y) + (v[j].z * v[j].z + v[j].w * v[j].w); }
        const float rstd = 1.0f / sqrtf(wave_sum(s2) * (1.0f / DM) + EPS);
#pragma unroll
        for (int j = 0; j < 8; ++j) { const int col = (LANE_ + 64 * j) * 4; const f32x4 fw = *(const f32x4*)(C.fin_w() + col); ((f32x4*)row)[LANE_ + 64 * j] = v[j] * rstd * fw; }
    }
}

__global__ void __launch_bounds__(NWAVES * 64, 2) fwd_megakernel(Args args) {
    extern __shared__ __attribute__((aligned(16))) unsigned char lds[];
    Ctx C;
    C.a = &args; C.lds = lds;
    C.wave = __builtin_amdgcn_readfirstlane((int)threadIdx.x >> 6);
    volatile LAS unsigned* MISC = (volatile LAS unsigned*)((LAS unsigned char*)lds + MISC_OFF);
    for (int u = threadIdx.x; u < (LDS_BYTES - LDSCTL_OFF) / 4; u += NWAVES * 64) ((LAS unsigned*)((LAS unsigned char*)lds + LDSCTL_OFF))[u] = 0u;
    __syncthreads();
    unsigned* ctl = (unsigned*)(args.ws + WS_CTL);
    XcdBarrier bar; bar.bar = ctl + CW_BAR; bar.x = 0; bar.st = nullptr;
    if (N_LAUNCHES == 1) bar = xcd_barrier_post(ctl + CW_BAR, MISC + 8);
#define GRID_BAR() do { if (N_LAUNCHES == 1) xcd_barrier(bar); } while (0)
#ifndef PHASE_MASK
#define PHASE_MASK 0x1fff
#endif
#define IN(k) ((((PHASE_MASK) >> (k)) & 1) && args.ph_lo <= (k) && (k) < args.ph_hi)
#define BOTH(k) (IN(k) && IN((k) + 1))
    PG8_LAS unsigned char* ring = (PG8_LAS unsigned char*)lds;

    if (IN(0)) { p0_prologue(C); if (BOTH(0)) GRID_BAR(); }
    if (IN(1)) { p1_rows(C); if (BOTH(1)) GRID_BAR(); }
    if (IN(2)) {
        pg8::Gemm g{(const pg8::bf16_t*)(args.ws + WS_U), (const pg8::bf16_t*)(args.ws + WS_WIN), MALL, NIN, DM, 0, 0};
        pg8::QkvOrder S; S.init(C.G(), (int)blockIdx.x);
        pg8::EpiQKV E{(pg8::bf16_t*)(args.ws + WS_QKV), (const float*)(args.ws + WS_ROPE), (const float*)(args.ws + WS_ROPE) + 2048};
        pg8::gemm_phase<pg8::EpiQKV, pg8::QkvOrder, true, true>(ring, g, S, E);
        if (BOTH(2)) GRID_BAR();
    }
    if (IN(3)) {
#ifndef NO_NA
        for (int u = C.vcu(); u < 256; u += C.G()) { const int bh = u >> 4; na::na_unit((const bf16*)(args.ws + WS_QKV), (bf16*)(args.ws + WS_MIX), C.rpb(), bh >> 3, bh & 7, u & 15, (char*)lds); }
#endif
#ifndef NO_KV
        for (int it = C.vcu(); it < 544; it += C.G()) { const int bh = it / 34; ret::kv_item(C, bh >> 3, bh & 7, it % 34); }
#endif
        if (BOTH(3)) GRID_BAR();
    }
    if (IN(4)) { ret::scan_phase(C); if (BOTH(4)) GRID_BAR(); }
    if (IN(5)) {
        for (int it = C.vcu(); it < 512; it += C.G()) ret::ro_item(C, it >> 8, (it >> 5) & 7, it & 31);
        if (BOTH(5)) GRID_BAR();
    }
    if (IN(6)) {
        pg8::Gemm g{(const pg8::bf16_t*)(args.ws + WS_MIX), (const pg8::bf16_t*)(args.ws + WS_WOUT), MLAT, DM, DM, 0, 0};
        pg8::StaticOrder S; S.init(MLAT, DM, C.G(), (int)blockIdx.x);
        pg8::EpiOut E{C.x(), C.out(), (const float*)(args.ws + WS_MOD)};
        pg8::gemm_phase<pg8::EpiOut, pg8::StaticOrder, true, true>(ring, g, S, E);
        if (BOTH(6)) GRID_BAR();
    }
    if (IN(7)) { p7_rows(C); if (BOTH(7)) GRID_BAR(); }
    if (IN(8)) { for (int it = blockIdx.x; it < NB * NEXP; it += C.G()) p8_topk(C, it >> 4, it & 15); if (BOTH(8)) GRID_BAR(); }
    if (IN(9)) { p9_gather(C); if (BOTH(9)) GRID_BAR(); }
    if (IN(10)) {
        pg8::Gemm g{(const pg8::bf16_t*)(args.ws + WS_XE), (const pg8::bf16_t*)(args.ws + WS_WGU), NEXP * NB * CAP, 2 * FF, DM, 2, (size_t)2048 * 2048 * 2};
        pg8::StaticOrder S; S.init(NEXP * NB * CAP, 2 * FF, C.G(), (int)blockIdx.x);
        pg8::EpiGU E{(pg8::bf16_t*)(args.ws + WS_HID)};
        pg8::gemm_phase<pg8::EpiGU, pg8::StaticOrder, true, true>(ring, g, S, E);
        if (BOTH(10)) GRID_BAR();
    }
    if (IN(11)) {
        pg8::Gemm g{(const pg8::bf16_t*)(args.ws + WS_HID), (const pg8::bf16_t*)(args.ws + WS_WDN), NEXP * NB * CAP, DM, FF, 2, (size_t)2048 * 1024 * 2};
        pg8::StaticOrder S; S.init(NEXP * NB * CAP, DM, C.G(), (int)blockIdx.x);
        pg8::EpiDown E{(pg8::bf16_t*)(args.ws + WS_YE), (const float*)(args.ws + WS_GATE)};
        pg8::gemm_phase<pg8::EpiDown, pg8::StaticOrder, true, true>(ring, g, S, E);
        if (BOTH(11)) GRID_BAR();
    }
    if (IN(12)) { p12_final(C); }
#undef IN
#undef BOTH
#undef GRID_BAR
}

extern "C" void kernel_launch(void* const* d_in, const int* in_sizes, int n_in, void* d_out, int out_size, void* d_ws, size_t ws_size, hipStream_t stream) {
    static int grid = 0;
    if (grid == 0) {
        if (n_in != 19 || in_sizes[0] != MLAT * DM || out_size != MLAT * DM || ws_size < WS_END) { fprintf(stderr, "kernel_launch: built for 19 inputs, x/out of %d floats, >= %zu bytes of workspace; got n_in %d in0 %d out %d ws %zu; nothing launched\n", MLAT * DM, (size_t)WS_END, n_in, n_in > 0 ? in_sizes[0] : -1, out_size, ws_size); grid = -1; return; }
        int dev = 0, cus = 0, per_cu = 0;
        if (hipGetDevice(&dev) != hipSuccess || hipDeviceGetAttribute(&cus, hipDeviceAttributeMultiprocessorCount, dev) != hipSuccess) { fprintf(stderr, "kernel_launch: hipGetDevice / hipDeviceGetAttribute failed\n"); grid = -1; return; }
        if (hipFuncSetAttribute((const void*)fwd_megakernel, hipFuncAttributeMaxDynamicSharedMemorySize, LDS_BYTES) != hipSuccess) { fprintf(stderr, "kernel_launch: hipFuncSetAttribute(%d B LDS) failed\n", LDS_BYTES); grid = -1; return; }
        if (hipOccupancyMaxActiveBlocksPerMultiprocessor(&per_cu, (const void*)fwd_megakernel, NWAVES * 64, LDS_BYTES) != hipSuccess || per_cu < 1) { fprintf(stderr, "kernel_launch: occupancy query reports %d workgroups per CU\n", per_cu); per_cu = 1; }
        (void)hipGetLastError();
        grid = cus;
    }
    if (grid < 0) return;
    if (hipMemsetAsync((char*)d_ws + WS_CTL, 0, CTL_ZERO_BYTES, stream) != hipSuccess) { fprintf(stderr, "kernel_launch: hipMemsetAsync failed\n"); return; }
    Args a{};
    for (int i = 0; i < 19; ++i) a.in[i] = (const float*)d_in[i];
    a.out = (float*)d_out; a.ws = (unsigned char*)d_ws;
    if (N_LAUNCHES == 1) {
        a.ph_lo = 0; a.ph_hi = PER_PHASE; a.li = 0;
        void* kargs[] = {&a};
        hipError_t e = hipLaunchCooperativeKernel((const void*)fwd_megakernel, dim3(grid), dim3(NWAVES * 64), kargs, LDS_BYTES, stream);
        if (e != hipSuccess) { fprintf(stderr, "kernel_launch: cooperative launch failed: %s (grid %d)\n", hipGetErrorString(e), grid); (void)hipGetLastError(); }
    } else {
        for (int li = 0; li < PER_PHASE; ++li) { a.ph_lo = li; a.ph_hi = li + 1; a.li = li;
            hipLaunchKernelGGL(fwd_megakernel, dim3(grid), dim3(NWAVES * 64), LDS_BYTES, stream, a);
            const hipError_t le = hipPeekAtLastError(); if (le != hipSuccess) { fprintf(stderr, "kernel_launch: launch %d failed: %s\n", li, hipGetErrorName(le)); break; } }
    }
}
```

```cpp
#include <hip/hip_runtime.h>
#include <hip/hip_bf16.h>
#include <cstdio>
#include <cstdint>
#include <cmath>
#define MK_N_LAUNCHES 1
namespace pg8 {
#define PG8_LAS __attribute__((address_space(3)))
typedef unsigned short bf16_t;
typedef short bf16x8 __attribute__((ext_vector_type(8)));
typedef float f32x4 __attribute__((ext_vector_type(4)));
typedef unsigned u32x4 __attribute__((ext_vector_type(4)));
constexpr int BM = 256, BK = 64, HALF = 128, HTB = HALF * BK * 2  , STAGE_BYTES = 8 * HTB, NXCD = 8, WGM = 8;

__host__ __device__ __forceinline__ int lds_byte(int r, int c) { const int st = (r >> 4) * 2 + (c >> 5), rr = r & 15, cc = c & 31, ob = rr * 64 + cc * 2; return st * 1024 + (ob ^ (((ob >> 9) & 1) << 5)); }
__host__ __device__ __forceinline__ void stage_rc(int b, int& R, int& C) { const int st = b / 1024, sb = b % 1024, swz = sb ^ (((sb >> 9) & 1) << 5); R = (st >> 1) * 16 + swz / 64; C = (st & 1) * 32 + (swz % 64) / 2; }
__host__ __device__ __forceinline__ int perm32(int rho) { const int n = rho >> 4, i = rho & 15; return 8 * (i >> 2) + 4 * n + (i & 3); }

struct Unit { int pm, pn; };
struct Gemm { const bf16_t* A; const bf16_t* Bt; int M, N, K; int gshift; size_t gstride;
    __device__ __forceinline__ size_t bofs(int pm, int pn) const { return (size_t)(pm >> gshift) * gstride + (size_t)pn * (size_t)(256 * 2) * (size_t)K; } };

struct StaticOrder {
    int nM, nN, nwg, G, c;
    __host__ __device__ void init(int M, int N, int G_, int c_) { nM = M / BM; nN = N / BM; nwg = nM * nN; G = G_; c = c_; }
    __host__ __device__ bool next(int i, Unit& u) const {
        const long L = (long)i * G + c; if (L >= nwg) return false;
        int wgid = (int)L; { const int q = nwg / NXCD, r = nwg % NXCD, xcd = wgid % NXCD, off = wgid / NXCD; wgid = (xcd < r ? xcd * (q + 1) : r * (q + 1) + (xcd - r) * q) + off; }
        const int nig = WGM * nN, gid = wgid / nig, fm = gid * WGM, gsz = (nM - fm) < WGM ? (nM - fm) : WGM;
        u.pm = fm + ((wgid % nig) % gsz); u.pn = (wgid % nig) / gsz; return true;
    }
    __device__ __forceinline__ void a_ready(const Unit&) const {}
    __device__ __forceinline__ void done(const Unit&) const {}
};


__device__ __forceinline__ unsigned cvt_pk_bf16(float lo, float hi) { unsigned r; asm volatile("v_cvt_pk_bf16_f32 %0, %1, %2" : "=v"(r) : "v"(lo), "v"(hi)); return r; }
__device__ __forceinline__ float silu_f(float x) { return x * __builtin_amdgcn_rcpf(1.0f + __expf(-x)); }
__device__ __forceinline__ f32x4 silu4(f32x4 v) { return (f32x4){silu_f(v[0]), silu_f(v[1]), silu_f(v[2]), silu_f(v[3])}; }
__device__ __forceinline__ u32x4 pack8(f32x4 v0, f32x4 v1) { u32x4 w; w.x = cvt_pk_bf16(v0[0], v0[1]); w.y = cvt_pk_bf16(v0[2], v0[3]); w.z = cvt_pk_bf16(v1[0], v1[1]); w.w = cvt_pk_bf16(v1[2], v1[3]); return w; }

struct EpiQKV {
    static constexpr bool PERM = true, AFTER_DRAIN = false;
    bf16_t* O; const float* rc; const float* rs;
    __device__ __forceinline__ void operator()(const f32x4 (&acc)[2][2][4][2], const Unit& u, int wr, int wc, int fr, int fq) const {
        const int colt = u.pn * BM, t = colt >> 10; const bool lat = u.pm < 32;
        const int col0 = colt + wc * 32 + 8 * fq;
        const bool rope = lat && (t == 2 || t == 5);
        const int i0 = (wc & 1) * 16 + 4 * fq;
#pragma unroll
        for (int ai = 0; ai < 2; ++ai)
#pragma unroll
            for (int m = 0; m < 4; ++m) {
                const int row = u.pm * BM + ai * HALF + wr * 64 + m * 16 + fr;
                bf16_t* rowp = O + (size_t)row * 7168 + col0;
                f32x4 c4 = (f32x4){1.f, 1.f, 1.f, 1.f}, s4 = (f32x4){0.f, 0.f, 0.f, 0.f};
                if (rope) { const int tok = row & 4095; const int pos = (wc >> 1) ? (tok & 63) : (tok >> 6); c4 = *(const f32x4*)(rc + pos * 32 + i0); s4 = *(const f32x4*)(rs + pos * 32 + i0); }
#pragma unroll
                for (int bj = 0; bj < 2; ++bj) {
                    f32x4 v0 = acc[ai][bj][m][0], v1 = acc[ai][bj][m][1];
                    if (rope) { const f32x4 a = v0 * c4 - v1 * s4, b = v1 * c4 + v0 * s4; v0 = a; v1 = b; }
                    if (t == 2) { v0 = v0 * 0.08838834764831845f; v1 = v1 * 0.08838834764831845f; }
                    if (t == 6) { v0 = silu4(v0); v1 = silu4(v1); }
                    *(u32x4*)(rowp + bj * HALF) = pack8(v0, v1);
                }
            }
    }
};
struct EpiOut {
    static constexpr bool PERM = false, AFTER_DRAIN = false;
    const float* x; float* out; const float* mod;
    __device__ __forceinline__ void operator()(const f32x4 (&acc)[2][2][4][2], const Unit& u, int wr, int wc, int fr, int fq) const {
        const int b = u.pm >> 4; const float* g2 = mod + b * 12288 + 2 * 2048;
        const int col0 = u.pn * BM + wc * 32 + 4 * fq;
        f32x4 gv[2][2];
#pragma unroll
        for (int bj = 0; bj < 2; ++bj)
#pragma unroll
            for (int n = 0; n < 2; ++n) gv[bj][n] = *(const f32x4*)(g2 + col0 + bj * HALF + n * 16);
#pragma unroll
        for (int ai = 0; ai < 2; ++ai)
#pragma unroll
            for (int m = 0; m < 4; ++m) {
                const size_t off = (size_t)(u.pm * BM + ai * HALF + wr * 64 + m * 16 + fr) * 2048 + col0;
#pragma unroll
                for (int bj = 0; bj < 2; ++bj)
#pragma unroll
                    for (int n = 0; n < 2; ++n) { const f32x4 xv = *(const f32x4*)(x + off + bj * HALF + n * 16); *(f32x4*)(out + off + bj * HALF + n * 16) = xv + gv[bj][n] * acc[ai][bj][m][n]; }
            }
    }
};
struct EpiGU {
    static constexpr bool PERM = true, AFTER_DRAIN = false;
    bf16_t* H;
    __device__ __forceinline__ void operator()(const f32x4 (&acc)[2][2][4][2], const Unit& u, int wr, int wc, int fr, int fq) const {
        const int col0 = u.pn * HALF + wc * 32 + 8 * fq;
#pragma unroll
        for (int ai = 0; ai < 2; ++ai)
#pragma unroll
            for (int m = 0; m < 4; ++m) {
                const int row = u.pm * BM + ai * HALF + wr * 64 + m * 16 + fr;
                const f32x4 h0 = silu4(acc[ai][0][m][0]) * acc[ai][1][m][0], h1 = silu4(acc[ai][0][m][1]) * acc[ai][1][m][1];
                *(u32x4*)(H + (size_t)row * 1024 + col0) = pack8(h0, h1);
            }
    }
};
struct EpiDown {
    static constexpr bool PERM = true, AFTER_DRAIN = false;
    bf16_t* Y; const float* gate;
    __device__ __forceinline__ void operator()(const f32x4 (&acc)[2][2][4][2], const Unit& u, int wr, int wc, int fr, int fq) const {
        const int col0 = u.pn * BM + wc * 32 + 8 * fq;
#pragma unroll
        for (int ai = 0; ai < 2; ++ai)
#pragma unroll
            for (int m = 0; m < 4; ++m) {
                const int row = u.pm * BM + ai * HALF + wr * 64 + m * 16 + fr;
                const float gt = gate[row];
#pragma unroll
                for (int bj = 0; bj < 2; ++bj) *(u32x4*)(Y + (size_t)row * 2048 + col0 + bj * HALF) = pack8(acc[ai][bj][m][0] * gt, acc[ai][bj][m][1] * gt);
            }
    }
};
struct QkvOrder {
    StaticOrder so; int G, c;
    __host__ __device__ void init(int G_, int c_) { so.init(8192, 7168, G_, c_); G = G_; c = c_; }
    __host__ __device__ bool next(int i, Unit& u) const {
        const long L = (long)i * G + c; if (L < so.nwg) return so.next(i, u);
        const int l = (int)(L - so.nwg); if (l >= 32) return false;
        u.pm = 32 + (l & 1); u.pn = l >> 1; return true;
    }
    __device__ __forceinline__ void a_ready(const Unit&) const {}
    __device__ __forceinline__ void done(const Unit&) const {}
};
template <class Epi, class Sched, bool ALIGN_EPI = false, bool SP2 = false>
__device__ __forceinline__ void gemm_phase(PG8_LAS unsigned char* lds, const Gemm g, const Sched& S, const Epi& E) {
    int tid_ = threadIdx.x; asm volatile("" : "+v"(tid_));
    const int tid = tid_, wid = __builtin_amdgcn_readfirstlane(tid >> 6), lane = tid & 63, wr = wid >> 2, wc = wid & 3, fr = lane & 15, fq = lane >> 4;
    const int K = g.K, nt = K / BK;
    unsigned voffA[2], voffB[2];
#pragma unroll
    for (int i = 0; i < 2; ++i) { int R, C; stage_rc(tid * 16 + i * 8192, R, C); const int Rb = Epi::PERM ? ((R & ~31) + perm32(R & 31)) : R;
        voffA[i] = (unsigned)(R * K + C) * 2u; voffB[i] = (unsigned)(Rb * K + C) * 2u; }
    const size_t kstep = (size_t)(BK * 2);
    const size_t hstep = (size_t)HALF * K * 2;
    const size_t tstep = 2 * hstep;
    const unsigned ldsw = (unsigned)wid * 1024u;
    const int aoff = lds_byte(wr * 64 + fr, fq * 8), boff = lds_byte(wc * 32 + fr, fq * 8);
#define PG8_SA(b, h) (((b) * 2 + (h)) * HTB)
#define PG8_SB(b, h) ((4 + (b) * 2 + (h)) * HTB)
#define PG8_STAGE(bufoff, gbase, voff) do { _Pragma("unroll") for (int _i = 0; _i < 2; ++_i) \
        __builtin_amdgcn_global_load_lds((const unsigned*)((const char*)(gbase) + (voff)[_i]), (PG8_LAS unsigned*)(lds + (bufoff) + ldsw + _i * 8192), 16, 0, 0); } while (0)
#define PG8_LDA(dst, b, h) do { _Pragma("unroll") for (int m = 0; m < 4; ++m) _Pragma("unroll") for (int k = 0; k < 2; ++k) dst[m][k] = *(const PG8_LAS bf16x8*)(lds + PG8_SA(b, h) + aoff + m * 2048 + k * 1024); } while (0)
#define PG8_LDB(dst, b, h) do { _Pragma("unroll") for (int n = 0; n < 2; ++n) _Pragma("unroll") for (int k = 0; k < 2; ++k) dst[n][k] = *(const PG8_LAS bf16x8*)(lds + PG8_SB(b, h) + boff + n * 2048 + k * 1024); } while (0)
#define PG8_MMA(ai, bj, At, Bt) do { __builtin_amdgcn_s_setprio(1); _Pragma("unroll") for (int m = 0; m < 4; ++m) _Pragma("unroll") for (int n = 0; n < 2; ++n) _Pragma("unroll") for (int k = 0; k < 2; ++k) \
        acc[ai][bj][m][n] = __builtin_amdgcn_mfma_f32_16x16x32_bf16(Bt[n][k], At[m][k], acc[ai][bj][m][n], 0, 0, 0); __builtin_amdgcn_s_setprio(0); } while (0)
#define PG8_WAIT_V(n) asm volatile("s_waitcnt vmcnt(" #n ")" ::: "memory")
#define PG8_WAIT_L(n) asm volatile("s_waitcnt lgkmcnt(" #n ")" ::: "memory")
#define PG8_BAR __builtin_amdgcn_s_barrier()
#define PG8_SCHED __builtin_amdgcn_sched_barrier(0)
    Unit cur, nxt; int ui = 0;
    if (!S.next(0, cur)) return;
    f32x4 acc[2][2][4][2];
#pragma unroll
    for (int a = 0; a < 2; ++a)
#pragma unroll
        for (int b = 0; b < 2; ++b)
#pragma unroll
            for (int m = 0; m < 4; ++m)
#pragma unroll
                for (int n = 0; n < 2; ++n) acc[a][b][m][n] = (f32x4){0.f, 0.f, 0.f, 0.f};
    bf16x8 At[4][2], B0[2][2], B1[2][2];
    const char* cA = (const char*)g.A + (size_t)cur.pm * tstep; const char* cB = (const char*)g.Bt + g.bofs(cur.pm, cur.pn);
    S.a_ready(cur);
    if constexpr (SP2) {
        PG8_STAGE(PG8_SB(0, 0), cB, voffB); PG8_STAGE(PG8_SB(0, 1), cB + hstep, voffB); PG8_STAGE(PG8_SA(0, 0), cA, voffA); PG8_STAGE(PG8_SA(0, 1), cA + hstep, voffA);
        if (wr == 1) PG8_BAR;
        PG8_WAIT_V(2); PG8_BAR;
        PG8_STAGE(PG8_SB(1, 0), cB + kstep, voffB); PG8_STAGE(PG8_SA(1, 0), cA + kstep, voffA); PG8_STAGE(PG8_SB(1, 1), cB + hstep + kstep, voffB);
        PG8_WAIT_V(6); PG8_BAR;
    } else {
        PG8_STAGE(PG8_SB(0, 0), cB, voffB); PG8_STAGE(PG8_SA(0, 0), cA, voffA); PG8_STAGE(PG8_SB(0, 1), cB + hstep, voffB); PG8_STAGE(PG8_SA(0, 1), cA + hstep, voffA);
        if (wr == 1) PG8_BAR;
        PG8_WAIT_V(4); PG8_BAR;
        PG8_STAGE(PG8_SB(1, 0), cB + kstep, voffB); PG8_STAGE(PG8_SA(1, 0), cA + kstep, voffA); PG8_STAGE(PG8_SB(1, 1), cB + hstep + kstep, voffB);
        PG8_WAIT_V(6); PG8_BAR;
    }
    for (;;) {
        const bool has_next = S.next(ui + 1, nxt);
        const char* nA = has_next ? (const char*)g.A + (size_t)nxt.pm * tstep : cA; const char* nB = has_next ? (const char*)g.Bt + g.bofs(nxt.pm, nxt.pn) : cB;
        for (int t = 0; t < nt; t += 2) {
            const bool last = (t == nt - 2);
            const char* a1 = cA + (size_t)(t + 1) * kstep;
            const char* a2 = last ? nA : cA + (size_t)(t + 2) * kstep; const char* b2 = last ? nB : cB + (size_t)(t + 2) * kstep;
            const char* a3 = a2 + kstep; const char* b3 = b2 + kstep;
            if (last && has_next) S.a_ready(nxt);
            if constexpr (SP2) {
            PG8_LDB(B0, 0, 0); PG8_LDB(B1, 0, 1); PG8_SCHED; PG8_LDA(At, 0, 0); PG8_STAGE(PG8_SA(1, 1), a1 + hstep, voffA);
            PG8_WAIT_V(8); PG8_WAIT_L(0); PG8_BAR; PG8_MMA(0, 0, At, B0); PG8_MMA(0, 1, At, B1); PG8_BAR; PG8_SCHED;
            PG8_LDA(At, 0, 1); PG8_STAGE(PG8_SB(0, 0), b2, voffB); PG8_STAGE(PG8_SB(0, 1), b2 + hstep, voffB); PG8_STAGE(PG8_SA(0, 0), a2, voffA);
            PG8_WAIT_V(8); PG8_WAIT_L(0); PG8_BAR; PG8_MMA(1, 0, At, B0); PG8_MMA(1, 1, At, B1); PG8_BAR; PG8_SCHED;
            PG8_LDB(B0, 1, 0); PG8_LDB(B1, 1, 1); PG8_SCHED; PG8_LDA(At, 1, 0); PG8_STAGE(PG8_SA(0, 1), a2 + hstep, voffA);
            PG8_WAIT_V(8); PG8_WAIT_L(0); PG8_BAR; PG8_MMA(0, 0, At, B0); PG8_MMA(0, 1, At, B1); PG8_BAR; PG8_SCHED;
            PG8_LDA(At, 1, 1); PG8_STAGE(PG8_SB(1, 0), b3, voffB); PG8_STAGE(PG8_SB(1, 1), b3 + hstep, voffB); PG8_STAGE(PG8_SA(1, 0), a3, voffA);
            PG8_WAIT_V(8); PG8_WAIT_L(0); PG8_BAR; PG8_MMA(1, 0, At, B0); PG8_MMA(1, 1, At, B1); PG8_BAR; PG8_SCHED;
            } else {
            PG8_LDB(B0, 0, 0); PG8_SCHED; PG8_LDA(At, 0, 0); PG8_STAGE(PG8_SA(1, 1), a1 + hstep, voffA);
            PG8_WAIT_L(8); PG8_BAR; PG8_WAIT_L(0); PG8_MMA(0, 0, At, B0); PG8_BAR; PG8_SCHED;
            PG8_LDB(B1, 0, 1); PG8_STAGE(PG8_SB(0, 0), b2, voffB);
            PG8_BAR; PG8_WAIT_L(0); PG8_MMA(0, 1, At, B1); PG8_BAR;
            PG8_LDA(At, 0, 1); PG8_STAGE(PG8_SA(0, 0), a2, voffA);
            PG8_BAR; PG8_WAIT_L(0); PG8_MMA(1, 0, At, B0); PG8_BAR; PG8_SCHED;
            PG8_STAGE(PG8_SB(0, 1), b2 + hstep, voffB);
            PG8_WAIT_V(6); PG8_BAR; PG8_MMA(1, 1, At, B1); PG8_BAR;
            PG8_LDB(B0, 1, 0); PG8_SCHED; PG8_LDA(At, 1, 0); PG8_STAGE(PG8_SA(0, 1), a2 + hstep, voffA);
            PG8_WAIT_L(8); PG8_BAR; PG8_WAIT_L(0); PG8_MMA(0, 0, At, B0); PG8_BAR; PG8_SCHED;
            PG8_LDB(B1, 1, 1); PG8_STAGE(PG8_SB(1, 0), b3, voffB);
            PG8_BAR; PG8_WAIT_L(0); PG8_MMA(0, 1, At, B1); PG8_BAR;
            PG8_LDA(At, 1, 1); PG8_STAGE(PG8_SA(1, 0), a3, voffA);
            PG8_BAR; PG8_WAIT_L(0); PG8_MMA(1, 0, At, B0); PG8_BAR; PG8_SCHED;
            PG8_STAGE(PG8_SB(1, 1), b3 + hstep, voffB);
            PG8_WAIT_V(6); PG8_BAR; PG8_MMA(1, 1, At, B1); PG8_BAR;
            }
        }
        if constexpr (ALIGN_EPI) { if (wr == 0) PG8_BAR; }
        if constexpr (!Epi::AFTER_DRAIN) { E(acc, cur, wr, wc, fr, fq); S.done(cur); }
        if (!has_next) break;
#pragma unroll
        for (int a = 0; a < 2; ++a)
#pragma unroll
            for (int b = 0; b < 2; ++b)
#pragma unroll
                for (int m = 0; m < 4; ++m)
#pragma unroll
                    for (int n = 0; n < 2; ++n) acc[a][b][m][n] = (f32x4){0.f, 0.f, 0.f, 0.f};
        cur = nxt; cA = nA; cB = nB; ++ui;
        if constexpr (ALIGN_EPI) { if (wr == 1) PG8_BAR; }
    }
    PG8_WAIT_V(0);
    if constexpr (!ALIGN_EPI) { if (wr == 0) PG8_BAR; }
    PG8_BAR;
    if constexpr (Epi::AFTER_DRAIN) { E.fused(acc, cur, wr, wc, fr, fq, lds, wid, lane); S.done(cur); }
#undef PG8_SA
#undef PG8_SB
#undef PG8_STAGE
#undef PG8_LDA
#undef PG8_LDB
#undef PG8_MMA
#undef PG8_WAIT_V
#undef PG8_WAIT_L
#undef PG8_BAR
#undef PG8_SCHED
}
}

constexpr int NWAVES = 8;
#ifndef MK_N_LAUNCHES
#define MK_N_LAUNCHES 1
#endif
constexpr int PER_PHASE = 13;
constexpr int N_LAUNCHES = MK_N_LAUNCHES;

constexpr int DM = 2048, NB = 2, SEQ = 4096, CTXL = 256, NEXP = 16, FF = 1024, CAP = 512;
constexpr int MLAT = NB * SEQ, MALL = MLAT + NB * CTXL, NIN = 7168, NMOD = 6 * DM;
constexpr float EPS = 1e-6f;

constexpr size_t MiB = 1u << 20, KiB = 1u << 10;
constexpr size_t WS_CTL = 0, CTL_ZERO_BYTES = 64 * KiB;
constexpr size_t WS_MODP = 1 * MiB;
constexpr size_t WS_MOD = 2 * MiB + 512 * KiB;
constexpr size_t WS_ROPE = 2 * MiB + 768 * KiB;
constexpr size_t WS_AFF = 3 * MiB;
constexpr size_t WS_SLOT = 3 * MiB + 512 * KiB;
constexpr size_t WS_IDX = 4 * MiB, WS_GATE = 4 * MiB + 64 * KiB;
constexpr size_t WS_WIN = 8 * MiB, WS_WOUT = 36 * MiB, WS_WGU = 44 * MiB, WS_WDN = 172 * MiB;
constexpr size_t WS_U = 236 * MiB;
constexpr size_t WS_QKV = 270 * MiB;
constexpr size_t WS_XE = 270 * MiB, WS_HID = 334 * MiB;
constexpr size_t WS_MIX = 389 * MiB;
constexpr size_t WS_KV = 421 * MiB;
constexpr size_t WS_YE = 421 * MiB;
constexpr size_t WS_ST = 489 * MiB;
constexpr size_t WS_END = 521 * MiB;
constexpr int CW_BAR = 1024;

constexpr int RING_BYTES = 131072;
constexpr int LDSCTL_OFF = 143360, MISC_OFF = LDSCTL_OFF + 320;
constexpr int LDS_BYTES = 147456;

#define GAS __attribute__((address_space(1)))
#define LAS __attribute__((address_space(3)))
typedef unsigned short bf16;
typedef unsigned v4u __attribute__((ext_vector_type(4)));
typedef unsigned v2u __attribute__((ext_vector_type(2)));
typedef float f32x4 __attribute__((ext_vector_type(4)));
typedef float f32x2 __attribute__((ext_vector_type(2)));
typedef float f32x16 __attribute__((ext_vector_type(16)));
typedef short bf16x8 __attribute__((ext_vector_type(8)));
typedef short s16x4 __attribute__((ext_vector_type(4)));
#define RLX_AGENT __ATOMIC_RELAXED, __HIP_MEMORY_SCOPE_AGENT
#define LDS_WAIT() asm volatile("s_waitcnt lgkmcnt(0)" ::: "memory")
#define VM_WAIT() asm volatile("s_waitcnt vmcnt(0)" ::: "memory")
#define SBAR() __builtin_amdgcn_sched_barrier(0)
__device__ __forceinline__ unsigned cvtpk(float lo, float hi) { unsigned r; asm volatile("v_cvt_pk_bf16_f32 %0, %1, %2" : "=v"(r) : "v"(lo), "v"(hi)); return r; }
__device__ __forceinline__ float bf2f(unsigned short b) { return __builtin_bit_cast(float, (unsigned)b << 16); }
__device__ __forceinline__ float silu_f(float x) { return x / (1.0f + __expf(-x)); }
__device__ __forceinline__ float log_sigmoid_f(float x) { return -log1pf(expf(-x)); }
__device__ __forceinline__ float wave_sum(float v) {
#pragma unroll
    for (int o = 1; o < 64; o <<= 1) v += __shfl_xor(v, o);
    return v;
}
__device__ __forceinline__ int opq(int v) { asm volatile("" : "+v"(v)); return v; }
__device__ __forceinline__ int crow(int r, int hi) { return (r & 3) + 8 * (r >> 2) + 4 * hi; }

#define XB_TMO      128
#define XB_XCNT(j)  (256  + 64 * (j))
#define XB_XSUB(j)  (1280 + 64 * (j))
#define XB_XGEN(j)  (2304 + 64 * (j))
#define XB_TOP      3328
#define XB_TOPGEN   3392
#define XCD_BAR_WORDS 3456
#define XB_SPIN_CAP (1u << 18)

__device__ __forceinline__ unsigned xb_ld(unsigned* p)              { return __hip_atomic_load(p, __ATOMIC_RELAXED, __HIP_MEMORY_SCOPE_AGENT); }
__device__ __forceinline__ unsigned xb_add(unsigned* p, unsigned v) { return __hip_atomic_fetch_add(p, v, __ATOMIC_RELAXED, __HIP_MEMORY_SCOPE_AGENT); }
__device__ __forceinline__ unsigned xb_xcc_id() { return (unsigned)__builtin_amdgcn_s_getreg((3 << 11) | 20) & 0xFu; }
#define XB_SPIN(cond, bar) do { unsigned _sp = 0; while (cond) { __builtin_amdgcn_s_sleep(1); \
    if ((++_sp & 255u) == 0u) { if (xb_ld(&(bar)[XB_TMO])) break; if (_sp > XB_SPIN_CAP) { atomicAdd(&(bar)[XB_TMO], 1u); break; } } } } while (0)

struct XcdBarrier {
    unsigned* bar; unsigned x;
    volatile LAS unsigned* st;
};

__device__ __forceinline__ XcdBarrier xcd_barrier_post(unsigned* bar, volatile LAS unsigned* st) {
    XcdBarrier b; b.bar = bar; b.x = xb_xcc_id(); b.st = st;
    if (threadIdx.x == 0) (void)xb_add(&bar[XB_XCNT(b.x)], 1u);
    return b;
}
__device__ __forceinline__ void xcd_barrier_complete(unsigned* bar, unsigned x, unsigned& nloc, unsigned& nx) {
    const unsigned G = gridDim.x * gridDim.y * gridDim.z;
    unsigned sum, cnt, mine, sp = 0u;
    for (;;) {
        sum = 0u; cnt = 0u; mine = 0u;
#pragma unroll
        for (unsigned j = 0; j < 16; ++j) { const unsigned c = xb_ld(&bar[XB_XCNT(j)]); sum += c; cnt += (c > 0u) ? 1u : 0u; mine = (j == x) ? c : mine; }
        if (sum == G) break;
        __builtin_amdgcn_s_sleep(1);
        if ((++sp & 255u) == 0u) { if (xb_ld(&bar[XB_TMO])) break; if (sp > XB_SPIN_CAP) { atomicAdd(&bar[XB_TMO], 1u); break; } }
    }
    nloc = mine > 0u ? mine : 1u; nx = cnt > 0u ? cnt : 1u;
}

__device__ __forceinline__ void xcd_barrier(const XcdBarrier& b) {
    asm volatile("s_waitcnt vmcnt(0)" ::: "memory");
    __syncthreads();
    if (threadIdx.x == 0) {
        unsigned* bar = b.bar;
        __builtin_amdgcn_s_waitcnt(0);
        unsigned nloc = b.st[0], nx = b.st[1];
        if (nloc == 0u) { xcd_barrier_complete(bar, b.x, nloc, nx); b.st[0] = nloc; b.st[1] = nx; }
        const unsigned old = xb_add(&bar[XB_XSUB(b.x)], 1u);
        const unsigned gen = old / nloc;
        if (old + 1u == (gen + 1u) * nloc) {
            __builtin_amdgcn_fence(__ATOMIC_RELEASE, "agent");
            asm volatile("s_waitcnt vmcnt(0)" ::: "memory");
            const unsigned og = xb_add(&bar[XB_TOP], 1u);
            const unsigned tg = og / nx;
            if (og + 1u == (tg + 1u) * nx) xb_add(&bar[XB_TOPGEN], 1u);
            else XB_SPIN(xb_ld(&bar[XB_TOPGEN]) == tg, bar);
            __builtin_amdgcn_fence(__ATOMIC_ACQUIRE, "agent");
            xb_add(&bar[XB_XGEN(b.x)], 1u);
            asm volatile("s_waitcnt vmcnt(0)" ::: "memory");
        } else {
            XB_SPIN(xb_ld(&bar[XB_XGEN(b.x)]) == gen, bar);
            __builtin_amdgcn_fence(__ATOMIC_ACQUIRE, "agent");
            asm volatile("s_waitcnt vmcnt(0)" ::: "memory");
        }
    }
    __syncthreads();
}

struct Args { const float* in[19]; float* out; unsigned char* ws; int ph_lo, ph_hi, li, pad; };
struct Ctx {
    const Args* a; unsigned char* lds;
    int wave;
    __device__ __forceinline__ int G() const { return (int)gridDim.x; }
    __device__ __forceinline__ int vcu() const { const int g = (int)gridDim.x, bx = (int)blockIdx.x; return (g % 8 == 0) ? (bx % 8) * (g / 8) + bx / 8 : bx; }
    __device__ __forceinline__ int gw() const { return vcu() * 8 + wave; }
    __device__ __forceinline__ int NGW() const { return (int)gridDim.x * 8; }
    __device__ __forceinline__ const float* x() const { return a->in[0]; } __device__ __forceinline__ const float* c() const { return a->in[1]; } __device__ __forceinline__ const float* ctxt() const { return a->in[2]; } __device__ __forceinline__ const float* c_ctx() const { return a->in[3]; } __device__ __forceinline__ const float* w_mod() const { return a->in[4]; } __device__ __forceinline__ const float* b_mod() const { return a->in[5]; } __device__ __forceinline__ const float* nmix() const { return a->in[6]; } __device__ __forceinline__ const float* nffn() const { return a->in[7]; } __device__ __forceinline__ const float* w_in() const { return a->in[8]; } __device__ __forceinline__ const float* rpb() const { return a->in[9]; } __device__ __forceinline__ const float* dec_f() const { return a->in[10]; } __device__ __forceinline__ const float* dec_b() const { return a->in[11]; } __device__ __forceinline__ const float* gn_w() const { return a->in[12]; } __device__ __forceinline__ const float* w_out() const { return a->in[13]; } __device__ __forceinline__ const float* w_router() const { return a->in[14]; } __device__ __forceinline__ const float* w_gate() const { return a->in[15]; } __device__ __forceinline__ const float* w_up() const { return a->in[16]; } __device__ __forceinline__ const float* w_down() const { return a->in[17]; } __device__ __forceinline__ const float* fin_w() const { return a->in[18]; }
    __device__ __forceinline__ float* out() const { return a->out; } __device__ __forceinline__ unsigned char* ws() const { return a->ws; }
};

__device__ __forceinline__ void p0_modpart(const Ctx& C) {
    const int TID_ = opq((int)threadIdx.x), LANE_ = TID_ & 63;
    float* sv = (float*)(C.lds + C.wave * 16384);
    float* modp = (float*)(C.ws() + WS_MODP);
    for (int unit = C.gw(); unit < 768; unit += C.NGW()) {
        const int nc = unit % 96, kc = unit / 96, n0 = nc * 128 + LANE_ * 2, k0 = kc * 256;
#pragma unroll
        for (int i = 0; i < 4; ++i) { const int kk = LANE_ + 64 * i, k = k0 + kk;
            sv[kk] = silu_f(C.c()[k]); sv[256 + kk] = silu_f(C.c()[2048 + k]); sv[512 + kk] = silu_f(C.c_ctx()[k]); }
        LDS_WAIT();
        f32x2 a0 = {0.f, 0.f}, a1 = {0.f, 0.f}, a2 = {0.f, 0.f};
        const float* wp = C.w_mod() + (size_t)k0 * NMOD + n0;
#pragma unroll 16
        for (int kk = 0; kk < 256; ++kk) { const f32x2 w = *(const f32x2*)(wp + (size_t)kk * NMOD); const float s0 = sv[kk], s1 = sv[256 + kk], s2 = sv[512 + kk];
            a0 += w * s0; a1 += w * s1; a2 += w * s2; }
        *(f32x2*)(modp + (size_t)(kc * 3 + 0) * NMOD + n0) = a0; *(f32x2*)(modp + (size_t)(kc * 3 + 1) * NMOD + n0) = a1; *(f32x2*)(modp + (size_t)(kc * 3 + 2) * NMOD + n0) = a2;
        LDS_WAIT();
    }
}
template <int MODE> __device__ __forceinline__ int orow_map(int n) {
    if (MODE == 1) { const int t = n >> 10; if (t == 2 || t == 5) { const int d = n & 127, a = d >> 6, nn = (d >> 5) & 1, i = d & 31; return (n & ~127) + 32 * (2 * a + (i >> 4)) + 8 * ((i >> 2) & 3) + 4 * nn + (i & 3); } return n; }
    if (MODE == 2) return (n >> 7) * 256 + (n & 127);
    if (MODE == 3) return (n >> 7) * 256 + 128 + (n & 127);
    return n;
}
template <int MODE> __device__ __forceinline__ void p0_transpose_item(const float* W, int K, int N, bf16* WT, float* scr, int item, int lane) {
    const int nblk = N / 32, kb = item / nblk, nb = item % nblk, k0 = 64 * kb, n0 = 32 * nb;
#pragma unroll 8
    for (int i = 0; i < 32; ++i) { const int kk = 2 * i + (lane >> 5); scr[kk * 33 + (lane & 31)] = W[(size_t)(k0 + kk) * N + n0 + (lane & 31)]; }
    LDS_WAIT();
    const int c = lane & 7;
#pragma unroll
    for (int j = 0; j < 4; ++j) { const int n = (lane >> 3) + 8 * j; const float* s = scr + (8 * c) * 33 + n;
        v4u o; o.x = cvtpk(s[0 * 33], s[1 * 33]); o.y = cvtpk(s[2 * 33], s[3 * 33]); o.z = cvtpk(s[4 * 33], s[5 * 33]); o.w = cvtpk(s[6 * 33], s[7 * 33]);
        *(v4u*)(WT + (size_t)orow_map<MODE>(n0 + n) * K + k0 + 8 * c) = o; }
    LDS_WAIT();
}
__device__ __forceinline__ void p0_prologue(const Ctx& C) {
    const int TID_ = opq((int)threadIdx.x), LANE_ = TID_ & 63;
    p0_modpart(C);
    float* scr = (float*)(C.lds + C.wave * 16384);
    constexpr int I_IN = 32 * 224, I_OUT = 32 * 64, I_E = 1024, I_GU = 16 * I_E;
    constexpr int NITEMS = I_IN + I_OUT + 3 * I_GU;
    bf16* WIN = (bf16*)(C.ws() + WS_WIN); bf16* WOUT = (bf16*)(C.ws() + WS_WOUT); bf16* WGU = (bf16*)(C.ws() + WS_WGU); bf16* WDN = (bf16*)(C.ws() + WS_WDN);
    for (int it = C.gw(); it < NITEMS; it += C.NGW()) {
        int r = it;
        if (r < I_IN) { p0_transpose_item<1>(C.w_in(), 2048, NIN, WIN, scr, r, LANE_); continue; } r -= I_IN;
        if (r < I_OUT) { p0_transpose_item<0>(C.w_out(), 2048, 2048, WOUT, scr, r, LANE_); continue; } r -= I_OUT;
        if (r < I_GU) { const int e = r >> 10; p0_transpose_item<2>(C.w_gate() + (size_t)e * 2048 * 1024, 2048, 1024, WGU + (size_t)e * 2048 * 2048, scr, r & 1023, LANE_); continue; } r -= I_GU;
        if (r < I_GU) { const int e = r >> 10; p0_transpose_item<3>(C.w_up() + (size_t)e * 2048 * 1024, 2048, 1024, WGU + (size_t)e * 2048 * 2048, scr, r & 1023, LANE_); continue; } r -= I_GU;
        { const int e = r >> 10; p0_transpose_item<0>(C.w_down() + (size_t)e * 1024 * 2048, 1024, 2048, WDN + (size_t)e * 2048 * 1024, scr, r & 1023, LANE_); }
    }
    if (blockIdx.x == 0) { float* rc = (float*)(C.ws() + WS_ROPE); float* rs = rc + 2048;
        for (int i = TID_; i < 2048; i += NWAVES * 64) { const int pos = i >> 5, f = i & 31; const float inv = powf(10000.0f, -(float)(2 * f) / 64.0f); const float ang = (float)pos * inv; rc[i] = cosf(ang); rs[i] = sinf(ang); } }
}

__device__ __forceinline__ void p1_rows(const Ctx& C) {
    const int TID_ = opq((int)threadIdx.x), LANE_ = TID_ & 63;
    float* tab = (float*)C.lds;
    const float* modp = (const float*)(C.ws() + WS_MODP);
    for (int idx = TID_; idx < 3 * 4096; idx += NWAVES * 64) { const int r = idx >> 12, n = idx & 4095; float v = C.b_mod()[n];
#pragma unroll
        for (int kc = 0; kc < 8; ++kc) v += modp[(size_t)(kc * 3 + r) * NMOD + n];
        tab[idx] = v; }
    { const int g = blockIdx.x * (NWAVES * 64) + TID_; float* mod = (float*)(C.ws() + WS_MOD);
      for (int q = g; q < 3 * NMOD; q += C.G() * NWAVES * 64) { const int r = q / NMOD, n = q % NMOD; float v = C.b_mod()[n];
#pragma unroll
          for (int kc = 0; kc < 8; ++kc) v += modp[(size_t)(kc * 3 + r) * NMOD + n];
          mod[q] = v; } }
    __syncthreads();
    bf16* U = (bf16*)(C.ws() + WS_U);
    for (int m = C.gw(); m < MALL; m += C.NGW()) {
        const float* src = m < MLAT ? C.x() + (size_t)m * DM : C.ctxt() + (size_t)(m - MLAT) * DM; const int r = m < MLAT ? (m >> 12) : 2;
        f32x4 v[8]; float s = 0.f;
#pragma unroll
        for (int j = 0; j < 8; ++j) { v[j] = ((const f32x4*)src)[LANE_ + 64 * j]; s += (v[j].x * v[j].x + v[j].y * v[j].y) + (v[j].z * v[j].z + v[j].w * v[j].w); }
        const float rstd = 1.0f / sqrtf(wave_sum(s) * (1.0f / DM) + EPS);
#pragma unroll
        for (int j = 0; j < 8; ++j) { const int col = (LANE_ + 64 * j) * 4; const f32x4 nw = *(const f32x4*)(C.nmix() + col), sh = *(const f32x4*)(tab + r * 4096 + col), sc = *(const f32x4*)(tab + r * 4096 + 2048 + col);
            const f32x4 u = (v[j] * rstd * nw) * (sc + 1.0f) + sh; v2u o; o.x = cvtpk(u.x, u.y); o.y = cvtpk(u.z, u.w); *(v2u*)(U + (size_t)m * DM + col) = o; }
    }
    __syncthreads();
}

namespace na {
constexpr float SCALE = 0.088388347648318440f, THR = 8.f;
constexpr int LD = NIN, KVBLK = 64, NT = 16;
constexpr int SHM_V = 16384, SHM_K = 16384, OFF_WS = 65536, OFF_TAB = 65536 + 2048;
#define KSWZ(row, colB) ((row) * 256 + ((colB) ^ (((row) & 7) << 4)))
__device__ __forceinline__ bf16x8 ld8(const bf16* p) { return *reinterpret_cast<const bf16x8*>(p); }
__device__ __forceinline__ void partialSM(f32x16& p0, f32x16& p1, float& m_reg, float& mn, float& alpha) {
  constexpr float C = SCALE * 1.4426950408889634f;
  float pmax = p0[0];
#pragma unroll
  for (int r = 1; r < 16; ++r) pmax = fmaxf(pmax, p0[r]);
#pragma unroll
  for (int r = 0; r < 16; ++r) pmax = fmaxf(pmax, p1[r]);
  { auto rr = __builtin_amdgcn_permlane32_swap(__float_as_uint(pmax), __float_as_uint(pmax), false, false);
    pmax = fmaxf(__uint_as_float(rr[0]), __uint_as_float(rr[1])); }
  if (__builtin_expect(__all(pmax - m_reg <= THR / SCALE), 1)) { mn = m_reg; alpha = 1.f; }
  else { mn = fmaxf(m_reg, pmax); alpha = __builtin_amdgcn_exp2f((m_reg - mn) * C); m_reg = mn; }
  float mnC = -mn * C;
#pragma unroll
  for (int r = 0; r < 16; ++r) p0[r] = fmaf(p0[r], C, mnC);
#pragma unroll
  for (int r = 0; r < 16; ++r) p1[r] = fmaf(p1[r], C, mnC);
#pragma unroll
  for (int r = 0; r < 16; ++r) p0[r] = __builtin_amdgcn_exp2f(p0[r]);
}
#define NA_PK4(P, BASE, OUT) do { unsigned a0 = cvtpk(P[BASE + 0], P[BASE + 1]), a1 = cvtpk(P[BASE + 2], P[BASE + 3]);   \
    unsigned b0 = cvtpk(P[BASE + 4], P[BASE + 5]), b1 = cvtpk(P[BASE + 6], P[BASE + 7]);                              \
    auto r0 = __builtin_amdgcn_permlane32_swap(a0, b0, false, false); auto r1 = __builtin_amdgcn_permlane32_swap(a1, b1, false, false); \
    v4u w = {r0[0], r1[0], r0[1], r1[1]}; OUT = *reinterpret_cast<bf16x8*>(&w); } while (0)
__device__ __forceinline__ void finishSM(f32x16& p0, f32x16& p1, float alpha, float& l_reg, bf16x8& pa0, bf16x8& pa1, bf16x8& pa2, bf16x8& pa3) {
#pragma unroll
  for (int r = 0; r < 16; ++r) p1[r] = __builtin_amdgcn_exp2f(p1[r]);
  float ps = 0;
#pragma unroll
  for (int r = 0; r < 16; ++r) ps += p0[r];
#pragma unroll
  for (int r = 0; r < 16; ++r) ps += p1[r];
  { auto rr = __builtin_amdgcn_permlane32_swap(__float_as_uint(ps), __float_as_uint(ps), false, false);
    ps = __uint_as_float(rr[0]) + __uint_as_float(rr[1]); }
  l_reg = l_reg * alpha + ps;
  NA_PK4(p0, 0, pa0); NA_PK4(p0, 8, pa1); NA_PK4(p1, 0, pa2); NA_PK4(p1, 8, pa3);
}
__device__ __forceinline__ void qkt(f32x16& p0, f32x16& p1, const bf16* Ks, const bf16x8* qr, int r32, int hi) {
  p0 = f32x16{}; p1 = f32x16{};
#pragma unroll
  for (int d0 = 0; d0 < 8; ++d0) { int cb = (d0 * 16 + hi * 8) * 2;
    bf16x8 b0 = *reinterpret_cast<const bf16x8*>((const char*)Ks + KSWZ(r32, cb));
    bf16x8 b1 = *reinterpret_cast<const bf16x8*>((const char*)Ks + KSWZ(32 + r32, cb));
    p0 = __builtin_amdgcn_mfma_f32_32x32x16_bf16(b0, qr[d0], p0, 0, 0, 0);
    p1 = __builtin_amdgcn_mfma_f32_32x32x16_bf16(b1, qr[d0], p1, 0, 0, 0); }
}
__device__ __forceinline__ int v_st(int k, int c) { const int kk = (k & ~0xC) | ((k & 4) << 1) | ((k & 8) >> 1); return ((kk >> 3) * 4 + (c >> 5)) * 512 + ((kk & 7) * 32 + (c & 31)) * 2; }
__device__ __forceinline__ int v_rd_base(int lane) { return ((lane & 3) << 3) | (((lane >> 2) & 3) << 6) | (((lane >> 4) & 1) << 5) | (((lane >> 5) & 1) << 8); }
constexpr int v_rd_off(int d0, int ks, int half) { return d0 * 512 + ks * 4096 + half * 2048; }
template <int OFF> __device__ __forceinline__ s16x4 tr_read(int vb) {
  s16x4 r; asm volatile("ds_read_b64_tr_b16 %0, %1 offset:%2" : "=&v"(r) : "v"(vb), "i"(OFF) : "memory"); return r;
}
template <int D0> __device__ __forceinline__ void pv_one(f32x16& od, int vb, bf16x8 pa0, bf16x8 pa1, bf16x8 pa2, bf16x8 pa3) {
  const s16x4 l0 = tr_read<v_rd_off(D0, 0, 0)>(vb), h0 = tr_read<v_rd_off(D0, 0, 1)>(vb), l1 = tr_read<v_rd_off(D0, 1, 0)>(vb), h1 = tr_read<v_rd_off(D0, 1, 1)>(vb);
  const s16x4 l2 = tr_read<v_rd_off(D0, 2, 0)>(vb), h2 = tr_read<v_rd_off(D0, 2, 1)>(vb), l3 = tr_read<v_rd_off(D0, 3, 0)>(vb), h3 = tr_read<v_rd_off(D0, 3, 1)>(vb);
  asm volatile("s_waitcnt lgkmcnt(0)" ::: "memory"); SBAR();
#define NA_PK(L, H) (bf16x8){L[0], L[1], L[2], L[3], H[0], H[1], H[2], H[3]}
  od = __builtin_amdgcn_mfma_f32_32x32x16_bf16(pa0, NA_PK(l0, h0), od, 0, 0, 0);
  od = __builtin_amdgcn_mfma_f32_32x32x16_bf16(pa1, NA_PK(l1, h1), od, 0, 0, 0);
  od = __builtin_amdgcn_mfma_f32_32x32x16_bf16(pa2, NA_PK(l2, h2), od, 0, 0, 0);
  od = __builtin_amdgcn_mfma_f32_32x32x16_bf16(pa3, NA_PK(l3, h3), od, 0, 0, 0);
}
__device__ __forceinline__ void pv_d0(f32x16* o, int vb, bf16x8 pa0, bf16x8 pa1, bf16x8 pa2, bf16x8 pa3) {
  pv_one<0>(o[0], vb, pa0, pa1, pa2, pa3); pv_one<1>(o[1], vb, pa0, pa1, pa2, pa3); pv_one<2>(o[2], vb, pa0, pa1, pa2, pa3); pv_one<3>(o[3], vb, pa0, pa1, pa2, pa3);
}
__device__ __forceinline__ void na_bias(f32x16& p0, f32x16& p1, int j, int kr_lo, int r, int rs, int cq, int cs, int hi, const float* tab) {
  if (j < 4) return;
  const int kr = kr_lo + j - 4; const bool inwin = (kr >= rs) && (kr < rs + 8); const float NEG = -1e30f;
  if (inwin) {
    const float* brow = tab + (kr - r + 7) * 128 + 63 - cq + 4 * hi;
    int tcs = 4 * hi - cs; asm volatile("" : "+v"(tcs));
#pragma unroll
    for (int e = 0; e < 16; ++e) { const int k0 = (e & 3) + 8 * (e >> 2); const bool v0 = (unsigned)(k0 + tcs) < 16u; p0[e] = v0 ? p0[e] + brow[k0] : NEG; }
    SBAR();
#pragma unroll
    for (int e = 0; e < 16; ++e) { const int k0 = (e & 3) + 8 * (e >> 2); const bool v1 = (unsigned)(k0 + 32 + tcs) < 16u; p1[e] = v1 ? p1[e] + brow[k0 + 32] : NEG; }
  } else {
#pragma unroll
    for (int e = 0; e < 16; ++e) { p0[e] = NEG; p1[e] = NEG; }
  }
}
__device__ __forceinline__ void na_unit(const bf16* __restrict__ QKV, bf16* __restrict__ MIX, const float* __restrict__ rpb, int b, int h, int rg, char* lds) {
  const int tid = opq((int)threadIdx.x), wid = __builtin_amdgcn_readfirstlane(tid >> 6), lane = tid & 63, r32 = lane & 31, hi = lane >> 5;
  bf16* V_lds = (bf16*)lds; bf16* K_lds = (bf16*)(lds + 2 * SHM_V);
  float* ws = (float*)(lds + OFF_WS) + wid * 64; float* li_l = ws; float* al_l = ws + 32;
  float* tab = (float*)(lds + OFF_TAB);
  for (int i = tid; i < 15 * 128; i += 512) { const int ro = i >> 7, xx = (i & 127) - 48; tab[i] = (xx >= 0 && xx <= 30) ? rpb[h * 465 + ro * 31 + xx] * (1.f / SCALE) : 0.f; }
  const int r = 4 * rg + (wid >> 1), cq = 32 * (wid & 1) + r32;
  const int rs = min(max(r - 4, 0), 56), cs = min(max(cq - 8, 0), 48), kr_lo = min(max(4 * rg - 4, 0), 52);
  const long rowc = MLAT + b * CTXL, rowl = (long)b * SEQ + kr_lo * 64;
#define NA_TROW(j) ((j) < 4 ? rowc + 64 * (j) : rowl + 64 * ((j) - 4))
  const bf16* Kh = QKV + h * 128; const bf16* Vh = QKV + 1024 + h * 128;
  float m_reg = -1e30f, l_reg = 0; f32x16 o[4] = {}; bf16x8 qr[8];
  const bf16* Qw = QKV + (long)(b * SEQ + rg * 256 + wid * 32 + r32) * LD + 4096 + h * 128 + hi * 8;
#pragma unroll
  for (int d0 = 0; d0 < 8; ++d0) qr[d0] = ld8(Qw + d0 * 16);
  const int sr = tid >> 4, sc = (tid & 15) * 8, vst0 = v_st(sr, sc), vst1 = v_st(32 + sr, sc);
  const int vb0 = (int)(uintptr_t)V_lds + v_rd_base(lane);
  struct { bf16x8 vs0, vs1, ks0, ks1; } sr_[1];
#define NA_SLOAD(i, j) do { const long t0_ = NA_TROW(j); sr_[i].vs0 = ld8(&Vh[(t0_ + sr) * LD + sc]); sr_[i].vs1 = ld8(&Vh[(t0_ + 32 + sr) * LD + sc]); \
    sr_[i].ks0 = ld8(&Kh[(t0_ + sr) * LD + sc]); sr_[i].ks1 = ld8(&Kh[(t0_ + 32 + sr) * LD + sc]); } while (0)
#define NA_SWRITE(bb, i) do { *(bf16x8*)((char*)V_lds + (bb) * SHM_V + vst0) = sr_[i].vs0;          \
    *(bf16x8*)((char*)V_lds + (bb) * SHM_V + vst1) = sr_[i].vs1; int kc = sc * 2;               \
    *(bf16x8*)((char*)K_lds + (bb) * SHM_K + KSWZ(sr, kc)) = sr_[i].ks0;                       \
    *(bf16x8*)((char*)K_lds + (bb) * SHM_K + KSWZ(32 + sr, kc)) = sr_[i].ks1; } while (0)
#define NA_SWAIT() asm volatile("s_waitcnt vmcnt(0)" ::: "memory")
#define NA_RESC(a) do { if (__any((a) < 1.f)) { if (hi == 0) al_l[r32] = (a); asm volatile("s_waitcnt lgkmcnt(0)" ::: "memory"); \
    _Pragma("unroll") for (int d = 0; d < 4; ++d) _Pragma("unroll") for (int rr_ = 0; rr_ < 16; ++rr_) o[d][rr_] *= al_l[crow(rr_, hi)]; } } while (0)
#define NA_BIAS(P0, P1, j) do { SBAR(); na_bias(P0, P1, (j), kr_lo, r, rs, cq, cs, hi, tab); SBAR(); } while (0)
  f32x16 pA0, pA1, pB0, pB1; float mnA, mnB, alA, alB; bf16x8 pa0, pa1, pa2, pa3;
  constexpr int SE = 0, SO = 0;
  NA_SLOAD(SE, 0); asm volatile("s_waitcnt vmcnt(0)" ::: "memory"); NA_SWRITE(0, SE); __syncthreads();
  qkt(pA0, pA1, K_lds, qr, r32, hi); partialSM(pA0, pA1, m_reg, mnA, alA);
  NA_SLOAD(SO, 1);
  NA_SWAIT(); NA_SWRITE(1, SO); __syncthreads();
  for (int j = 1; j + 1 < NT; j += 2) {
    SBAR(); qkt(pB0, pB1, (bf16*)((char*)K_lds + SHM_K), qr, r32, hi);
    finishSM(pA0, pA1, alA, l_reg, pa0, pa1, pa2, pa3); SBAR();
    NA_SLOAD(SO, j + 1); SBAR();
    pv_d0(o, vb0, pa0, pa1, pa2, pa3); NA_BIAS(pB0, pB1, j); partialSM(pB0, pB1, m_reg, mnB, alB);
    __syncthreads(); NA_SWAIT(); NA_SWRITE(0, SE);
    NA_RESC(alB); __syncthreads();
    SBAR(); qkt(pA0, pA1, K_lds, qr, r32, hi);
    finishSM(pB0, pB1, alB, l_reg, pa0, pa1, pa2, pa3); SBAR();
    NA_SLOAD(SE, j + 2); SBAR();
    pv_d0(o, vb0 + SHM_V, pa0, pa1, pa2, pa3); NA_BIAS(pA0, pA1, j + 1); partialSM(pA0, pA1, m_reg, mnA, alA);
    __syncthreads(); NA_SWAIT(); NA_SWRITE(1, SO);
    NA_RESC(alA); __syncthreads();
  }
  SBAR(); qkt(pB0, pB1, (bf16*)((char*)K_lds + SHM_K), qr, r32, hi);
  finishSM(pA0, pA1, alA, l_reg, pa0, pa1, pa2, pa3); SBAR();
  pv_d0(o, vb0, pa0, pa1, pa2, pa3); NA_BIAS(pB0, pB1, NT - 1); partialSM(pB0, pB1, m_reg, mnB, alB);
  __syncthreads(); NA_RESC(alB);
  finishSM(pB0, pB1, alB, l_reg, pa0, pa1, pa2, pa3); SBAR();
  pv_d0(o, vb0 + SHM_V, pa0, pa1, pa2, pa3);
  if (hi == 0) li_l[r32] = l_reg; asm volatile("s_waitcnt lgkmcnt(0)" ::: "memory");
  float rli[16];
#pragma unroll
  for (int rr_ = 0; rr_ < 16; ++rr_) rli[rr_] = __builtin_amdgcn_rcpf(li_l[crow(rr_, hi)]);
  bf16* Ow = MIX + (long)(b * SEQ + rg * 256 + wid * 32) * DM + h * 128;
#pragma unroll
  for (int rr_ = 0; rr_ < 16; ++rr_) { const int orow = crow(rr_, hi);
#pragma unroll
    for (int d0 = 0; d0 < 4; d0 += 1) { const unsigned pk = cvtpk(o[d0][rr_] * rli[rr_], 0.f); Ow[(long)orow * DM + d0 * 32 + r32] = (bf16)(pk & 0xffffu); } }
  __syncthreads();
#undef NA_SLOAD
#undef NA_SWRITE
#undef NA_SWAIT
#undef NA_RESC
#undef NA_BIAS
#undef NA_TROW
}
}

namespace ret {
typedef const LAS char* lds_cptr;
typedef short v4i16_t __attribute__((ext_vector_type(4)));
__device__ __forceinline__ s16x4 vtr(lds_cptr p) { return __builtin_bit_cast(s16x4, __builtin_amdgcn_ds_read_tr16_b64_v4i16((LAS v4i16_t*)p)); }
__device__ __forceinline__ bf16x8 tr_frag(lds_cptr base, int pitchB, int t0, int c0, int lane) {
    const int g = lane >> 4, q = (lane & 15) >> 2, p = lane & 3;
    lds_cptr a = base + (t0 + 8 * (g >> 1) + q) * pitchB + (c0 + 16 * (g & 1) + 4 * p) * 2;
    const s16x4 lo = vtr(a), hi4 = vtr(a + 4 * pitchB);
    return (bf16x8){lo[0], lo[1], lo[2], lo[3], hi4[0], hi4[1], hi4[2], hi4[3]};
}
__device__ __forceinline__ bf16x8 scale_frag8(bf16x8 a, f32x4 w0, f32x4 w1) {
    const v4u x = __builtin_bit_cast(v4u, a); v4u o;
    o.x = cvtpk(__builtin_bit_cast(float, x.x << 16) * w0.x, __builtin_bit_cast(float, x.x & 0xffff0000u) * w0.y);
    o.y = cvtpk(__builtin_bit_cast(float, x.y << 16) * w0.z, __builtin_bit_cast(float, x.y & 0xffff0000u) * w0.w);
    o.z = cvtpk(__builtin_bit_cast(float, x.z << 16) * w1.x, __builtin_bit_cast(float, x.z & 0xffff0000u) * w1.y);
    o.w = cvtpk(__builtin_bit_cast(float, x.w << 16) * w1.z, __builtin_bit_cast(float, x.w & 0xffff0000u) * w1.w);
    return __builtin_bit_cast(bf16x8, o);
}
__device__ __forceinline__ bf16x8 scale_frag1(bf16x8 a, float w) { const f32x4 w4 = {w, w, w, w}; return scale_frag8(a, w4, w4); }

constexpr int KV_PITCH = 320;
constexpr int KV_OFF_K = 0, KV_OFF_V = 128 * KV_PITCH, KV_OFF_W = 2 * 128 * KV_PITCH;
__device__ __forceinline__ void kv_item(const Ctx& C, int b, int h, int c) {
    const int TID_ = opq((int)threadIdx.x), LANE_ = TID_ & 63;
    const bf16* QKV = (const bf16*)(C.ws() + WS_QKV); float* KVB = (float*)(C.ws() + WS_KV);
    char* lds = (char*)C.lds; const int tid = TID_, lane = LANE_, wid = C.wave, r32 = lane & 31, hi = lane >> 5;
    const long rowbase = c < 2 ? (long)MLAT + b * CTXL + c * 128 : (long)b * SEQ + (c - 2) * 128;
    float* wt = (float*)(lds + KV_OFF_W);
    if (tid < 256) { const int d = tid >> 7, t = tid & 127; const float lg = log_sigmoid_f(d ? C.dec_b()[h] : C.dec_f()[h]); wt[tid] = expf(lg * (float)(d ? t : 127 - t)); }
#pragma unroll
    for (int i = 0; i < 4; ++i) { const int piece = tid + 512 * i, row = piece >> 4, cc = piece & 15;
        const bf16* src = QKV + (rowbase + row) * NIN + h * 128 + cc * 8;
        const v4u kx = *(const v4u*)(src + 2048), vx = *(const v4u*)(src + 3072);
        *(v4u*)(lds + KV_OFF_K + row * KV_PITCH + cc * 16) = kx; *(v4u*)(lds + KV_OFF_V + row * KV_PITCH + cc * 16) = vx; }
    __syncthreads();
    const lds_cptr Kb = (lds_cptr)(lds + KV_OFF_K), Vb = (lds_cptr)(lds + KV_OFF_V);
    const int dvb = wid & 3, dk0 = 2 * (wid >> 2);
    f32x16 acc[2][2] = {};
#pragma unroll
    for (int ks = 0; ks < 8; ++ks) {
        const bf16x8 a = tr_frag(Vb, KV_PITCH, 16 * ks, 32 * dvb, lane);
        const f32x4 wf0 = *(const f32x4*)(wt + 16 * ks + 8 * hi), wf1 = *(const f32x4*)(wt + 16 * ks + 8 * hi + 4);
        const f32x4 wb0 = *(const f32x4*)(wt + 128 + 16 * ks + 8 * hi), wb1 = *(const f32x4*)(wt + 128 + 16 * ks + 8 * hi + 4);
        const bf16x8 af = scale_frag8(a, wf0, wf1), ab = scale_frag8(a, wb0, wb1);
#pragma unroll
        for (int d = 0; d < 2; ++d) { const bf16x8 bk = tr_frag(Kb, KV_PITCH, 16 * ks, 32 * (dk0 + d), lane);
            acc[0][d] = __builtin_amdgcn_mfma_f32_32x32x16_bf16(af, bk, acc[0][d], 0, 0, 0);
            acc[1][d] = __builtin_amdgcn_mfma_f32_32x32x16_bf16(ab, bk, acc[1][d], 0, 0, 0); }
    }
#pragma unroll
    for (int dir = 0; dir < 2; ++dir)
#pragma unroll
        for (int d = 0; d < 2; ++d) { float* dst = KVB + ((size_t)(((b * 8 + h) * 2 + dir) * 34 + c)) * 16384 + 32 * (dk0 + d) + r32;
#pragma unroll
            for (int e = 0; e < 16; ++e) dst[(32 * dvb + crow(e, hi)) * 128] = acc[dir][d][e]; }
    __syncthreads();
}

__device__ __forceinline__ void scan_phase(const Ctx& C) {
    const int TID_ = opq((int)threadIdx.x), LANE_ = TID_ & 63;
    const float* KVB = (const float*)(C.ws() + WS_KV); bf16* ST = (bf16*)(C.ws() + WS_ST);
    for (int g = blockIdx.x * (NWAVES * 64) + TID_; g < 32 * 4096; g += C.G() * NWAVES * 64) {
        const int grp = g >> 12, e4 = g & 4095, h = (grp >> 1) & 7, dir = grp & 1;
        const float G = expf(128.0f * log_sigmoid_f(dir ? C.dec_b()[h] : C.dec_f()[h]));
        const f32x4* kv = (const f32x4*)(KVB + (size_t)grp * 34 * 16384) + e4;
        bf16* st = ST + (size_t)grp * 32 * 16384 + e4 * 4;
        f32x4 S;
        if (dir == 0) {
            S = kv[0] * G + kv[4096]; { v2u o; o.x = cvtpk(S.x, S.y); o.y = cvtpk(S.z, S.w); *(v2u*)(st) = o; }
#pragma unroll 4
            for (int n = 0; n < 31; ++n) { S = S * G + kv[(size_t)(n + 2) * 4096]; v2u o; o.x = cvtpk(S.x, S.y); o.y = cvtpk(S.z, S.w); *(v2u*)(st + (size_t)(n + 1) * 16384) = o; }
        } else {
            S = kv[0] + kv[4096] * G; { v2u o; o.x = cvtpk(S.x, S.y); o.y = cvtpk(S.z, S.w); *(v2u*)(st + (size_t)31 * 16384) = o; }
#pragma unroll 4
            for (int n = 31; n >= 1; --n) { S = S * G + kv[(size_t)(n + 2) * 4096]; v2u o; o.x = cvtpk(S.x, S.y); o.y = cvtpk(S.z, S.w); *(v2u*)(st + (size_t)(n - 1) * 16384) = o; }
        }
    }
}

constexpr int RO_OFF_K = 0, RO_OFF_V = 32768, RO_OFF_ST = 65536;
__device__ __forceinline__ void ro_item(const Ctx& C, int b, int h, int n) {
    const int TID_ = opq((int)threadIdx.x), LANE_ = TID_ & 63;
    const bf16* QKV = (const bf16*)(C.ws() + WS_QKV); const bf16* ST = (const bf16*)(C.ws() + WS_ST); bf16* MIX = (bf16*)(C.ws() + WS_MIX);
    char* lds = (char*)C.lds; const int tid = TID_, lane = LANE_, wid = C.wave, r32 = lane & 31, hi = lane >> 5;
    const long rowbase = (long)b * SEQ + n * 128;
    { const int sr = tid >> 4, sc = (tid & 15) * 8;
#pragma unroll
      for (int i = 0; i < 4; ++i) { const int row = sr + 32 * i; const bf16* src = QKV + (rowbase + row) * NIN + h * 128 + sc;
          const bf16x8 kx = *(const bf16x8*)(src + 2048), vx = *(const bf16x8*)(src + 3072);
          *(bf16x8*)(lds + RO_OFF_K + KSWZ(row, sc * 2)) = kx; *(bf16x8*)(lds + RO_OFF_V + (row >> 6) * 16384 + na::v_st(row & 63, sc)) = vx; } }
    __syncthreads();
    const int ib = wid & 3, dh = wid >> 2, iq = 32 * ib + r32;
    const float L2E = 1.4426950408889634f; const float lf2 = log_sigmoid_f(C.dec_f()[h]) * L2E, lb2 = log_sigmoid_f(C.dec_b()[h]) * L2E;
    bf16x8 qr[8];
    { const bf16* Qw = QKV + (rowbase + iq) * NIN + 5120 + h * 128 + hi * 8;
#pragma unroll
      for (int d0 = 0; d0 < 8; ++d0) qr[d0] = *(const bf16x8*)(Qw + d0 * 16); }
    f32x16 o[2] = {};
#pragma unroll
    for (int tile = 0; tile < 2; ++tile) {
        f32x16 p0 = {}, p1 = {};
        const char* Ks = lds + RO_OFF_K;
#pragma unroll
        for (int d0 = 0; d0 < 8; ++d0) { const int cb = (d0 * 16 + hi * 8) * 2;
            const bf16x8 k0 = *(const bf16x8*)(Ks + KSWZ(64 * tile + r32, cb)), k1 = *(const bf16x8*)(Ks + KSWZ(64 * tile + 32 + r32, cb));
            p0 = __builtin_amdgcn_mfma_f32_32x32x16_bf16(k0, qr[d0], p0, 0, 0, 0);
            p1 = __builtin_amdgcn_mfma_f32_32x32x16_bf16(k1, qr[d0], p1, 0, 0, 0); }
        SBAR();
        { int dbi = iq - 64 * tile - 4 * hi; asm volatile("" : "+v"(dbi)); const float dbase = (float)dbi;
#pragma unroll
          for (int e = 0; e < 16; ++e) {
            const float d0_ = dbase - (float)((e & 3) + 8 * (e >> 2)), d1_ = d0_ - 32.0f;
            float f0 = __builtin_amdgcn_exp2f(lf2 * fmaxf(d0_, 0.f) + lb2 * fmaxf(-d0_, 0.f)), f1 = __builtin_amdgcn_exp2f(lf2 * fmaxf(d1_, 0.f) + lb2 * fmaxf(-d1_, 0.f));
            f0 = fmaf(f0, fmaxf(1.0f - fabsf(d0_), 0.f), f0); f1 = fmaf(f1, fmaxf(1.0f - fabsf(d1_), 0.f), f1);
            p0[e] *= f0; p1[e] *= f1; } }
        SBAR();
        bf16x8 pa0, pa1, pa2, pa3;
        NA_PK4(p0, 0, pa0); NA_PK4(p0, 8, pa1); NA_PK4(p1, 0, pa2); NA_PK4(p1, 8, pa3);
        const int vb = (int)(uintptr_t)(lds + RO_OFF_V + tile * 16384) + na::v_rd_base(lane);
        if (dh == 0) { na::pv_one<0>(o[0], vb, pa0, pa1, pa2, pa3); na::pv_one<1>(o[1], vb, pa0, pa1, pa2, pa3); }
        else         { na::pv_one<2>(o[0], vb, pa0, pa1, pa2, pa3); na::pv_one<3>(o[1], vb, pa0, pa1, pa2, pa3); }
    }
    {
        const float cf = __builtin_amdgcn_exp2f(lf2 * (float)(iq + 1)), cb_ = __builtin_amdgcn_exp2f(lb2 * (float)(128 - iq));
        const bf16* Sf = ST + ((size_t)(((b * 8 + h) * 2 + 0) * 32 + n)) * 16384; const bf16* Sb = ST + ((size_t)(((b * 8 + h) * 2 + 1) * 32 + n)) * 16384;
#pragma unroll
        for (int ks = 0; ks < 8; ++ks) { SBAR(); const bf16x8 qf = scale_frag1(qr[ks], cf), qb = scale_frag1(qr[ks], cb_);
#pragma unroll
            for (int d = 0; d < 2; ++d) { const size_t so = (size_t)(32 * (2 * dh + d) + r32) * 128 + 16 * ks + 8 * hi;
                const bf16x8 sf = *(const bf16x8*)(Sf + so), sb = *(const bf16x8*)(Sb + so);
                o[d] = __builtin_amdgcn_mfma_f32_32x32x16_bf16(qf, sf, o[d], 0, 0, 0);
                o[d] = __builtin_amdgcn_mfma_f32_32x32x16_bf16(qb, sb, o[d], 0, 0, 0); } }
    }
    float* stats = (float*)(lds + RO_OFF_ST);
#pragma unroll
    for (int e = 0; e < 16; ++e) { float s1 = o[0][e] + o[1][e], s2 = o[0][e] * o[0][e] + o[1][e] * o[1][e];
#pragma unroll
        for (int m = 1; m < 32; m <<= 1) { s1 += __shfl_xor(s1, m); s2 += __shfl_xor(s2, m); }
        if (r32 == 0) { float* sp = stats + ((ib * 2 + dh) * 32 + crow(e, hi)) * 2; sp[0] = s1; sp[1] = s2; } }
    __syncthreads();
    const float* gnw = C.gn_w() + h * 128 + 32 * (2 * dh) + r32;
#pragma unroll
    for (int e = 0; e < 16; ++e) { const int q = crow(e, hi); const float* sa = stats + ((ib * 2 + 0) * 32 + q) * 2; const float* sb = stats + ((ib * 2 + 1) * 32 + q) * 2;
        const float mean = (sa[0] + sb[0]) * (1.0f / 128.0f), var = (sa[1] + sb[1]) * (1.0f / 128.0f) - mean * mean, rstd = 1.0f / sqrtf(fmaxf(var, 0.f) + EPS);
        const long row = rowbase + 32 * ib + q;
#pragma unroll
        for (int d = 0; d < 2; ++d) { const int dv = 32 * (2 * dh + d) + r32;
            const float gs = bf2f(QKV[row * NIN + 6144 + h * 128 + dv]);
            const float y = (o[d][e] - mean) * rstd * gnw[32 * d] * gs;
            MIX[row * DM + 1024 + h * 128 + dv] = (bf16)(cvtpk(y, 0.f) & 0xffffu); } }
    __syncthreads();
}
}

__device__ __forceinline__ void p7_rows(const Ctx& C) {
    const int TID_ = opq((int)threadIdx.x), LANE_ = TID_ & 63;
    float* wrT = (float*)C.lds;
    for (int idx = TID_; idx < DM * NEXP; idx += NWAVES * 64) wrT[(idx & 15) * DM + (idx >> 4)] = C.w_router()[idx];
    __syncthreads();
    const float* mod = (const float*)(C.ws() + WS_MOD); bf16* U2 = (bf16*)(C.ws() + WS_U); float* AFF = (float*)(C.ws() + WS_AFF);
    for (int m = C.gw(); m < MLAT; m += C.NGW()) {
        const int b = m >> 12, n = m & 4095; const float* src = C.out() + (size_t)m * DM;
        f32x4 v[8]; float s = 0.f;
#pragma unroll
        for (int j = 0; j < 8; ++j) { v[j] = ((const f32x4*)src)[LANE_ + 64 * j]; s += (v[j].x * v[j].x + v[j].y * v[j].y) + (v[j].z * v[j].z + v[j].w * v[j].w); }
        const float rstd = 1.0f / sqrtf(wave_sum(s) * (1.0f / DM) + EPS);
#pragma unroll
        for (int j = 0; j < 8; ++j) { const int col = (LANE_ + 64 * j) * 4; const f32x4 nw = *(const f32x4*)(C.nffn() + col), sh = *(const f32x4*)(mod + b * NMOD + 3 * DM + col), sc = *(const f32x4*)(mod + b * NMOD + 4 * DM + col);
            v[j] = (v[j] * rstd * nw) * (sc + 1.0f) + sh; v2u o; o.x = cvtpk(v[j].x, v[j].y); o.y = cvtpk(v[j].z, v[j].w); *(v2u*)(U2 + (size_t)m * DM + col) = o; }
        float lg[NEXP];
#pragma unroll
        for (int e = 0; e < NEXP; ++e) { float a = 0.f;
#pragma unroll
            for (int j = 0; j < 8; ++j) { const f32x4 w = *(const f32x4*)(wrT + e * DM + (LANE_ + 64 * j) * 4); a += (v[j].x * w.x + v[j].y * w.y) + (v[j].z * w.z + v[j].w * w.w); }
            lg[e] = wave_sum(a); }
        float mx = lg[0];
#pragma unroll
        for (int e = 1; e < NEXP; ++e) mx = fmaxf(mx, lg[e]);
        float sum = 0.f;
#pragma unroll
        for (int e = 0; e < NEXP; ++e) { lg[e] = expf(lg[e] - mx); sum += lg[e]; }
        const float inv = 1.0f / sum; float mine = 0.f;
#pragma unroll
        for (int e = 0; e < NEXP; ++e) mine = (LANE_ == e) ? lg[e] * inv : mine;
        if (LANE_ < NEXP) AFF[(size_t)(b * NEXP + LANE_) * SEQ + n] = mine;
    }
    __syncthreads();
}

__device__ __forceinline__ void p8_topk(const Ctx& C, int b, int e) {
    const int TID_ = opq((int)threadIdx.x), LANE_ = TID_ & 63;
    unsigned* hist = (unsigned*)C.lds;
    unsigned* scal = hist + 256; unsigned* wtot = hist + 288;
    const float* aff = (const float*)(C.ws() + WS_AFF) + (size_t)(b * NEXP + e) * SEQ;
    int* SLOT = (int*)(C.ws() + WS_SLOT) + (size_t)(b * NEXP + e) * SEQ; int* IDX = (int*)(C.ws() + WS_IDX) + (e * 2 + b) * CAP; float* GATE = (float*)(C.ws() + WS_GATE) + (e * 2 + b) * CAP;
    const int tid = TID_, base = tid * 8;
    unsigned key[8]; { const v4u a = *(const v4u*)(aff + base), c2 = *(const v4u*)(aff + base + 4); key[0] = a.x; key[1] = a.y; key[2] = a.z; key[3] = a.w; key[4] = c2.x; key[5] = c2.y; key[6] = c2.z; key[7] = c2.w; }
    unsigned prefix = 0u, remaining = CAP;
#pragma unroll
    for (int pass = 0; pass < 4; ++pass) {
        const int shift = 24 - 8 * pass;
        if (tid < 256) hist[tid] = 0u;
        __syncthreads();
#pragma unroll
        for (int i = 0; i < 8; ++i) { const bool match = (pass == 0) || ((key[i] >> (shift + 8)) == (prefix >> (shift + 8))); if (match) atomicAdd(&hist[(key[i] >> shift) & 255u], 1u); }
        __syncthreads();
        if (tid == 0) { unsigned cum = 0u; int d = 255; for (; d > 0; --d) { const unsigned hcnt = hist[d]; if (cum + hcnt >= remaining) break; cum += hcnt; } scal[0] = prefix | ((unsigned)d << shift); scal[1] = remaining - cum; }
        __syncthreads();
        prefix = scal[0]; remaining = scal[1];
        __syncthreads();
    }
    unsigned cg = 0u, ce = 0u;
#pragma unroll
    for (int i = 0; i < 8; ++i) { cg += key[i] > prefix ? 1u : 0u; ce += key[i] == prefix ? 1u : 0u; }
    unsigned pk = cg | (ce << 16), inc = pk;
#pragma unroll
    for (int o = 1; o < 64; o <<= 1) { const unsigned t = __shfl_up(inc, o); if (LANE_ >= o) inc += t; }
    if (LANE_ == 63) wtot[C.wave] = inc;
    __syncthreads();
    unsigned woff = 0u;
    for (int w = 0; w < C.wave; ++w) woff += wtot[w];
    const unsigned excl = woff + inc - pk; unsigned rg_ = excl & 0xffffu, re_ = excl >> 16;
    const unsigned ngt = CAP - remaining;
#pragma unroll
    for (int i = 0; i < 8; ++i) { int slot = -1;
        if (key[i] > prefix) { slot = (int)rg_; ++rg_; }
        else if (key[i] == prefix) { if (re_ < remaining) slot = (int)(ngt + re_); ++re_; }
        SLOT[base + i] = slot;
        if (slot >= 0) { IDX[slot] = base + i; GATE[slot] = __builtin_bit_cast(float, key[i]); } }
    __syncthreads();
}

__device__ __forceinline__ void p9_gather(const Ctx& C) {
    const int TID_ = opq((int)threadIdx.x), LANE_ = TID_ & 63;
    const bf16* U2 = (const bf16*)(C.ws() + WS_U); bf16* XE = (bf16*)(C.ws() + WS_XE); const int* IDX = (const int*)(C.ws() + WS_IDX);
    for (int R = C.gw(); R < NEXP * NB * CAP; R += C.NGW()) {
        const int b = (R >> 9) & 1; const int tok = IDX[R];
        const v4u* src = (const v4u*)(U2 + (size_t)(b * SEQ + tok) * DM) + LANE_; v4u* dst = (v4u*)(XE + (size_t)R * DM) + LANE_;
        const v4u a0 = src[0], a1 = src[64], a2 = src[128], a3 = src[192];
        dst[0] = a0; dst[64] = a1; dst[128] = a2; dst[192] = a3;
    }
}

__device__ __forceinline__ void p12_final(const Ctx& C) {
    const int TID_ = opq((int)threadIdx.x), LANE_ = TID_ & 63;
    const float* mod = (const float*)(C.ws() + WS_MOD); const bf16* YE = (const bf16*)(C.ws() + WS_YE); const int* SLOT = (const int*)(C.ws() + WS_SLOT);
    for (int m = C.gw(); m < MLAT; m += C.NGW()) {
        const int b = m >> 12, n = m & 4095; float* row = C.out() + (size_t)m * DM;
        f32x4 acc[8];
#pragma unroll
        for (int j = 0; j < 8; ++j) acc[j] = (f32x4){0.f, 0.f, 0.f, 0.f};
        for (int e = 0; e < NEXP; ++e) {
            const int s = __builtin_amdgcn_readfirstlane(SLOT[(size_t)(b * NEXP + e) * SEQ + n]);
            if (s >= 0) { const v2u* yr = (const v2u*)(YE + (size_t)((e * 2 + b) * CAP + s) * DM) + LANE_;
#pragma unroll
                for (int j = 0; j < 8; ++j) { const v2u y = yr[64 * j]; acc[j].x += __builtin_bit_cast(float, y.x << 16); acc[j].y += __builtin_bit_cast(float, y.x & 0xffff0000u); acc[j].z += __builtin_bit_cast(float, y.y << 16); acc[j].w += __builtin_bit_cast(float, y.y & 0xffff0000u); } }
        }
        f32x4 v[8]; float s2 = 0.f;
#pragma unroll
        for (int j = 0; j < 8; ++j) { const int col = (LANE_ + 64 * j) * 4; const f32x4 g5 = *(const f32x4*)(mod + b * NMOD + 5 * DM + col);
            v[j] = ((const f32x4*)row)[LANE_ + 64 * j] + g5 * acc[j]; s2 += (v[j].x * v[j].x + v[j].y * v[j].y) + (v[j].z * v[j].z + v[j].w * v[j].w); }
        const float rstd = 1.0f / sqrtf(wave_sum(s2) * (1.0f / DM) + EPS);
#pragma unroll
        for (int j = 0; j < 8; ++j) { const int col = (LANE_ + 64 * j) * 4; const f32x4 fw = *(const f32x4*)(C.fin_w() + col); ((f32x4*)row)[LANE_ + 64 * j] = v[j] * rstd * fw; }
    }
}

__global__ void __launch_bounds__(NWAVES * 64, 2) fwd_megakernel(Args args) {
    extern __shared__ __attribute__((aligned(16))) unsigned char lds[];
    Ctx C;
    C.a = &args; C.lds = lds;
    C.wave = __builtin_amdgcn_readfirstlane((int)threadIdx.x >> 6);
    volatile LAS unsigned* MISC = (volatile LAS unsigned*)((LAS unsigned char*)lds + MISC_OFF);
    for (int u = threadIdx.x; u < (LDS_BYTES - LDSCTL_OFF) / 4; u += NWAVES * 64) ((LAS unsigned*)((LAS unsigned char*)lds + LDSCTL_OFF))[u] = 0u;
    __syncthreads();
    unsigned* ctl = (unsigned*)(args.ws + WS_CTL);
    XcdBarrier bar; bar.bar = ctl + CW_BAR; bar.x = 0; bar.st = nullptr;
    if (N_LAUNCHES == 1) bar = xcd_barrier_post(ctl + CW_BAR, MISC + 8);
#define GRID_BAR() do { if (N_LAUNCHES == 1) xcd_barrier(bar); } while (0)
#ifndef PHASE_MASK
#define PHASE_MASK 0x1fff
#endif
#define IN(k) ((((PHASE_MASK) >> (k)) & 1) && args.ph_lo <= (k) && (k) < args.ph_hi)
#define BOTH(k) (IN(k) && IN((k) + 1))
    PG8_LAS unsigned char* ring = (PG8_LAS unsigned char*)lds;

    if (IN(0)) { p0_prologue(C); if (BOTH(0)) GRID_BAR(); }
    if (IN(1)) { p1_rows(C); if (BOTH(1)) GRID_BAR(); }
    if (IN(2)) {
        pg8::Gemm g{(const pg8::bf16_t*)(args.ws + WS_U), (const pg8::bf16_t*)(args.ws + WS_WIN), MALL, NIN, DM, 0, 0};
        pg8::QkvOrder S; S.init(C.G(), (int)blockIdx.x);
        pg8::EpiQKV E{(pg8::bf16_t*)(args.ws + WS_QKV), (const float*)(args.ws + WS_ROPE), (const float*)(args.ws + WS_ROPE) + 2048};
        pg8::gemm_phase<pg8::EpiQKV, pg8::QkvOrder, true, true>(ring, g, S, E);
        if (BOTH(2)) GRID_BAR();
    }
    if (IN(3)) {
#ifndef NO_NA
        for (int u = C.vcu(); u < 256; u += C.G()) { const int bh = u >> 4; na::na_unit((const bf16*)(args.ws + WS_QKV), (bf16*)(args.ws + WS_MIX), C.rpb(), bh >> 3, bh & 7, u & 15, (char*)lds); }
#endif
#ifndef NO_KV
        for (int it = C.vcu(); it < 544; it += C.G()) { const int bh = it / 34; ret::kv_item(C, bh >> 3, bh & 7, it % 34); }
#endif
        if (BOTH(3)) GRID_BAR();
    }
    if (IN(4)) { ret::scan_phase(C); if (BOTH(4)) GRID_BAR(); }
    if (IN(5)) {
        for (int it = C.vcu(); it < 512; it += C.G()) ret::ro_item(C, it >> 8, (it >> 5) & 7, it & 31);
        if (BOTH(5)) GRID_BAR();
    }
    if (IN(6)) {
        pg8::Gemm g{(const pg8::bf16_t*)(args.ws + WS_MIX), (const pg8::bf16_t*)(args.ws + WS_WOUT), MLAT, DM, DM, 0, 0};
        pg8::StaticOrder S; S.init(MLAT, DM, C.G(), (int)blockIdx.x);
        pg8::EpiOut E{C.x(), C.out(), (const float*)(args.ws + WS_MOD)};
        pg8::gemm_phase<pg8::EpiOut, pg8::StaticOrder, true, true>(ring, g, S, E);
        if (BOTH(6)) GRID_BAR();
    }
    if (IN(7)) { p7_rows(C); if (BOTH(7)) GRID_BAR(); }
    if (IN(8)) { for (int it = blockIdx.x; it < NB * NEXP; it += C.G()) p8_topk(C, it >> 4, it & 15); if (BOTH(8)) GRID_BAR(); }
    if (IN(9)) { p9_gather(C); if (BOTH(9)) GRID_BAR(); }
    if (IN(10)) {
        pg8::Gemm g{(const pg8::bf16_t*)(args.ws + WS_XE), (const pg8::bf16_t*)(args.ws + WS_WGU), NEXP * NB * CAP, 2 * FF, DM, 2, (size_t)2048 * 2048 * 2};
        pg8::StaticOrder S; S.init(NEXP * NB * CAP, 2 * FF, C.G(), (int)blockIdx.x);
        pg8::EpiGU E{(pg8::bf16_t*)(args.ws + WS_HID)};
        pg8::gemm_phase<pg8::EpiGU, pg8::StaticOrder, true, true>(ring, g, S, E);
        if (BOTH(10)) GRID_BAR();
    }
    if (IN(11)) {
        pg8::Gemm g{(const pg8::bf16_t*)(args.ws + WS_HID), (const pg8::bf16_t*)(args.ws + WS_WDN), NEXP * NB * CAP, DM, FF, 2, (size_t)2048 * 1024 * 2};
        pg8::StaticOrder S; S.init(NEXP * NB * CAP, DM, C.G(), (int)blockIdx.x);
        pg8::EpiDown E{(pg8::bf16_t*)(args.ws + WS_YE), (const float*)(args.ws + WS_GATE)};
        pg8::gemm_phase<pg8::EpiDown, pg8::StaticOrder, true, true>(ring, g, S, E);
        if (BOTH(11)) GRID_BAR();
    }
    if (IN(12)) { p12_final(C); }
#undef IN
#undef BOTH
#undef GRID_BAR
}

extern "C" void kernel_launch(void* const* d_in, const int* in_sizes, int n_in, void* d_out, int out_size, void* d_ws, size_t ws_size, hipStream_t stream) {
    static int grid = 0;
    if (grid == 0) {
        if (n_in != 19 || in_sizes[0] != MLAT * DM || out_size != MLAT * DM || ws_size < WS_END) { fprintf(stderr, "kernel_launch: built for 19 inputs, x/out of %d floats, >= %zu bytes of workspace; got n_in %d in0 %d out %d ws %zu; nothing launched\n", MLAT * DM, (size_t)WS_END, n_in, n_in > 0 ? in_sizes[0] : -1, out_size, ws_size); grid = -1; return; }
        int dev = 0, cus = 0, per_cu = 0;
        if (hipGetDevice(&dev) != hipSuccess || hipDeviceGetAttribute(&cus, hipDeviceAttributeMultiprocessorCount, dev) != hipSuccess) { fprintf(stderr, "kernel_launch: hipGetDevice / hipDeviceGetAttribute failed\n"); grid = -1; return; }
        if (hipFuncSetAttribute((const void*)fwd_megakernel, hipFuncAttributeMaxDynamicSharedMemorySize, LDS_BYTES) != hipSuccess) { fprintf(stderr, "kernel_launch: hipFuncSetAttribute(%d B LDS) failed\n", LDS_BYTES); grid = -1; return; }
        if (hipOccupancyMaxActiveBlocksPerMultiprocessor(&per_cu, (const void*)fwd_megakernel, NWAVES * 64, LDS_BYTES) != hipSuccess || per_cu < 1) { fprintf(stderr, "kernel_launch: occupancy query reports %d workgroups per CU\n", per_cu); per_cu = 1; }
        (void)hipGetLastError();
        grid = cus;
    }
    if (grid < 0) return;
    if (hipMemsetAsync((char*)d_ws + WS_CTL, 0, CTL_ZERO_BYTES, stream) != hipSuccess) { fprintf(stderr, "kernel_launch: hipMemsetAsync failed\n"); return; }
    Args a{};
    for (int i = 0; i < 19; ++i) a.in[i] = (const float*)d_in[i];
    a.out = (float*)d_out; a.ws = (unsigned char*)d_ws;
    if (N_LAUNCHES == 1) {
        a.ph_lo = 0; a.ph_hi = PER_PHASE; a.li = 0;
        void* kargs[] = {&a};
        hipError_t e = hipLaunchCooperativeKernel((const void*)fwd_megakernel, dim3(grid), dim3(NWAVES * 64), kargs, LDS_BYTES, stream);
        if (e != hipSuccess) { fprintf(stderr, "kernel_launch: cooperative launch failed: %s (grid %d)\n", hipGetErrorString(e), grid); (void)hipGetLastError(); }
    } else {
        for (int li = 0; li < PER_PHASE; ++li) { a.ph_lo = li; a.ph_hi = li + 1; a.li = li;
            hipLaunchKernelGGL(fwd_megakernel, dim3(grid), dim3(NWAVES * 64), LDS_BYTES, stream, a);
            const hipError_t le = hipPeekAtLastError(); if (le != hipSuccess) { fprintf(stderr, "kernel_launch: launch %d failed: %s\n", li, hipGetErrorName(le)); break; } }
    }
}
```

```cpp
#include <hip/hip_runtime.h>
#include <hip/hip_bf16.h>
#include <cstdio>
#include <cstdint>
#include <cmath>
#define MK_N_LAUNCHES 1
namespace pg8 {
#define PG8_LAS __attribute__((address_space(3)))
typedef unsigned short bf16_t;
typedef short bf16x8 __attribute__((ext_vector_type(8)));
typedef float f32x4 __attribute__((ext_vector_type(4)));
typedef unsigned u32x4 __attribute__((ext_vector_type(4)));
constexpr int BM = 256, BK = 64, HALF = 128, HTB = HALF * BK * 2  , STAGE_BYTES = 8 * HTB, NXCD = 8, WGM = 8;

__host__ __device__ __forceinline__ int lds_byte(int r, int c) { const int st = (r >> 4) * 2 + (c >> 5), rr = r & 15, cc = c & 31, ob = rr * 64 + cc * 2; return st * 1024 + (ob ^ (((ob >> 9) & 1) << 5)); }
__host__ __device__ __forceinline__ void stage_rc(int b, int& R, int& C) { const int st = b / 1024, sb = b % 1024, swz = sb ^ (((sb >> 9) & 1) << 5); R = (st >> 1) * 16 + swz / 64; C = (st & 1) * 32 + (swz % 64) / 2; }
__host__ __device__ __forceinline__ int perm32(int rho) { const int n = rho >> 4, i = rho & 15; return 8 * (i >> 2) + 4 * n + (i & 3); }

struct Unit { int pm, pn; };
struct Gemm { const bf16_t* A; const bf16_t* Bt; int M, N, K; int gshift; size_t gstride;
    __device__ __forceinline__ size_t bofs(int pm, int pn) const { return (size_t)(pm >> gshift) * gstride + (size_t)pn * (size_t)(256 * 2) * (size_t)K; } };

struct StaticOrder {
    int nM, nN, nwg, G, c;
    __host__ __device__ void init(int M, int N, int G_, int c_) { nM = M / BM; nN = N / BM; nwg = nM * nN; G = G_; c = c_; }
    __host__ __device__ bool next(int i, Unit& u) const {
        const long L = (long)i * G + c; if (L >= nwg) return false;
        int wgid = (int)L; { const int q = nwg / NXCD, r = nwg % NXCD, xcd = wgid % NXCD, off = wgid / NXCD; wgid = (xcd < r ? xcd * (q + 1) : r * (q + 1) + (xcd - r) * q) + off; }
        const int nig = WGM * nN, gid = wgid / nig, fm = gid * WGM, gsz = (nM - fm) < WGM ? (nM - fm) : WGM;
        u.pm = fm + ((wgid % nig) % gsz); u.pn = (wgid % nig) / gsz; return true;
    }
    __device__ __forceinline__ void a_ready(const Unit&) const {}
    __device__ __forceinline__ void done(const Unit&) const {}
};


__device__ __forceinline__ unsigned cvt_pk_bf16(float lo, float hi) { unsigned r; asm volatile("v_cvt_pk_bf16_f32 %0, %1, %2" : "=v"(r) : "v"(lo), "v"(hi)); return r; }
__device__ __forceinline__ float silu_f(float x) { return x * __builtin_amdgcn_rcpf(1.0f + __expf(-x)); }
__device__ __forceinline__ f32x4 silu4(f32x4 v) { return (f32x4){silu_f(v[0]), silu_f(v[1]), silu_f(v[2]), silu_f(v[3])}; }
__device__ __forceinline__ u32x4 pack8(f32x4 v0, f32x4 v1) { u32x4 w; w.x = cvt_pk_bf16(v0[0], v0[1]); w.y = cvt_pk_bf16(v0[2], v0[3]); w.z = cvt_pk_bf16(v1[0], v1[1]); w.w = cvt_pk_bf16(v1[2], v1[3]); return w; }

struct EpiQKV {
    static constexpr bool PERM = true, AFTER_DRAIN = false;
    bf16_t* O; const float* rc; const float* rs;
    __device__ __forceinline__ void operator()(const f32x4 (&acc)[2][2][4][2], const Unit& u, int wr, int wc, int fr, int fq) const {
        const int colt = u.pn * BM, t = colt >> 10; const bool lat = u.pm < 32;
        const int col0 = colt + wc * 32 + 8 * fq;
        const bool rope = lat && (t == 2 || t == 5);
        const int i0 = (wc & 1) * 16 + 4 * fq;
#pragma unroll
        for (int ai = 0; ai < 2; ++ai)
#pragma unroll
            for (int m = 0; m < 4; ++m) {
                const int row = u.pm * BM + ai * HALF + wr * 64 + m * 16 + fr;
                bf16_t* rowp = O + (size_t)row * 7168 + col0;
                f32x4 c4 = (f32x4){1.f, 1.f, 1.f, 1.f}, s4 = (f32x4){0.f, 0.f, 0.f, 0.f};
                if (rope) { const int tok = row & 4095; const int pos = (wc >> 1) ? (tok & 63) : (tok >> 6); c4 = *(const f32x4*)(rc + pos * 32 + i0); s4 = *(const f32x4*)(rs + pos * 32 + i0); }
#pragma unroll
                for (int bj = 0; bj < 2; ++bj) {
                    f32x4 v0 = acc[ai][bj][m][0], v1 = acc[ai][bj][m][1];
                    if (rope) { const f32x4 a = v0 * c4 - v1 * s4, b = v1 * c4 + v0 * s4; v0 = a; v1 = b; }
                    if (t == 2) { v0 = v0 * 0.08838834764831845f; v1 = v1 * 0.08838834764831845f; }
                    if (t == 6) { v0 = silu4(v0); v1 = silu4(v1); }
                    *(u32x4*)(rowp + bj * HALF) = pack8(v0, v1);
                }
            }
    }
};
struct EpiOut {
    static constexpr bool PERM = false, AFTER_DRAIN = false;
    const float* x; float* out; const float* mod;
    __device__ __forceinline__ void operator()(const f32x4 (&acc)[2][2][4][2], const Unit& u, int wr, int wc, int fr, int fq) const {
        const int b = u.pm >> 4; const float* g2 = mod + b * 12288 + 2 * 2048;
        const int col0 = u.pn * BM + wc * 32 + 4 * fq;
        f32x4 gv[2][2];
#pragma unroll
        for (int bj = 0; bj < 2; ++bj)
#pragma unroll
            for (int n = 0; n < 2; ++n) gv[bj][n] = *(const f32x4*)(g2 + col0 + bj * HALF + n * 16);
#pragma unroll
        for (int ai = 0; ai < 2; ++ai)
#pragma unroll
            for (int m = 0; m < 4; ++m) {
                const size_t off = (size_t)(u.pm * BM + ai * HALF + wr * 64 + m * 16 + fr) * 2048 + col0;
#pragma unroll
                for (int bj = 0; bj < 2; ++bj)
#pragma unroll
                    for (int n = 0; n < 2; ++n) { const f32x4 xv = *(const f32x4*)(x + off + bj * HALF + n * 16); *(f32x4*)(out + off + bj * HALF + n * 16) = xv + gv[bj][n] * acc[ai][bj][m][n]; }
            }
    }
};
struct EpiGU {
    static constexpr bool PERM = true, AFTER_DRAIN = false;
    bf16_t* H;
    __device__ __forceinline__ void operator()(const f32x4 (&acc)[2][2][4][2], const Unit& u, int wr, int wc, int fr, int fq) const {
        const int col0 = u.pn * HALF + wc * 32 + 8 * fq;
#pragma unroll
        for (int ai = 0; ai < 2; ++ai)
#pragma unroll
            for (int m = 0; m < 4; ++m) {
                const int row = u.pm * BM + ai * HALF + wr * 64 + m * 16 + fr;
                const f32x4 h0 = silu4(acc[ai][0][m][0]) * acc[ai][1][m][0], h1 = silu4(acc[ai][0][m][1]) * acc[ai][1][m][1];
                *(u32x4*)(H + (size_t)row * 1024 + col0) = pack8(h0, h1);
            }
    }
};
struct EpiDown {
    static constexpr bool PERM = true, AFTER_DRAIN = false;
    bf16_t* Y; const float* gate;
    __device__ __forceinline__ void operator()(const f32x4 (&acc)[2][2][4][2], const Unit& u, int wr, int wc, int fr, int fq) const {
        const int col0 = u.pn * BM + wc * 32 + 8 * fq;
#pragma unroll
        for (int ai = 0; ai < 2; ++ai)
#pragma unroll
            for (int m = 0; m < 4; ++m) {
                const int row = u.pm * BM + ai * HALF + wr * 64 + m * 16 + fr;
                const float gt = gate[row];
#pragma unroll
                for (int bj = 0; bj < 2; ++bj) *(u32x4*)(Y + (size_t)row * 2048 + col0 + bj * HALF) = pack8(acc[ai][bj][m][0] * gt, acc[ai][bj][m][1] * gt);
            }
    }
};
struct QkvOrder {
    StaticOrder so; int G, c;
    __host__ __device__ void init(int G_, int c_) { so.init(8192, 7168, G_, c_); G = G_; c = c_; }
    __host__ __device__ bool next(int i, Unit& u) const {
        const long L = (long)i * G + c; if (L < so.nwg) return so.next(i, u);
        const int l = (int)(L - so.nwg); if (l >= 32) return false;
        u.pm = 32 + (l & 1); u.pn = l >> 1; return true;
    }
    __device__ __forceinline__ void a_ready(const Unit&) const {}
    __device__ __forceinline__ void done(const Unit&) const {}
};
template <class Epi, class Sched, bool ALIGN_EPI = false, bool SP2 = false>
__device__ __forceinline__ void gemm_phase(PG8_LAS unsigned char* lds, const Gemm g, const Sched& S, const Epi& E) {
    int tid_ = threadIdx.x; asm volatile("" : "+v"(tid_));
    const int tid = tid_, wid = __builtin_amdgcn_readfirstlane(tid >> 6), lane = tid & 63, wr = wid >> 2, wc = wid & 3, fr = lane & 15, fq = lane >> 4;
    const int K = g.K, nt = K / BK;
    unsigned voffA[2], voffB[2];
#pragma unroll
    for (int i = 0; i < 2; ++i) { int R, C; stage_rc(tid * 16 + i * 8192, R, C); const int Rb = Epi::PERM ? ((R & ~31) + perm32(R & 31)) : R;
        voffA[i] = (unsigned)(R * K + C) * 2u; voffB[i] = (unsigned)(Rb * K + C) * 2u; }
    const size_t kstep = (size_t)(BK * 2);
    const size_t hstep = (size_t)HALF * K * 2;
    const size_t tstep = 2 * hstep;
    const unsigned ldsw = (unsigned)wid * 1024u;
    const int aoff = lds_byte(wr * 64 + fr, fq * 8), boff = lds_byte(wc * 32 + fr, fq * 8);
#define PG8_SA(b, h) (((b) * 2 + (h)) * HTB)
#define PG8_SB(b, h) ((4 + (b) * 2 + (h)) * HTB)
#define PG8_STAGE(bufoff, gbase, voff) do { _Pragma("unroll") for (int _i = 0; _i < 2; ++_i) \
        __builtin_amdgcn_global_load_lds((const unsigned*)((const char*)(gbase) + (voff)[_i]), (PG8_LAS unsigned*)(lds + (bufoff) + ldsw + _i * 8192), 16, 0, 0); } while (0)
#define PG8_LDA(dst, b, h) do { _Pragma("unroll") for (int m = 0; m < 4; ++m) _Pragma("unroll") for (int k = 0; k < 2; ++k) dst[m][k] = *(const PG8_LAS bf16x8*)(lds + PG8_SA(b, h) + aoff + m * 2048 + k * 1024); } while (0)
#define PG8_LDB(dst, b, h) do { _Pragma("unroll") for (int n = 0; n < 2; ++n) _Pragma("unroll") for (int k = 0; k < 2; ++k) dst[n][k] = *(const PG8_LAS bf16x8*)(lds + PG8_SB(b, h) + boff + n * 2048 + k * 1024); } while (0)
#define PG8_MMA(ai, bj, At, Bt) do { __builtin_amdgcn_s_setprio(1); _Pragma("unroll") for (int m = 0; m < 4; ++m) _Pragma("unroll") for (int n = 0; n < 2; ++n) _Pragma("unroll") for (int k = 0; k < 2; ++k) \
        acc[ai][bj][m][n] = __builtin_amdgcn_mfma_f32_16x16x32_bf16(Bt[n][k], At[m][k], acc[ai][bj][m][n], 0, 0, 0); __builtin_amdgcn_s_setprio(0); } while (0)
#define PG8_WAIT_V(n) asm volatile("s_waitcnt vmcnt(" #n ")" ::: "memory")
#define PG8_WAIT_L(n) asm volatile("s_waitcnt lgkmcnt(" #n ")" ::: "memory")
#define PG8_BAR __builtin_amdgcn_s_barrier()
#define PG8_SCHED __builtin_amdgcn_sched_barrier(0)
    Unit cur, nxt; int ui = 0;
    if (!S.next(0, cur)) return;
    f32x4 acc[2][2][4][2];
#pragma unroll
    for (int a = 0; a < 2; ++a)
#pragma unroll
        for (int b = 0; b < 2; ++b)
#pragma unroll
            for (int m = 0; m < 4; ++m)
#pragma unroll
                for (int n = 0; n < 2; ++n) acc[a][b][m][n] = (f32x4){0.f, 0.f, 0.f, 0.f};
    bf16x8 At[4][2], B0[2][2], B1[2][2];
    const char* cA = (const char*)g.A + (size_t)cur.pm * tstep; const char* cB = (const char*)g.Bt + g.bofs(cur.pm, cur.pn);
    S.a_ready(cur);
    if constexpr (SP2) {
        PG8_STAGE(PG8_SB(0, 0), cB, voffB); PG8_STAGE(PG8_SB(0, 1), cB + hstep, voffB); PG8_STAGE(PG8_SA(0, 0), cA, voffA); PG8_STAGE(PG8_SA(0, 1), cA + hstep, voffA);
        if (wr == 1) PG8_BAR;
        PG8_WAIT_V(2); PG8_BAR;
        PG8_STAGE(PG8_SB(1, 0), cB + kstep, voffB); PG8_STAGE(PG8_SA(1, 0), cA + kstep, voffA); PG8_STAGE(PG8_SB(1, 1), cB + hstep + kstep, voffB);
        PG8_WAIT_V(6); PG8_BAR;
    } else {
        PG8_STAGE(PG8_SB(0, 0), cB, voffB); PG8_STAGE(PG8_SA(0, 0), cA, voffA); PG8_STAGE(PG8_SB(0, 1), cB + hstep, voffB); PG8_STAGE(PG8_SA(0, 1), cA + hstep, voffA);
        if (wr == 1) PG8_BAR;
        PG8_WAIT_V(4); PG8_BAR;
        PG8_STAGE(PG8_SB(1, 0), cB + kstep, voffB); PG8_STAGE(PG8_SA(1, 0), cA + kstep, voffA); PG8_STAGE(PG8_SB(1, 1), cB + hstep + kstep, voffB);
        PG8_WAIT_V(6); PG8_BAR;
    }
    for (;;) {
        const bool has_next = S.next(ui + 1, nxt);
        const char* nA = has_next ? (const char*)g.A + (size_t)nxt.pm * tstep : cA; const char* nB = has_next ? (const char*)g.Bt + g.bofs(nxt.pm, nxt.pn) : cB;
        for (int t = 0; t < nt; t += 2) {
            const bool last = (t == nt - 2);
            const char* a1 = cA + (size_t)(t + 1) * kstep;
            const char* a2 = last ? nA : cA + (size_t)(t + 2) * kstep; const char* b2 = last ? nB : cB + (size_t)(t + 2) * kstep;
            const char* a3 = a2 + kstep; const char* b3 = b2 + kstep;
            if (last && has_next) S.a_ready(nxt);
            if constexpr (SP2) {
            PG8_LDB(B0, 0, 0); PG8_LDB(B1, 0, 1); PG8_SCHED; PG8_LDA(At, 0, 0); PG8_STAGE(PG8_SA(1, 1), a1 + hstep, voffA);
            PG8_WAIT_V(8); PG8_WAIT_L(0); PG8_BAR; PG8_MMA(0, 0, At, B0); PG8_MMA(0, 1, At, B1); PG8_BAR; PG8_SCHED;
            PG8_LDA(At, 0, 1); PG8_STAGE(PG8_SB(0, 0), b2, voffB); PG8_STAGE(PG8_SB(0, 1), b2 + hstep, voffB); PG8_STAGE(PG8_SA(0, 0), a2, voffA);
            PG8_WAIT_V(8); PG8_WAIT_L(0); PG8_BAR; PG8_MMA(1, 0, At, B0); PG8_MMA(1, 1, At, B1); PG8_BAR; PG8_SCHED;
            PG8_LDB(B0, 1, 0); PG8_LDB(B1, 1, 1); PG8_SCHED; PG8_LDA(At, 1, 0); PG8_STAGE(PG8_SA(0, 1), a2 + hstep, voffA);
            PG8_WAIT_V(8); PG8_WAIT_L(0); PG8_BAR; PG8_MMA(0, 0, At, B0); PG8_MMA(0, 1, At, B1); PG8_BAR; PG8_SCHED;
            PG8_LDA(At, 1, 1); PG8_STAGE(PG8_SB(1, 0), b3, voffB); PG8_STAGE(PG8_SB(1, 1), b3 + hstep, voffB); PG8_STAGE(PG8_SA(1, 0), a3, voffA);
            PG8_WAIT_V(8); PG8_WAIT_L(0); PG8_BAR; PG8_MMA(1, 0, At, B0); PG8_MMA(1, 1, At, B1); PG8_BAR; PG8_SCHED;
            } else {
            PG8_LDB(B0, 0, 0); PG8_SCHED; PG8_LDA(At, 0, 0); PG8_STAGE(PG8_SA(1, 1), a1 + hstep, voffA);
            PG8_WAIT_L(8); PG8_BAR; PG8_WAIT_L(0); PG8_MMA(0, 0, At, B0); PG8_BAR; PG8_SCHED;
            PG8_LDB(B1, 0, 1); PG8_STAGE(PG8_SB(0, 0), b2, voffB);
            PG8_BAR; PG8_WAIT_L(0); PG8_MMA(0, 1, At, B1); PG8_BAR;
            PG8_LDA(At, 0, 1); PG8_STAGE(PG8_SA(0, 0), a2, voffA);
            PG8_BAR; PG8_WAIT_L(0); PG8_MMA(1, 0, At, B0); PG8_BAR; PG8_SCHED;
            PG8_STAGE(PG8_SB(0, 1), b2 + hstep, voffB);
            PG8_WAIT_V(6); PG8_BAR; PG8_MMA(1, 1, At, B1); PG8_BAR;
            PG8_LDB(B0, 1, 0); PG8_SCHED; PG8_LDA(At, 1, 0); PG8_STAGE(PG8_SA(0, 1), a2 + hstep, voffA);
            PG8_WAIT_L(8); PG8_BAR; PG8_WAIT_L(0); PG8_MMA(0, 0, At, B0); PG8_BAR; PG8_SCHED;
            PG8_LDB(B1, 1, 1); PG8_STAGE(PG8_SB(1, 0), b3, voffB);
            PG8_BAR; PG8_WAIT_L(0); PG8_MMA(0, 1, At, B1); PG8_BAR;
            PG8_LDA(At, 1, 1); PG8_STAGE(PG8_SA(1, 0), a3, voffA);
            PG8_BAR; PG8_WAIT_L(0); PG8_MMA(1, 0, At, B0); PG8_BAR; PG8_SCHED;
            PG8_STAGE(PG8_SB(1, 1), b3 + hstep, voffB);
            PG8_WAIT_V(6); PG8_BAR; PG8_MMA(1, 1, At, B1); PG8_BAR;
            }
        }
        if constexpr (ALIGN_EPI) { if (wr == 0) PG8_BAR; }
        if constexpr (!Epi::AFTER_DRAIN) { E(acc, cur, wr, wc, fr, fq); S.done(cur); }
        if (!has_next) break;
#pragma unroll
        for (int a = 0; a < 2; ++a)
#pragma unroll
            for (int b = 0; b < 2; ++b)
#pragma unroll
                for (int m = 0; m < 4; ++m)
#pragma unroll
                    for (int n = 0; n < 2; ++n) acc[a][b][m][n] = (f32x4){0.f, 0.f, 0.f, 0.f};
        cur = nxt; cA = nA; cB = nB; ++ui;
        if constexpr (ALIGN_EPI) { if (wr == 1) PG8_BAR; }
    }
    PG8_WAIT_V(0);
    if constexpr (!ALIGN_EPI) { if (wr == 0) PG8_BAR; }
    PG8_BAR;
    if constexpr (Epi::AFTER_DRAIN) { E.fused(acc, cur, wr, wc, fr, fq, lds, wid, lane); S.done(cur); }
#undef PG8_SA
#undef PG8_SB
#undef PG8_STAGE
#undef PG8_LDA
#undef PG8_LDB
#undef PG8_MMA
#undef PG8_WAIT_V
#undef PG8_WAIT_L
#undef PG8_BAR
#undef PG8_SCHED
}
}

constexpr int NWAVES = 8;
#ifndef MK_N_LAUNCHES
#define MK_N_LAUNCHES 1
#endif
constexpr int PER_PHASE = 13;
constexpr int N_LAUNCHES = MK_N_LAUNCHES;

constexpr int DM = 2048, NB = 2, SEQ = 4096, CTXL = 256, NEXP = 16, FF = 1024, CAP = 512;
constexpr int MLAT = NB * SEQ, MALL = MLAT + NB * CTXL, NIN = 7168, NMOD = 6 * DM;
constexpr float EPS = 1e-6f;
constexpr int MOD_KC = 4;

constexpr size_t MiB = 1u << 20, KiB = 1u << 10;
constexpr size_t WS_CTL = 0, CTL_ZERO_BYTES = 64 * KiB;
constexpr size_t WS_MODP = 1 * MiB;
constexpr size_t WS_MOD = 2 * MiB + 512 * KiB;
constexpr size_t WS_ROPE = 2 * MiB + 768 * KiB;
constexpr size_t WS_AFF = 3 * MiB;
constexpr size_t WS_SLOT = 3 * MiB + 512 * KiB;
constexpr size_t WS_IDX = 4 * MiB, WS_GATE = 4 * MiB + 64 * KiB;
constexpr size_t WS_WIN = 8 * MiB, WS_WOUT = 36 * MiB, WS_WGU = 44 * MiB, WS_WDN = 172 * MiB;
constexpr size_t WS_U = 236 * MiB;
constexpr size_t WS_QKV = 270 * MiB;
constexpr size_t WS_XE = 270 * MiB, WS_HID = 334 * MiB;
constexpr size_t WS_MIX = 389 * MiB;
constexpr size_t WS_KV = 421 * MiB;
constexpr size_t WS_YE = 421 * MiB;
constexpr size_t WS_ST = 489 * MiB;
constexpr size_t WS_END = 521 * MiB;
constexpr int CW_BAR = 1024;

constexpr int RING_BYTES = 131072;
constexpr int LDSCTL_OFF = 143360, MISC_OFF = LDSCTL_OFF + 320;
constexpr int LDS_BYTES = 147456;

#define GAS __attribute__((address_space(1)))
#define LAS __attribute__((address_space(3)))
typedef unsigned short bf16;
typedef unsigned v4u __attribute__((ext_vector_type(4)));
typedef unsigned v2u __attribute__((ext_vector_type(2)));
typedef float f32x4 __attribute__((ext_vector_type(4)));
typedef float f32x2 __attribute__((ext_vector_type(2)));
typedef float f32x16 __attribute__((ext_vector_type(16)));
typedef short bf16x8 __attribute__((ext_vector_type(8)));
typedef short s16x4 __attribute__((ext_vector_type(4)));
#define RLX_AGENT __ATOMIC_RELAXED, __HIP_MEMORY_SCOPE_AGENT
#define LDS_WAIT() asm volatile("s_waitcnt lgkmcnt(0)" ::: "memory")
#define VM_WAIT() asm volatile("s_waitcnt vmcnt(0)" ::: "memory")
#define SBAR() __builtin_amdgcn_sched_barrier(0)
__device__ __forceinline__ unsigned cvtpk(float lo, float hi) { unsigned r; asm volatile("v_cvt_pk_bf16_f32 %0, %1, %2" : "=v"(r) : "v"(lo), "v"(hi)); return r; }
__device__ __forceinline__ float bf2f(unsigned short b) { return __builtin_bit_cast(float, (unsigned)b << 16); }
__device__ __forceinline__ float silu_f(float x) { return x / (1.0f + __expf(-x)); }
__device__ __forceinline__ float log_sigmoid_f(float x) { return -log1pf(expf(-x)); }
__device__ __forceinline__ float wave_sum(float v) {
#pragma unroll
    for (int o = 1; o < 64; o <<= 1) v += __shfl_xor(v, o);
    return v;
}
__device__ __forceinline__ int opq(int v) { asm volatile("" : "+v"(v)); return v; }
__device__ __forceinline__ int crow(int r, int hi) { return (r & 3) + 8 * (r >> 2) + 4 * hi; }

#define XB_TMO      128
#define XB_XCNT(j)  (256  + 64 * (j))
#define XB_XSUB(j)  (1280 + 64 * (j))
#define XB_XGEN(j)  (2304 + 64 * (j))
#define XB_TOP      3328
#define XB_TOPGEN   3392
#define XCD_BAR_WORDS 3456
#define XB_SPIN_CAP (1u << 18)

__device__ __forceinline__ unsigned xb_ld(unsigned* p)              { return __hip_atomic_load(p, __ATOMIC_RELAXED, __HIP_MEMORY_SCOPE_AGENT); }
__device__ __forceinline__ unsigned xb_add(unsigned* p, unsigned v) { return __hip_atomic_fetch_add(p, v, __ATOMIC_RELAXED, __HIP_MEMORY_SCOPE_AGENT); }
__device__ __forceinline__ unsigned xb_xcc_id() { return (unsigned)__builtin_amdgcn_s_getreg((3 << 11) | 20) & 0xFu; }
#define XB_SPIN(cond, bar) do { unsigned _sp = 0; while (cond) { __builtin_amdgcn_s_sleep(1); \
    if ((++_sp & 255u) == 0u) { if (xb_ld(&(bar)[XB_TMO])) break; if (_sp > XB_SPIN_CAP) { atomicAdd(&(bar)[XB_TMO], 1u); break; } } } } while (0)

struct XcdBarrier {
    unsigned* bar; unsigned x;
    volatile LAS unsigned* st;
};

__device__ __forceinline__ XcdBarrier xcd_barrier_post(unsigned* bar, volatile LAS unsigned* st) {
    XcdBarrier b; b.bar = bar; b.x = xb_xcc_id(); b.st = st;
    if (threadIdx.x == 0) (void)xb_add(&bar[XB_XCNT(b.x)], 1u);
    return b;
}
__device__ __forceinline__ void xcd_barrier_complete(unsigned* bar, unsigned x, unsigned& nloc, unsigned& nx) {
    const unsigned G = gridDim.x * gridDim.y * gridDim.z;
    unsigned sum, cnt, mine, sp = 0u;
    for (;;) {
        sum = 0u; cnt = 0u; mine = 0u;
#pragma unroll
        for (unsigned j = 0; j < 16; ++j) { const unsigned c = xb_ld(&bar[XB_XCNT(j)]); sum += c; cnt += (c > 0u) ? 1u : 0u; mine = (j == x) ? c : mine; }
        if (sum == G) break;
        __builtin_amdgcn_s_sleep(1);
        if ((++sp & 255u) == 0u) { if (xb_ld(&bar[XB_TMO])) break; if (sp > XB_SPIN_CAP) { atomicAdd(&bar[XB_TMO], 1u); break; } }
    }
    nloc = mine > 0u ? mine : 1u; nx = cnt > 0u ? cnt : 1u;
}

__device__ __forceinline__ void xcd_barrier(const XcdBarrier& b) {
    asm volatile("s_waitcnt vmcnt(0)" ::: "memory");
    __syncthreads();
    if (threadIdx.x == 0) {
        unsigned* bar = b.bar;
        __builtin_amdgcn_s_waitcnt(0);
        unsigned nloc = b.st[0], nx = b.st[1];
        if (nloc == 0u) { xcd_barrier_complete(bar, b.x, nloc, nx); b.st[0] = nloc; b.st[1] = nx; }
        const unsigned old = xb_add(&bar[XB_XSUB(b.x)], 1u);
        const unsigned gen = old / nloc;
        if (old + 1u == (gen + 1u) * nloc) {
            __builtin_amdgcn_fence(__ATOMIC_RELEASE, "agent");
            asm volatile("s_waitcnt vmcnt(0)" ::: "memory");
            const unsigned og = xb_add(&bar[XB_TOP], 1u);
            const unsigned tg = og / nx;
            if (og + 1u == (tg + 1u) * nx) xb_add(&bar[XB_TOPGEN], 1u);
            else XB_SPIN(xb_ld(&bar[XB_TOPGEN]) == tg, bar);
            __builtin_amdgcn_fence(__ATOMIC_ACQUIRE, "agent");
            xb_add(&bar[XB_XGEN(b.x)], 1u);
            asm volatile("s_waitcnt vmcnt(0)" ::: "memory");
        } else {
            XB_SPIN(xb_ld(&bar[XB_XGEN(b.x)]) == gen, bar);
            __builtin_amdgcn_fence(__ATOMIC_ACQUIRE, "agent");
            asm volatile("s_waitcnt vmcnt(0)" ::: "memory");
        }
    }
    __syncthreads();
}

struct Args { const float* in[19]; float* out; unsigned char* ws; int ph_lo, ph_hi, li, pad; };
struct Ctx {
    const Args* a; unsigned char* lds;
    int wave;
    __device__ __forceinline__ int G() const { return (int)gridDim.x; }
    __device__ __forceinline__ int vcu() const { const int g = (int)gridDim.x, bx = (int)blockIdx.x; return (g % 8 == 0) ? (bx % 8) * (g / 8) + bx / 8 : bx; }
    __device__ __forceinline__ int gw() const { return vcu() * 8 + wave; }
    __device__ __forceinline__ int NGW() const { return (int)gridDim.x * 8; }
    __device__ __forceinline__ const float* x() const { return a->in[0]; } __device__ __forceinline__ const float* c() const { return a->in[1]; } __device__ __forceinline__ const float* ctxt() const { return a->in[2]; } __device__ __forceinline__ const float* c_ctx() const { return a->in[3]; } __device__ __forceinline__ const float* w_mod() const { return a->in[4]; } __device__ __forceinline__ const float* b_mod() const { return a->in[5]; } __device__ __forceinline__ const float* nmix() const { return a->in[6]; } __device__ __forceinline__ const float* nffn() const { return a->in[7]; } __device__ __forceinline__ const float* w_in() const { return a->in[8]; } __device__ __forceinline__ const float* rpb() const { return a->in[9]; } __device__ __forceinline__ const float* dec_f() const { return a->in[10]; } __device__ __forceinline__ const float* dec_b() const { return a->in[11]; } __device__ __forceinline__ const float* gn_w() const { return a->in[12]; } __device__ __forceinline__ const float* w_out() const { return a->in[13]; } __device__ __forceinline__ const float* w_router() const { return a->in[14]; } __device__ __forceinline__ const float* w_gate() const { return a->in[15]; } __device__ __forceinline__ const float* w_up() const { return a->in[16]; } __device__ __forceinline__ const float* w_down() const { return a->in[17]; } __device__ __forceinline__ const float* fin_w() const { return a->in[18]; }
    __device__ __forceinline__ float* out() const { return a->out; } __device__ __forceinline__ unsigned char* ws() const { return a->ws; }
};

__device__ __forceinline__ void p0_modpart(const Ctx& C, int u0, int ustep) {
    const int TID_ = opq((int)threadIdx.x), LANE_ = TID_ & 63;
    float* sv = (float*)(C.lds + C.wave * 16384);
    float* modp = (float*)(C.ws() + WS_MODP);
    for (int unit = u0; unit < 96 * MOD_KC; unit += ustep) {
        const int nc = unit % 96, kc = unit / 96, n0 = nc * 128 + LANE_ * 2;
        f32x2 a0 = {0.f, 0.f}, a1 = {0.f, 0.f}, a2 = {0.f, 0.f};
        for (int sub = 0; sub < 2048 / MOD_KC / 256; ++sub) {
            const int k0 = kc * (2048 / MOD_KC) + sub * 256;
#pragma unroll
            for (int i = 0; i < 4; ++i) { const int kk = LANE_ + 64 * i, k = k0 + kk;
                sv[kk] = silu_f(C.c()[k]); sv[256 + kk] = silu_f(C.c()[2048 + k]); sv[512 + kk] = silu_f(C.c_ctx()[k]); }
            LDS_WAIT();
            const float* wp = C.w_mod() + (size_t)k0 * NMOD + n0;
#pragma unroll 16
            for (int kk = 0; kk < 256; ++kk) { const f32x2 w = *(const f32x2*)(wp + (size_t)kk * NMOD); const float s0 = sv[kk], s1 = sv[256 + kk], s2 = sv[512 + kk];
                a0 += w * s0; a1 += w * s1; a2 += w * s2; }
            LDS_WAIT();
        }
        *(f32x2*)(modp + (size_t)(kc * 3 + 0) * NMOD + n0) = a0; *(f32x2*)(modp + (size_t)(kc * 3 + 1) * NMOD + n0) = a1; *(f32x2*)(modp + (size_t)(kc * 3 + 2) * NMOD + n0) = a2;
    }
}
template <int MODE> __device__ __forceinline__ int orow_map(int n) {
    if (MODE == 1) { const int t = n >> 10; if (t == 2 || t == 5) { const int d = n & 127, a = d >> 6, nn = (d >> 5) & 1, i = d & 31; return (n & ~127) + 32 * (2 * a + (i >> 4)) + 8 * ((i >> 2) & 3) + 4 * nn + (i & 3); } return n; }
    if (MODE == 2) return (n >> 7) * 256 + (n & 127);
    if (MODE == 3) return (n >> 7) * 256 + 128 + (n & 127);
    return n;
}
template <int MODE> __device__ __forceinline__ void p0_transpose_item(const float* W, int K, int N, bf16* WT, float* scr, int item, int lane) {
    const int nblk = N / 32, kb = item / nblk, nb = item % nblk, k0 = 64 * kb, n0 = 32 * nb;
    float tv[32];
#pragma unroll
    for (int i = 0; i < 32; ++i) tv[i] = W[(size_t)(k0 + 2 * i + (lane >> 5)) * N + n0 + (lane & 31)];
#pragma unroll
    for (int i = 0; i < 32; ++i) scr[(2 * i + (lane >> 5)) * 33 + (lane & 31)] = tv[i];
    LDS_WAIT();
    const int c = lane & 7;
#pragma unroll
    for (int j = 0; j < 4; ++j) { const int n = (lane >> 3) + 8 * j; const float* s = scr + (8 * c) * 33 + n;
        v4u o; o.x = cvtpk(s[0 * 33], s[1 * 33]); o.y = cvtpk(s[2 * 33], s[3 * 33]); o.z = cvtpk(s[4 * 33], s[5 * 33]); o.w = cvtpk(s[6 * 33], s[7 * 33]);
        *(v4u*)(WT + (size_t)orow_map<MODE>(n0 + n) * K + k0 + 8 * c) = o; }
    LDS_WAIT();
}
__device__ __forceinline__ void p0_prologue(const Ctx& C) {
    const int TID_ = opq((int)threadIdx.x), LANE_ = TID_ & 63;
    const int gw = C.gw(), r16 = gw & 15, g16 = gw >> 4, n16 = C.NGW() >> 4;
    const bool host = (r16 == 0) || (r16 == 5) || (r16 == 10);
    if (host) { p0_modpart(C, g16 * 3 + r16 / 5, n16 * 3); }
    const int tw = g16 * 13 + (r16 - 1 - (r16 > 5 ? 1 : 0) - (r16 > 10 ? 1 : 0)), ntw = n16 * 13;
    float* scr = (float*)(C.lds + C.wave * 16384);
    constexpr int I_IN = 32 * 224, I_OUT = 32 * 64, I_E = 1024, I_GU = 16 * I_E;
    constexpr int NITEMS = I_IN + I_OUT + 3 * I_GU;
    bf16* WIN = (bf16*)(C.ws() + WS_WIN); bf16* WOUT = (bf16*)(C.ws() + WS_WOUT); bf16* WGU = (bf16*)(C.ws() + WS_WGU); bf16* WDN = (bf16*)(C.ws() + WS_WDN);
    if (!host)
    for (int it = tw; it < NITEMS; it += ntw) {
        int r = it;
        if (r < I_IN) { p0_transpose_item<1>(C.w_in(), 2048, NIN, WIN, scr, r, LANE_); continue; } r -= I_IN;
        if (r < I_OUT) { p0_transpose_item<0>(C.w_out(), 2048, 2048, WOUT, scr, r, LANE_); continue; } r -= I_OUT;
        if (r < I_GU) { const int e = r >> 10; p0_transpose_item<2>(C.w_gate() + (size_t)e * 2048 * 1024, 2048, 1024, WGU + (size_t)e * 2048 * 2048, scr, r & 1023, LANE_); continue; } r -= I_GU;
        if (r < I_GU) { const int e = r >> 10; p0_transpose_item<3>(C.w_up() + (size_t)e * 2048 * 1024, 2048, 1024, WGU + (size_t)e * 2048 * 2048, scr, r & 1023, LANE_); continue; } r -= I_GU;
        { const int e = r >> 10; p0_transpose_item<0>(C.w_down() + (size_t)e * 1024 * 2048, 1024, 2048, WDN + (size_t)e * 2048 * 1024, scr, r & 1023, LANE_); }
    }
    if (blockIdx.x == 0) { float* rc = (float*)(C.ws() + WS_ROPE); float* rs = rc + 2048;
        for (int i = TID_; i < 2048; i += NWAVES * 64) { const int pos = i >> 5, f = i & 31; const float inv = powf(10000.0f, -(float)(2 * f) / 64.0f); const float ang = (float)pos * inv; rc[i] = cosf(ang); rs[i] = sinf(ang); } }
}

__device__ __forceinline__ void p1_rows(const Ctx& C) {
    const int TID_ = opq((int)threadIdx.x), LANE_ = TID_ & 63;
    float* tab = (float*)C.lds;
    const float* modp = (const float*)(C.ws() + WS_MODP);
    for (int idx = TID_; idx < 3 * 4096; idx += NWAVES * 64) { const int r = idx >> 12, n = idx & 4095; float v = C.b_mod()[n];
#pragma unroll
        for (int kc = 0; kc < MOD_KC; ++kc) v += modp[(size_t)(kc * 3 + r) * NMOD + n];
        tab[idx] = v; }
    { const int g = blockIdx.x * (NWAVES * 64) + TID_; float* mod = (float*)(C.ws() + WS_MOD);
      for (int q = g; q < 3 * NMOD; q += C.G() * NWAVES * 64) { const int r = q / NMOD, n = q % NMOD; float v = C.b_mod()[n];
#pragma unroll
          for (int kc = 0; kc < MOD_KC; ++kc) v += modp[(size_t)(kc * 3 + r) * NMOD + n];
          mod[q] = v; } }
    __syncthreads();
    bf16* U = (bf16*)(C.ws() + WS_U);
    for (int m = C.gw(); m < MALL; m += C.NGW()) {
        const float* src = m < MLAT ? C.x() + (size_t)m * DM : C.ctxt() + (size_t)(m - MLAT) * DM; const int r = m < MLAT ? (m >> 12) : 2;
        f32x4 v[8]; float s = 0.f;
#pragma unroll
        for (int j = 0; j < 8; ++j) { v[j] = ((const f32x4*)src)[LANE_ + 64 * j]; s += (v[j].x * v[j].x + v[j].y * v[j].y) + (v[j].z * v[j].z + v[j].w * v[j].w); }
        const float rstd = 1.0f / sqrtf(wave_sum(s) * (1.0f / DM) + EPS);
#pragma unroll
        for (int j = 0; j < 8; ++j) { const int col = (LANE_ + 64 * j) * 4; const f32x4 nw = *(const f32x4*)(C.nmix() + col), sh = *(const f32x4*)(tab + r * 4096 + col), sc = *(const f32x4*)(tab + r * 4096 + 2048 + col);
            const f32x4 u = (v[j] * rstd * nw) * (sc + 1.0f) + sh; v2u o; o.x = cvtpk(u.x, u.y); o.y = cvtpk(u.z, u.w); *(v2u*)(U + (size_t)m * DM + col) = o; }
    }
    __syncthreads();
}

namespace na {
constexpr float SCALE = 0.088388347648318440f, THR = 8.f;
constexpr int LD = NIN, KVBLK = 64, NT = 16;
constexpr int SHM_V = 16384, SHM_K = 16384, OFF_WS = 65536, OFF_TAB = 65536 + 2048;
#define KSWZ(row, colB) ((row) * 256 + ((colB) ^ (((row) & 7) << 4)))
__device__ __forceinline__ bf16x8 ld8(const bf16* p) { return *reinterpret_cast<const bf16x8*>(p); }
__device__ __forceinline__ void partialSM(f32x16& p0, f32x16& p1, float& m_reg, float& mn, float& alpha) {
  constexpr float C = SCALE * 1.4426950408889634f;
  float pmax = p0[0];
#pragma unroll
  for (int r = 1; r < 16; ++r) pmax = fmaxf(pmax, p0[r]);
#pragma unroll
  for (int r = 0; r < 16; ++r) pmax = fmaxf(pmax, p1[r]);
  { auto rr = __builtin_amdgcn_permlane32_swap(__float_as_uint(pmax), __float_as_uint(pmax), false, false);
    pmax = fmaxf(__uint_as_float(rr[0]), __uint_as_float(rr[1])); }
  if (__builtin_expect(__all(pmax - m_reg <= THR / SCALE), 1)) { mn = m_reg; alpha = 1.f; }
  else { mn = fmaxf(m_reg, pmax); alpha = __builtin_amdgcn_exp2f((m_reg - mn) * C); m_reg = mn; }
  float mnC = -mn * C;
#pragma unroll
  for (int r = 0; r < 16; ++r) p0[r] = fmaf(p0[r], C, mnC);
#pragma unroll
  for (int r = 0; r < 16; ++r) p1[r] = fmaf(p1[r], C, mnC);
#pragma unroll
  for (int r = 0; r < 16; ++r) p0[r] = __builtin_amdgcn_exp2f(p0[r]);
}
#define NA_PK4(P, BASE, OUT) do { unsigned a0 = cvtpk(P[BASE + 0], P[BASE + 1]), a1 = cvtpk(P[BASE + 2], P[BASE + 3]);   \
    unsigned b0 = cvtpk(P[BASE + 4], P[BASE + 5]), b1 = cvtpk(P[BASE + 6], P[BASE + 7]);                              \
    auto r0 = __builtin_amdgcn_permlane32_swap(a0, b0, false, false); auto r1 = __builtin_amdgcn_permlane32_swap(a1, b1, false, false); \
    v4u w = {r0[0], r1[0], r0[1], r1[1]}; OUT = *reinterpret_cast<bf16x8*>(&w); } while (0)
__device__ __forceinline__ void finishSM(f32x16& p0, f32x16& p1, float alpha, float& l_reg, bf16x8& pa0, bf16x8& pa1, bf16x8& pa2, bf16x8& pa3) {
#pragma unroll
  for (int r = 0; r < 16; ++r) p1[r] = __builtin_amdgcn_exp2f(p1[r]);
  float ps = 0;
#pragma unroll
  for (int r = 0; r < 16; ++r) ps += p0[r];
#pragma unroll
  for (int r = 0; r < 16; ++r) ps += p1[r];
  { auto rr = __builtin_amdgcn_permlane32_swap(__float_as_uint(ps), __float_as_uint(ps), false, false);
    ps = __uint_as_float(rr[0]) + __uint_as_float(rr[1]); }
  l_reg = l_reg * alpha + ps;
  NA_PK4(p0, 0, pa0); NA_PK4(p0, 8, pa1); NA_PK4(p1, 0, pa2); NA_PK4(p1, 8, pa3);
}
__device__ __forceinline__ void qkt(f32x16& p0, f32x16& p1, const bf16* Ks, const bf16x8* qr, int r32, int hi) {
  p0 = f32x16{}; p1 = f32x16{};
#pragma unroll
  for (int d0 = 0; d0 < 8; ++d0) { int cb = (d0 * 16 + hi * 8) * 2;
    bf16x8 b0 = *reinterpret_cast<const bf16x8*>((const char*)Ks + KSWZ(r32, cb));
    bf16x8 b1 = *reinterpret_cast<const bf16x8*>((const char*)Ks + KSWZ(32 + r32, cb));
    p0 = __builtin_amdgcn_mfma_f32_32x32x16_bf16(b0, qr[d0], p0, 0, 0, 0);
    p1 = __builtin_amdgcn_mfma_f32_32x32x16_bf16(b1, qr[d0], p1, 0, 0, 0); }
}
__device__ __forceinline__ int v_st(int k, int c) { const int kk = (k & ~0xC) | ((k & 4) << 1) | ((k & 8) >> 1); return ((kk >> 3) * 4 + (c >> 5)) * 512 + ((kk & 7) * 32 + (c & 31)) * 2; }
__device__ __forceinline__ int v_rd_base(int lane) { return ((lane & 3) << 3) | (((lane >> 2) & 3) << 6) | (((lane >> 4) & 1) << 5) | (((lane >> 5) & 1) << 8); }
constexpr int v_rd_off(int d0, int ks, int half) { return d0 * 512 + ks * 4096 + half * 2048; }
template <int OFF> __device__ __forceinline__ s16x4 tr_read(int vb) {
  s16x4 r; asm volatile("ds_read_b64_tr_b16 %0, %1 offset:%2" : "=&v"(r) : "v"(vb), "i"(OFF) : "memory"); return r;
}
template <int D0> __device__ __forceinline__ void pv_one(f32x16& od, int vb, bf16x8 pa0, bf16x8 pa1, bf16x8 pa2, bf16x8 pa3) {
  const s16x4 l0 = tr_read<v_rd_off(D0, 0, 0)>(vb), h0 = tr_read<v_rd_off(D0, 0, 1)>(vb), l1 = tr_read<v_rd_off(D0, 1, 0)>(vb), h1 = tr_read<v_rd_off(D0, 1, 1)>(vb);
  const s16x4 l2 = tr_read<v_rd_off(D0, 2, 0)>(vb), h2 = tr_read<v_rd_off(D0, 2, 1)>(vb), l3 = tr_read<v_rd_off(D0, 3, 0)>(vb), h3 = tr_read<v_rd_off(D0, 3, 1)>(vb);
  asm volatile("s_waitcnt lgkmcnt(0)" ::: "memory"); SBAR();
#define NA_PK(L, H) (bf16x8){L[0], L[1], L[2], L[3], H[0], H[1], H[2], H[3]}
  od = __builtin_amdgcn_mfma_f32_32x32x16_bf16(pa0, NA_PK(l0, h0), od, 0, 0, 0);
  od = __builtin_amdgcn_mfma_f32_32x32x16_bf16(pa1, NA_PK(l1, h1), od, 0, 0, 0);
  od = __builtin_amdgcn_mfma_f32_32x32x16_bf16(pa2, NA_PK(l2, h2), od, 0, 0, 0);
  od = __builtin_amdgcn_mfma_f32_32x32x16_bf16(pa3, NA_PK(l3, h3), od, 0, 0, 0);
}
__device__ __forceinline__ void pv_d0(f32x16* o, int vb, bf16x8 pa0, bf16x8 pa1, bf16x8 pa2, bf16x8 pa3) {
  pv_one<0>(o[0], vb, pa0, pa1, pa2, pa3); pv_one<1>(o[1], vb, pa0, pa1, pa2, pa3); pv_one<2>(o[2], vb, pa0, pa1, pa2, pa3); pv_one<3>(o[3], vb, pa0, pa1, pa2, pa3);
}
__device__ __forceinline__ void na_bias(f32x16& p0, f32x16& p1, int j, int kr_lo, int r, int rs, int cq, int cs, int hi, const float* tab) {
  if (j < 4) return;
  const int kr = kr_lo + j - 4; const bool inwin = (kr >= rs) && (kr < rs + 8); const float NEG = -1e30f;
  if (inwin) {
    const float* brow = tab + (kr - r + 7) * 128 + 63 - cq + 4 * hi;
    int tcs = 4 * hi - cs; asm volatile("" : "+v"(tcs));
#pragma unroll
    for (int e = 0; e < 16; ++e) { const int k0 = (e & 3) + 8 * (e >> 2); const bool v0 = (unsigned)(k0 + tcs) < 16u; p0[e] = v0 ? p0[e] + brow[k0] : NEG; }
    SBAR();
#pragma unroll
    for (int e = 0; e < 16; ++e) { const int k0 = (e & 3) + 8 * (e >> 2); const bool v1 = (unsigned)(k0 + 32 + tcs) < 16u; p1[e] = v1 ? p1[e] + brow[k0 + 32] : NEG; }
  } else {
#pragma unroll
    for (int e = 0; e < 16; ++e) { p0[e] = NEG; p1[e] = NEG; }
  }
}
__device__ __forceinline__ void na_unit(const bf16* __restrict__ QKV, bf16* __restrict__ MIX, const float* __restrict__ rpb, int b, int h, int rg, char* lds) {
  const int tid = opq((int)threadIdx.x), wid = __builtin_amdgcn_readfirstlane(tid >> 6), lane = tid & 63, r32 = lane & 31, hi = lane >> 5;
  bf16* V_lds = (bf16*)lds; bf16* K_lds = (bf16*)(lds + 2 * SHM_V);
  float* ws = (float*)(lds + OFF_WS) + wid * 64; float* li_l = ws; float* al_l = ws + 32;
  float* tab = (float*)(lds + OFF_TAB);
  for (int i = tid; i < 15 * 128; i += 512) { const int ro = i >> 7, xx = (i & 127) - 48; tab[i] = (xx >= 0 && xx <= 30) ? rpb[h * 465 + ro * 31 + xx] * (1.f / SCALE) : 0.f; }
  const int r = 4 * rg + (wid >> 1), cq = 32 * (wid & 1) + r32;
  const int rs = min(max(r - 4, 0), 56), cs = min(max(cq - 8, 0), 48), kr_lo = min(max(4 * rg - 4, 0), 52);
  const long rowc = MLAT + b * CTXL, rowl = (long)b * SEQ + kr_lo * 64;
#define NA_TROW(j) ((j) < 4 ? rowc + 64 * (j) : rowl + 64 * ((j) - 4))
  const bf16* Kh = QKV + h * 128; const bf16* Vh = QKV + 1024 + h * 128;
  float m_reg = -1e30f, l_reg = 0; f32x16 o[4] = {}; bf16x8 qr[8];
  const bf16* Qw = QKV + (long)(b * SEQ + rg * 256 + wid * 32 + r32) * LD + 4096 + h * 128 + hi * 8;
#pragma unroll
  for (int d0 = 0; d0 < 8; ++d0) qr[d0] = ld8(Qw + d0 * 16);
  const int sr = tid >> 4, sc = (tid & 15) * 8, vst0 = v_st(sr, sc), vst1 = v_st(32 + sr, sc);
  const int vb0 = (int)(uintptr_t)V_lds + v_rd_base(lane);
  struct { bf16x8 vs0, vs1, ks0, ks1; } sr_[1];
#define NA_SLOAD(i, j) do { const long t0_ = NA_TROW(j); sr_[i].vs0 = ld8(&Vh[(t0_ + sr) * LD + sc]); sr_[i].vs1 = ld8(&Vh[(t0_ + 32 + sr) * LD + sc]); \
    sr_[i].ks0 = ld8(&Kh[(t0_ + sr) * LD + sc]); sr_[i].ks1 = ld8(&Kh[(t0_ + 32 + sr) * LD + sc]); } while (0)
#define NA_SWRITE(bb, i) do { *(bf16x8*)((char*)V_lds + (bb) * SHM_V + vst0) = sr_[i].vs0;          \
    *(bf16x8*)((char*)V_lds + (bb) * SHM_V + vst1) = sr_[i].vs1; int kc = sc * 2;               \
    *(bf16x8*)((char*)K_lds + (bb) * SHM_K + KSWZ(sr, kc)) = sr_[i].ks0;                       \
    *(bf16x8*)((char*)K_lds + (bb) * SHM_K + KSWZ(32 + sr, kc)) = sr_[i].ks1; } while (0)
#define NA_SWAIT() asm volatile("s_waitcnt vmcnt(0)" ::: "memory")
#define NA_RESC(a) do { if (__any((a) < 1.f)) { if (hi == 0) al_l[r32] = (a); asm volatile("s_waitcnt lgkmcnt(0)" ::: "memory"); \
    _Pragma("unroll") for (int d = 0; d < 4; ++d) _Pragma("unroll") for (int rr_ = 0; rr_ < 16; ++rr_) o[d][rr_] *= al_l[crow(rr_, hi)]; } } while (0)
#define NA_BIAS(P0, P1, j) do { SBAR(); na_bias(P0, P1, (j), kr_lo, r, rs, cq, cs, hi, tab); SBAR(); } while (0)
  f32x16 pA0, pA1, pB0, pB1; float mnA, mnB, alA, alB; bf16x8 pa0, pa1, pa2, pa3;
  constexpr int SE = 0, SO = 0;
  NA_SLOAD(SE, 0); asm volatile("s_waitcnt vmcnt(0)" ::: "memory"); NA_SWRITE(0, SE); __syncthreads();
  qkt(pA0, pA1, K_lds, qr, r32, hi); partialSM(pA0, pA1, m_reg, mnA, alA);
  NA_SLOAD(SO, 1);
  NA_SWAIT(); NA_SWRITE(1, SO); __syncthreads();
  for (int j = 1; j + 1 < NT; j += 2) {
    SBAR(); qkt(pB0, pB1, (bf16*)((char*)K_lds + SHM_K), qr, r32, hi);
    finishSM(pA0, pA1, alA, l_reg, pa0, pa1, pa2, pa3); SBAR();
    NA_SLOAD(SO, j + 1); SBAR();
    pv_d0(o, vb0, pa0, pa1, pa2, pa3); NA_BIAS(pB0, pB1, j); partialSM(pB0, pB1, m_reg, mnB, alB);
    __syncthreads(); NA_SWAIT(); NA_SWRITE(0, SE);
    NA_RESC(alB); __syncthreads();
    SBAR(); qkt(pA0, pA1, K_lds, qr, r32, hi);
    finishSM(pB0, pB1, alB, l_reg, pa0, pa1, pa2, pa3); SBAR();
    NA_SLOAD(SE, j + 2); SBAR();
    pv_d0(o, vb0 + SHM_V, pa0, pa1, pa2, pa3); NA_BIAS(pA0, pA1, j + 1); partialSM(pA0, pA1, m_reg, mnA, alA);
    __syncthreads(); NA_SWAIT(); NA_SWRITE(1, SO);
    NA_RESC(alA); __syncthreads();
  }
  SBAR(); qkt(pB0, pB1, (bf16*)((char*)K_lds + SHM_K), qr, r32, hi);
  finishSM(pA0, pA1, alA, l_reg, pa0, pa1, pa2, pa3); SBAR();
  pv_d0(o, vb0, pa0, pa1, pa2, pa3); NA_BIAS(pB0, pB1, NT - 1); partialSM(pB0, pB1, m_reg, mnB, alB);
  __syncthreads(); NA_RESC(alB);
  finishSM(pB0, pB1, alB, l_reg, pa0, pa1, pa2, pa3); SBAR();
  pv_d0(o, vb0 + SHM_V, pa0, pa1, pa2, pa3);
  if (hi == 0) li_l[r32] = l_reg; asm volatile("s_waitcnt lgkmcnt(0)" ::: "memory");
  float rli[16];
#pragma unroll
  for (int rr_ = 0; rr_ < 16; ++rr_) rli[rr_] = __builtin_amdgcn_rcpf(li_l[crow(rr_, hi)]);
  bf16* Ow = MIX + (long)(b * SEQ + rg * 256 + wid * 32) * DM + h * 128;
#pragma unroll
  for (int rr_ = 0; rr_ < 16; ++rr_) { const int orow = crow(rr_, hi);
#pragma unroll
    for (int d0 = 0; d0 < 4; d0 += 1) { const unsigned pk = cvtpk(o[d0][rr_] * rli[rr_], 0.f); Ow[(long)orow * DM + d0 * 32 + r32] = (bf16)(pk & 0xffffu); } }
  __syncthreads();
#undef NA_SLOAD
#undef NA_SWRITE
#undef NA_SWAIT
#undef NA_RESC
#undef NA_BIAS
#undef NA_TROW
}
}

namespace ret {
typedef const LAS char* lds_cptr;
typedef short v4i16_t __attribute__((ext_vector_type(4)));
__device__ __forceinline__ s16x4 vtr(lds_cptr p) { return __builtin_bit_cast(s16x4, __builtin_amdgcn_ds_read_tr16_b64_v4i16((LAS v4i16_t*)p)); }
__device__ __forceinline__ bf16x8 tr_frag(lds_cptr base, int pitchB, int t0, int c0, int lane) {
    const int g = lane >> 4, q = (lane & 15) >> 2, p = lane & 3;
    lds_cptr a = base + (t0 + 8 * (g >> 1) + q) * pitchB + (c0 + 16 * (g & 1) + 4 * p) * 2;
    const s16x4 lo = vtr(a), hi4 = vtr(a + 4 * pitchB);
    return (bf16x8){lo[0], lo[1], lo[2], lo[3], hi4[0], hi4[1], hi4[2], hi4[3]};
}
__device__ __forceinline__ bf16x8 scale_frag8(bf16x8 a, f32x4 w0, f32x4 w1) {
    const v4u x = __builtin_bit_cast(v4u, a); v4u o;
    o.x = cvtpk(__builtin_bit_cast(float, x.x << 16) * w0.x, __builtin_bit_cast(float, x.x & 0xffff0000u) * w0.y);
    o.y = cvtpk(__builtin_bit_cast(float, x.y << 16) * w0.z, __builtin_bit_cast(float, x.y & 0xffff0000u) * w0.w);
    o.z = cvtpk(__builtin_bit_cast(float, x.z << 16) * w1.x, __builtin_bit_cast(float, x.z & 0xffff0000u) * w1.y);
    o.w = cvtpk(__builtin_bit_cast(float, x.w << 16) * w1.z, __builtin_bit_cast(float, x.w & 0xffff0000u) * w1.w);
    return __builtin_bit_cast(bf16x8, o);
}
__device__ __forceinline__ bf16x8 scale_frag1(bf16x8 a, float w) { const f32x4 w4 = {w, w, w, w}; return scale_frag8(a, w4, w4); }

constexpr int KV_PITCH = 320;
constexpr int KV_OFF_K = 0, KV_OFF_V = 128 * KV_PITCH, KV_OFF_W = 2 * 128 * KV_PITCH;
__device__ __forceinline__ void kv_item(const Ctx& C, int b, int h, int c) {
    const int TID_ = opq((int)threadIdx.x), LANE_ = TID_ & 63;
    const bf16* QKV = (const bf16*)(C.ws() + WS_QKV); float* KVB = (float*)(C.ws() + WS_KV);
    char* lds = (char*)C.lds; const int tid = TID_, lane = LANE_, wid = C.wave, r32 = lane & 31, hi = lane >> 5;
    const long rowbase = c < 2 ? (long)MLAT + b * CTXL + c * 128 : (long)b * SEQ + (c - 2) * 128;
    float* wt = (float*)(lds + KV_OFF_W);
    if (tid < 256) { const int d = tid >> 7, t = tid & 127; const float lg = log_sigmoid_f(d ? C.dec_b()[h] : C.dec_f()[h]); wt[tid] = expf(lg * (float)(d ? t : 127 - t)); }
#pragma unroll
    for (int i = 0; i < 4; ++i) { const int piece = tid + 512 * i, row = piece >> 4, cc = piece & 15;
        const bf16* src = QKV + (rowbase + row) * NIN + h * 128 + cc * 8;
        const v4u kx = *(const v4u*)(src + 2048), vx = *(const v4u*)(src + 3072);
        *(v4u*)(lds + KV_OFF_K + row * KV_PITCH + cc * 16) = kx; *(v4u*)(lds + KV_OFF_V + row * KV_PITCH + cc * 16) = vx; }
    __syncthreads();
    const lds_cptr Kb = (lds_cptr)(lds + KV_OFF_K), Vb = (lds_cptr)(lds + KV_OFF_V);
    const int dvb = wid & 3, dk0 = 2 * (wid >> 2);
    f32x16 acc[2][2] = {};
#pragma unroll
    for (int ks = 0; ks < 8; ++ks) {
        const bf16x8 a = tr_frag(Vb, KV_PITCH, 16 * ks, 32 * dvb, lane);
        const f32x4 wf0 = *(const f32x4*)(wt + 16 * ks + 8 * hi), wf1 = *(const f32x4*)(wt + 16 * ks + 8 * hi + 4);
        const f32x4 wb0 = *(const f32x4*)(wt + 128 + 16 * ks + 8 * hi), wb1 = *(const f32x4*)(wt + 128 + 16 * ks + 8 * hi + 4);
        const bf16x8 af = scale_frag8(a, wf0, wf1), ab = scale_frag8(a, wb0, wb1);
#pragma unroll
        for (int d = 0; d < 2; ++d) { const bf16x8 bk = tr_frag(Kb, KV_PITCH, 16 * ks, 32 * (dk0 + d), lane);
            acc[0][d] = __builtin_amdgcn_mfma_f32_32x32x16_bf16(af, bk, acc[0][d], 0, 0, 0);
            acc[1][d] = __builtin_amdgcn_mfma_f32_32x32x16_bf16(ab, bk, acc[1][d], 0, 0, 0); }
    }
#pragma unroll
    for (int dir = 0; dir < 2; ++dir)
#pragma unroll
        for (int d = 0; d < 2; ++d) { float* dst = KVB + ((size_t)(((b * 8 + h) * 2 + dir) * 34 + c)) * 16384 + 32 * (dk0 + d) + r32;
#pragma unroll
            for (int e = 0; e < 16; ++e) dst[(32 * dvb + crow(e, hi)) * 128] = acc[dir][d][e]; }
    __syncthreads();
}

__device__ __forceinline__ void scan_phase(const Ctx& C) {
    const int TID_ = opq((int)threadIdx.x), LANE_ = TID_ & 63;
    const float* KVB = (const float*)(C.ws() + WS_KV); bf16* ST = (bf16*)(C.ws() + WS_ST);
    for (int g = blockIdx.x * (NWAVES * 64) + TID_; g < 32 * 4096; g += C.G() * NWAVES * 64) {
        const int grp = g >> 12, e4 = g & 4095, h = (grp >> 1) & 7, dir = grp & 1;
        const float G = expf(128.0f * log_sigmoid_f(dir ? C.dec_b()[h] : C.dec_f()[h]));
        const f32x4* kv = (const f32x4*)(KVB + (size_t)grp * 34 * 16384) + e4;
        bf16* st = ST + (size_t)grp * 32 * 16384 + e4 * 4;
        f32x4 S;
        if (dir == 0) {
            S = kv[0] * G + kv[4096]; { v2u o; o.x = cvtpk(S.x, S.y); o.y = cvtpk(S.z, S.w); *(v2u*)(st) = o; }
#pragma unroll 4
            for (int n = 0; n < 31; ++n) { S = S * G + kv[(size_t)(n + 2) * 4096]; v2u o; o.x = cvtpk(S.x, S.y); o.y = cvtpk(S.z, S.w); *(v2u*)(st + (size_t)(n + 1) * 16384) = o; }
        } else {
            S = kv[0] + kv[4096] * G; { v2u o; o.x = cvtpk(S.x, S.y); o.y = cvtpk(S.z, S.w); *(v2u*)(st + (size_t)31 * 16384) = o; }
#pragma unroll 4
            for (int n = 31; n >= 1; --n) { S = S * G + kv[(size_t)(n + 2) * 4096]; v2u o; o.x = cvtpk(S.x, S.y); o.y = cvtpk(S.z, S.w); *(v2u*)(st + (size_t)(n - 1) * 16384) = o; }
        }
    }
}

constexpr int RO_OFF_K = 0, RO_OFF_V = 32768, RO_OFF_SF = 65536, RO_OFF_SB = 98304, RO_OFF_ST = 131072;
__device__ __forceinline__ void ro_item(const Ctx& C, int b, int h, int n) {
    const int TID_ = opq((int)threadIdx.x), LANE_ = TID_ & 63;
    const bf16* QKV = (const bf16*)(C.ws() + WS_QKV); const bf16* ST = (const bf16*)(C.ws() + WS_ST); bf16* MIX = (bf16*)(C.ws() + WS_MIX);
    char* lds = (char*)C.lds; const int tid = TID_, lane = LANE_, wid = C.wave, r32 = lane & 31, hi = lane >> 5;
    const long rowbase = (long)b * SEQ + n * 128;
    { const int sr = tid >> 4, sc = (tid & 15) * 8;
#pragma unroll
      for (int i = 0; i < 4; ++i) { const int row = sr + 32 * i; const bf16* src = QKV + (rowbase + row) * NIN + h * 128 + sc;
          const bf16x8 kx = *(const bf16x8*)(src + 2048), vx = *(const bf16x8*)(src + 3072);
          *(bf16x8*)(lds + RO_OFF_K + KSWZ(row, sc * 2)) = kx; *(bf16x8*)(lds + RO_OFF_V + (row >> 6) * 16384 + na::v_st(row & 63, sc)) = vx; }
      const bf16* Sf = ST + ((size_t)(((b * 8 + h) * 2 + 0) * 32 + n)) * 16384; const bf16* Sb = ST + ((size_t)(((b * 8 + h) * 2 + 1) * 32 + n)) * 16384;
#pragma unroll
      for (int i = 0; i < 4; ++i) { const int row = sr + 32 * i; const bf16x8 fx = *(const bf16x8*)(Sf + row * 128 + sc), bx = *(const bf16x8*)(Sb + row * 128 + sc);
          *(bf16x8*)(lds + RO_OFF_SF + KSWZ(row, sc * 2)) = fx; *(bf16x8*)(lds + RO_OFF_SB + KSWZ(row, sc * 2)) = bx; } }
    __syncthreads();
    const int ib = wid & 3, dh = wid >> 2, iq = 32 * ib + r32;
    const float L2E = 1.4426950408889634f; const float lf2 = log_sigmoid_f(C.dec_f()[h]) * L2E, lb2 = log_sigmoid_f(C.dec_b()[h]) * L2E;
    bf16x8 qr[8];
    { const bf16* Qw = QKV + (rowbase + iq) * NIN + 5120 + h * 128 + hi * 8;
#pragma unroll
      for (int d0 = 0; d0 < 8; ++d0) qr[d0] = *(const bf16x8*)(Qw + d0 * 16); }
    f32x16 o[2] = {};
#pragma unroll
    for (int tile = 0; tile < 2; ++tile) {
        f32x16 p0 = {}, p1 = {};
        const char* Ks = lds + RO_OFF_K;
#pragma unroll
        for (int d0 = 0; d0 < 8; ++d0) { const int cb = (d0 * 16 + hi * 8) * 2;
            const bf16x8 k0 = *(const bf16x8*)(Ks + KSWZ(64 * tile + r32, cb)), k1 = *(const bf16x8*)(Ks + KSWZ(64 * tile + 32 + r32, cb));
            p0 = __builtin_amdgcn_mfma_f32_32x32x16_bf16(k0, qr[d0], p0, 0, 0, 0);
            p1 = __builtin_amdgcn_mfma_f32_32x32x16_bf16(k1, qr[d0], p1, 0, 0, 0); }
        SBAR();
        { int dbi = iq - 64 * tile - 4 * hi; asm volatile("" : "+v"(dbi)); const float dbase = (float)dbi;
#pragma unroll
          for (int e = 0; e < 16; ++e) {
            const float d0_ = dbase - (float)((e & 3) + 8 * (e >> 2)), d1_ = d0_ - 32.0f;
            float f0 = __builtin_amdgcn_exp2f(lf2 * fmaxf(d0_, 0.f) + lb2 * fmaxf(-d0_, 0.f)), f1 = __builtin_amdgcn_exp2f(lf2 * fmaxf(d1_, 0.f) + lb2 * fmaxf(-d1_, 0.f));
            f0 = fmaf(f0, fmaxf(1.0f - fabsf(d0_), 0.f), f0); f1 = fmaf(f1, fmaxf(1.0f - fabsf(d1_), 0.f), f1);
            p0[e] *= f0; p1[e] *= f1; } }
        SBAR();
        bf16x8 pa0, pa1, pa2, pa3;
        NA_PK4(p0, 0, pa0); NA_PK4(p0, 8, pa1); NA_PK4(p1, 0, pa2); NA_PK4(p1, 8, pa3);
        const int vb = (int)(uintptr_t)(lds + RO_OFF_V + tile * 16384) + na::v_rd_base(lane);
        if (dh == 0) { na::pv_one<0>(o[0], vb, pa0, pa1, pa2, pa3); na::pv_one<1>(o[1], vb, pa0, pa1, pa2, pa3); }
        else         { na::pv_one<2>(o[0], vb, pa0, pa1, pa2, pa3); na::pv_one<3>(o[1], vb, pa0, pa1, pa2, pa3); }
    }
    {
        const float cf = __builtin_amdgcn_exp2f(lf2 * (float)(iq + 1)), cb_ = __builtin_amdgcn_exp2f(lb2 * (float)(128 - iq));
#pragma unroll
        for (int ks = 0; ks < 8; ++ks) { const bf16x8 qf = scale_frag1(qr[ks], cf), qb = scale_frag1(qr[ks], cb_);
#pragma unroll
            for (int d = 0; d < 2; ++d) { const int so = KSWZ(32 * (2 * dh + d) + r32, (16 * ks + 8 * hi) * 2);
                const bf16x8 sf = *(const bf16x8*)(lds + RO_OFF_SF + so), sb = *(const bf16x8*)(lds + RO_OFF_SB + so);
                o[d] = __builtin_amdgcn_mfma_f32_32x32x16_bf16(qf, sf, o[d], 0, 0, 0);
                o[d] = __builtin_amdgcn_mfma_f32_32x32x16_bf16(qb, sb, o[d], 0, 0, 0); } }
    }
    float* stats = (float*)(lds + RO_OFF_ST);
#pragma unroll
    for (int e = 0; e < 16; ++e) { float s1 = o[0][e] + o[1][e], s2 = o[0][e] * o[0][e] + o[1][e] * o[1][e];
#pragma unroll
        for (int m = 1; m < 32; m <<= 1) { s1 += __shfl_xor(s1, m); s2 += __shfl_xor(s2, m); }
        if (r32 == 0) { float* sp = stats + ((ib * 2 + dh) * 32 + crow(e, hi)) * 2; sp[0] = s1; sp[1] = s2; } }
    __syncthreads();
    const float* gnw = C.gn_w() + h * 128 + 32 * (2 * dh) + r32;
#pragma unroll
    for (int e = 0; e < 16; ++e) { const int q = crow(e, hi); const float* sa = stats + ((ib * 2 + 0) * 32 + q) * 2; const float* sb = stats + ((ib * 2 + 1) * 32 + q) * 2;
        const float mean = (sa[0] + sb[0]) * (1.0f / 128.0f), var = (sa[1] + sb[1]) * (1.0f / 128.0f) - mean * mean, rstd = 1.0f / sqrtf(fmaxf(var, 0.f) + EPS);
        const long row = rowbase + 32 * ib + q;
#pragma unroll
        for (int d = 0; d < 2; ++d) { const int dv = 32 * (2 * dh + d) + r32;
            const float gs = bf2f(QKV[row * NIN + 6144 + h * 128 + dv]);
            const float y = (o[d][e] - mean) * rstd * gnw[32 * d] * gs;
            MIX[row * DM + 1024 + h * 128 + dv] = (bf16)(cvtpk(y, 0.f) & 0xffffu); } }
    __syncthreads();
}
}

__device__ __forceinline__ void p7_rows(const Ctx& C) {
    const int TID_ = opq((int)threadIdx.x), LANE_ = TID_ & 63;
    float* wrT = (float*)C.lds;
    { f32x4 wv[16];
#pragma unroll
      for (int i = 0; i < 16; ++i) wv[i] = ((const f32x4*)C.w_router())[TID_ + 512 * i];
#pragma unroll
      for (int i = 0; i < 16; ++i) { const int q = TID_ + 512 * i, col = q >> 2, e0 = (q & 3) * 4;
          wrT[(e0 + 0) * DM + col] = wv[i].x; wrT[(e0 + 1) * DM + col] = wv[i].y; wrT[(e0 + 2) * DM + col] = wv[i].z; wrT[(e0 + 3) * DM + col] = wv[i].w; } }
    __syncthreads();
    const float* mod = (const float*)(C.ws() + WS_MOD); bf16* U2 = (bf16*)(C.ws() + WS_U); float* AFF = (float*)(C.ws() + WS_AFF);
    for (int m = C.gw(); m < MLAT; m += C.NGW()) {
        const int b = m >> 12, n = m & 4095; const float* src = C.out() + (size_t)m * DM;
        f32x4 v[8]; float s = 0.f;
#pragma unroll
        for (int j = 0; j < 8; ++j) { v[j] = ((const f32x4*)src)[LANE_ + 64 * j]; s += (v[j].x * v[j].x + v[j].y * v[j].y) + (v[j].z * v[j].z + v[j].w * v[j].w); }
        const float rstd = 1.0f / sqrtf(wave_sum(s) * (1.0f / DM) + EPS);
#pragma unroll
        for (int j = 0; j < 8; ++j) { const int col = (LANE_ + 64 * j) * 4; const f32x4 nw = *(const f32x4*)(C.nffn() + col), sh = *(const f32x4*)(mod + b * NMOD + 3 * DM + col), sc = *(const f32x4*)(mod + b * NMOD + 4 * DM + col);
            v[j] = (v[j] * rstd * nw) * (sc + 1.0f) + sh; v2u o; o.x = cvtpk(v[j].x, v[j].y); o.y = cvtpk(v[j].z, v[j].w); *(v2u*)(U2 + (size_t)m * DM + col) = o; }
        float lg[NEXP];
#pragma unroll
        for (int e = 0; e < NEXP; ++e) { float a = 0.f;
#pragma unroll
            for (int j = 0; j < 8; ++j) { const f32x4 w = *(const f32x4*)(wrT + e * DM + (LANE_ + 64 * j) * 4); a += (v[j].x * w.x + v[j].y * w.y) + (v[j].z * w.z + v[j].w * w.w); }
            lg[e] = wave_sum(a); }
        float mx = lg[0];
#pragma unroll
        for (int e = 1; e < NEXP; ++e) mx = fmaxf(mx, lg[e]);
        float sum = 0.f;
#pragma unroll
        for (int e = 0; e < NEXP; ++e) { lg[e] = expf(lg[e] - mx); sum += lg[e]; }
        const float inv = 1.0f / sum; float mine = 0.f;
#pragma unroll
        for (int e = 0; e < NEXP; ++e) mine = (LANE_ == e) ? lg[e] * inv : mine;
        if (LANE_ < NEXP) AFF[(size_t)(b * NEXP + LANE_) * SEQ + n] = mine;
    }
    __syncthreads();
}

__device__ __forceinline__ void p8_topk(const Ctx& C, int b, int e) {
    const int TID_ = opq((int)threadIdx.x), LANE_ = TID_ & 63;
    unsigned* hist = (unsigned*)C.lds;
    unsigned* scal = hist + 256; unsigned* wtot = hist + 288;
    const float* aff = (const float*)(C.ws() + WS_AFF) + (size_t)(b * NEXP + e) * SEQ;
    int* SLOT = (int*)(C.ws() + WS_SLOT) + (size_t)(b * NEXP + e) * SEQ; int* IDX = (int*)(C.ws() + WS_IDX) + (e * 2 + b) * CAP; float* GATE = (float*)(C.ws() + WS_GATE) + (e * 2 + b) * CAP;
    const int tid = TID_, base = tid * 8;
    unsigned key[8]; { const v4u a = *(const v4u*)(aff + base), c2 = *(const v4u*)(aff + base + 4); key[0] = a.x; key[1] = a.y; key[2] = a.z; key[3] = a.w; key[4] = c2.x; key[5] = c2.y; key[6] = c2.z; key[7] = c2.w; }
    unsigned prefix = 0u, remaining = CAP;
#pragma unroll
    for (int pass = 0; pass < 4; ++pass) {
        const int shift = 24 - 8 * pass;
        if (tid < 256) hist[tid] = 0u;
        __syncthreads();
#pragma unroll
        for (int i = 0; i < 8; ++i) { const bool match = (pass == 0) || ((key[i] >> (shift + 8)) == (prefix >> (shift + 8))); if (match) atomicAdd(&hist[(key[i] >> shift) & 255u], 1u); }
        __syncthreads();
        {
          unsigned hcnt = 0u, suf = 0u;
          if (tid < 256) { hcnt = hist[tid]; suf = hcnt;
#pragma unroll
              for (int o = 1; o < 64; o <<= 1) { const unsigned t2 = __shfl_down(suf, o); if (LANE_ + o < 64) suf += t2; }
              if (LANE_ == 0) wtot[8 + C.wave] = suf; }
          __syncthreads();
          if (tid < 256) { for (int w = C.wave + 1; w < 4; ++w) suf += wtot[8 + w];
              if (suf >= remaining && suf - hcnt < remaining) { scal[0] = prefix | ((unsigned)tid << shift); scal[1] = remaining - (suf - hcnt); } }
        }
        __syncthreads();
        prefix = scal[0]; remaining = scal[1];
        __syncthreads();
    }
    unsigned cg = 0u, ce = 0u;
#pragma unroll
    for (int i = 0; i < 8; ++i) { cg += key[i] > prefix ? 1u : 0u; ce += key[i] == prefix ? 1u : 0u; }
    unsigned pk = cg | (ce << 16), inc = pk;
#pragma unroll
    for (int o = 1; o < 64; o <<= 1) { const unsigned t = __shfl_up(inc, o); if (LANE_ >= o) inc += t; }
    if (LANE_ == 63) wtot[C.wave] = inc;
    __syncthreads();
    unsigned woff = 0u;
    for (int w = 0; w < C.wave; ++w) woff += wtot[w];
    const unsigned excl = woff + inc - pk; unsigned rg_ = excl & 0xffffu, re_ = excl >> 16;
    const unsigned ngt = CAP - remaining;
#pragma unroll
    for (int i = 0; i < 8; ++i) { int slot = -1;
        if (key[i] > prefix) { slot = (int)rg_; ++rg_; }
        else if (key[i] == prefix) { if (re_ < remaining) slot = (int)(ngt + re_); ++re_; }
        SLOT[base + i] = slot;
        if (slot >= 0) { IDX[slot] = base + i; GATE[slot] = __builtin_bit_cast(float, key[i]); } }
    __syncthreads();
}

__device__ __forceinline__ void p9_gather(const Ctx& C) {
    const int TID_ = opq((int)threadIdx.x), LANE_ = TID_ & 63;
    const bf16* U2 = (const bf16*)(C.ws() + WS_U); bf16* XE = (bf16*)(C.ws() + WS_XE); const int* IDX = (const int*)(C.ws() + WS_IDX);
    for (int R = C.gw(); R < NEXP * NB * CAP; R += C.NGW()) {
        const int b = (R >> 9) & 1; const int tok = IDX[R];
        const v4u* src = (const v4u*)(U2 + (size_t)(b * SEQ + tok) * DM) + LANE_; v4u* dst = (v4u*)(XE + (size_t)R * DM) + LANE_;
        const v4u a0 = src[0], a1 = src[64], a2 = src[128], a3 = src[192];
        dst[0] = a0; dst[64] = a1; dst[128] = a2; dst[192] = a3;
    }
}

__device__ __forceinline__ void p12_final(const Ctx& C) {
    const int TID_ = opq((int)threadIdx.x), LANE_ = TID_ & 63;
    const float* mod = (const float*)(C.ws() + WS_MOD); const bf16* YE = (const bf16*)(C.ws() + WS_YE); const int* SLOT = (const int*)(C.ws() + WS_SLOT);
    for (int m = C.gw(); m < MLAT; m += C.NGW()) {
        const int b = m >> 12, n = m & 4095; float* row = C.out() + (size_t)m * DM;
        f32x4 acc[8];
#pragma unroll
        for (int j = 0; j < 8; ++j) acc[j] = (f32x4){0.f, 0.f, 0.f, 0.f};
        const int sl = (LANE_ < NEXP) ? SLOT[(size_t)(b * NEXP + LANE_) * SEQ + n] : -1;
        unsigned mk = (unsigned)__ballot(sl >= 0);
        while (mk) {
            const int e0 = __builtin_ctz(mk); mk &= mk - 1; const bool two = mk != 0u; const int e1 = two ? __builtin_ctz(mk) : e0; if (two) mk &= mk - 1;
            const int s0 = __builtin_amdgcn_readlane(sl, e0), s1 = __builtin_amdgcn_readlane(sl, e1);
            const v2u* y0 = (const v2u*)(YE + (size_t)((e0 * 2 + b) * CAP + s0) * DM) + LANE_; const v2u* y1 = (const v2u*)(YE + (size_t)((e1 * 2 + b) * CAP + s1) * DM) + LANE_;
            v2u a0[8], a1[8];
#pragma unroll
            for (int j = 0; j < 8; ++j) { a0[j] = y0[64 * j]; a1[j] = y1[64 * j]; }
            const float w1 = two ? 1.0f : 0.0f;
#pragma unroll
            for (int j = 0; j < 8; ++j) {
                acc[j].x += __builtin_bit_cast(float, a0[j].x << 16); acc[j].y += __builtin_bit_cast(float, a0[j].x & 0xffff0000u); acc[j].z += __builtin_bit_cast(float, a0[j].y << 16); acc[j].w += __builtin_bit_cast(float, a0[j].y & 0xffff0000u);
                acc[j].x += w1 * __builtin_bit_cast(float, a1[j].x << 16); acc[j].y += w1 * __builtin_bit_cast(float, a1[j].x & 0xffff0000u); acc[j].z += w1 * __builtin_bit_cast(float, a1[j].y << 16); acc[j].w += w1 * __builtin_bit_cast(float, a1[j].y & 0xffff0000u); }
        }
        f32x4 v[8]; float s2 = 0.f;
#pragma unroll
        for (int j = 0; j < 8; ++j) { const int col = (LANE_ + 64 * j) * 4; const f32x4 g5 = *(const f32x4*)(mod + b * NMOD + 5 * DM + col);
            v[j] = ((const f32x4*)row)[LANE_ + 64 * j] + g5 * acc[j]; s2 += (v[j].x * v[j].x + v[j].y * v[j].y) + (v[j].z * v[j].z + v[j].w * v[j].w); }
        const float rstd = 1.0f / sqrtf(wave_sum(s2) * (1.0f / DM) + EPS);
#pragma unroll
        for (int j = 0; j < 8; ++j) { const int col = (LANE_ + 64 * j) * 4; const f32x4 fw = *(const f32x4*)(C.fin_w() + col); ((f32x4*)row)[LANE_ + 64 * j] = v[j] * rstd * fw; }
    }
}

__global__ void __launch_bounds__(NWAVES * 64, 2) fwd_megakernel(Args args) {
    extern __shared__ __attribute__((aligned(16))) unsigned char lds[];
    Ctx C;
    C.a = &args; C.lds = lds;
    C.wave = __builtin_amdgcn_readfirstlane((int)threadIdx.x >> 6);
    volatile LAS unsigned* MISC = (volatile LAS unsigned*)((LAS unsigned char*)lds + MISC_OFF);
    for (int u = threadIdx.x; u < (LDS_BYTES - LDSCTL_OFF) / 4; u += NWAVES * 64) ((LAS unsigned*)((LAS unsigned char*)lds + LDSCTL_OFF))[u] = 0u;
    __syncthreads();
    unsigned* ctl = (unsigned*)(args.ws + WS_CTL);
    XcdBarrier bar; bar.bar = ctl + CW_BAR; bar.x = 0; bar.st = nullptr;
    if (N_LAUNCHES == 1) bar = xcd_barrier_post(ctl + CW_BAR, MISC + 8);
#define GRID_BAR() do { if (N_LAUNCHES == 1) xcd_barrier(bar); } while (0)
#ifndef PHASE_MASK
#define PHASE_MASK 0x1fff
#endif
#define IN(k) ((((PHASE_MASK) >> (k)) & 1) && args.ph_lo <= (k) && (k) < args.ph_hi)
#define BOTH(k) (IN(k) && IN((k) + 1))
#ifndef PROBE_MASK
#define PROBE_MASK 0
#endif
#define REPS(k) ((((PROBE_MASK) >> (k)) & 1) ? 2 : 1)
    PG8_LAS unsigned char* ring = (PG8_LAS unsigned char*)lds;

    if (IN(0)) for (int rep_ = 0; rep_ < REPS(0); ++rep_) { p0_prologue(C); if (BOTH(0) || rep_ + 1 < REPS(0)) GRID_BAR(); }
    if (IN(1)) for (int rep_ = 0; rep_ < REPS(1); ++rep_) { p1_rows(C); if (BOTH(1) || rep_ + 1 < REPS(1)) GRID_BAR(); }
    if (IN(2)) for (int rep_ = 0; rep_ < REPS(2); ++rep_) {
        pg8::Gemm g{(const pg8::bf16_t*)(args.ws + WS_U), (const pg8::bf16_t*)(args.ws + WS_WIN), MALL, NIN, DM, 0, 0};
        pg8::QkvOrder S; S.init(C.G(), (int)blockIdx.x);
        pg8::EpiQKV E{(pg8::bf16_t*)(args.ws + WS_QKV), (const float*)(args.ws + WS_ROPE), (const float*)(args.ws + WS_ROPE) + 2048};
        pg8::gemm_phase<pg8::EpiQKV, pg8::QkvOrder, true, true>(ring, g, S, E);
        if (BOTH(2) || rep_ + 1 < REPS(2)) GRID_BAR();
    }
    if (IN(3)) for (int rep_ = 0; rep_ < REPS(3); ++rep_) {
#ifndef NO_NA
        for (int u = C.vcu(); u < 256; u += C.G()) { const int bh = u >> 4; na::na_unit((const bf16*)(args.ws + WS_QKV), (bf16*)(args.ws + WS_MIX), C.rpb(), bh >> 3, bh & 7, u & 15, (char*)lds); }
#endif
#ifndef NO_KV
        for (int it = C.vcu(); it < 544; it += C.G()) { const int bh = it / 34; ret::kv_item(C, bh >> 3, bh & 7, it % 34); }
#endif
        if (BOTH(3) || rep_ + 1 < REPS(3)) GRID_BAR();
    }
    if (IN(4)) for (int rep_ = 0; rep_ < REPS(4); ++rep_) { ret::scan_phase(C); if (BOTH(4) || rep_ + 1 < REPS(4)) GRID_BAR(); }
    if (IN(5)) for (int rep_ = 0; rep_ < REPS(5); ++rep_) {
        for (int it = C.vcu(); it < 512; it += C.G()) ret::ro_item(C, it >> 8, (it >> 5) & 7, it & 31);
        if (BOTH(5) || rep_ + 1 < REPS(5)) GRID_BAR();
    }
    if (IN(6)) for (int rep_ = 0; rep_ < REPS(6); ++rep_) {
        pg8::Gemm g{(const pg8::bf16_t*)(args.ws + WS_MIX), (const pg8::bf16_t*)(args.ws + WS_WOUT), MLAT, DM, DM, 0, 0};
        pg8::StaticOrder S; S.init(MLAT, DM, C.G(), (int)blockIdx.x);
        pg8::EpiOut E{C.x(), C.out(), (const float*)(args.ws + WS_MOD)};
        pg8::gemm_phase<pg8::EpiOut, pg8::StaticOrder, true, true>(ring, g, S, E);
        if (BOTH(6) || rep_ + 1 < REPS(6)) GRID_BAR();
    }
    if (IN(7)) for (int rep_ = 0; rep_ < REPS(7); ++rep_) { p7_rows(C); if (BOTH(7) || rep_ + 1 < REPS(7)) GRID_BAR(); }
    if (IN(8)) for (int rep_ = 0; rep_ < REPS(8); ++rep_) { for (int it = blockIdx.x; it < NB * NEXP; it += C.G()) p8_topk(C, it >> 4, it & 15); if (BOTH(8) || rep_ + 1 < REPS(8)) GRID_BAR(); }
    if (IN(9)) for (int rep_ = 0; rep_ < REPS(9); ++rep_) { p9_gather(C); if (BOTH(9) || rep_ + 1 < REPS(9)) GRID_BAR(); }
    if (IN(10)) for (int rep_ = 0; rep_ < REPS(10); ++rep_) {
        pg8::Gemm g{(const pg8::bf16_t*)(args.ws + WS_XE), (const pg8::bf16_t*)(args.ws + WS_WGU), NEXP * NB * CAP, 2 * FF, DM, 2, (size_t)2048 * 2048 * 2};
        pg8::StaticOrder S; S.init(NEXP * NB * CAP, 2 * FF, C.G(), (int)blockIdx.x);
        pg8::EpiGU E{(pg8::bf16_t*)(args.ws + WS_HID)};
        pg8::gemm_phase<pg8::EpiGU, pg8::StaticOrder, true, true>(ring, g, S, E);
        if (BOTH(10) || rep_ + 1 < REPS(10)) GRID_BAR();
    }
    if (IN(11)) for (int rep_ = 0; rep_ < REPS(11); ++rep_) {
        pg8::Gemm g{(const pg8::bf16_t*)(args.ws + WS_HID), (const pg8::bf16_t*)(args.ws + WS_WDN), NEXP * NB * CAP, DM, FF, 2, (size_t)2048 * 1024 * 2};
        pg8::StaticOrder S; S.init(NEXP * NB * CAP, DM, C.G(), (int)blockIdx.x);
        pg8::EpiDown E{(pg8::bf16_t*)(args.ws + WS_YE), (const float*)(args.ws + WS_GATE)};
        pg8::gemm_phase<pg8::EpiDown, pg8::StaticOrder, true, true>(ring, g, S, E);
        if (BOTH(11) || rep_ + 1 < REPS(11)) GRID_BAR();
    }
    if (IN(12)) for (int rep_ = 0; rep_ < REPS(12); ++rep_) { p12_final(C); }
#undef IN
#undef BOTH
#undef GRID_BAR
}

extern "C" void kernel_launch(void* const* d_in, const int* in_sizes, int n_in, void* d_out, int out_size, void* d_ws, size_t ws_size, hipStream_t stream) {
    static int grid = 0;
    if (grid == 0) {
        if (n_in != 19 || in_sizes[0] != MLAT * DM || out_size != MLAT * DM || ws_size < WS_END) { fprintf(stderr, "kernel_launch: built for 19 inputs, x/out of %d floats, >= %zu bytes of workspace; got n_in %d in0 %d out %d ws %zu; nothing launched\n", MLAT * DM, (size_t)WS_END, n_in, n_in > 0 ? in_sizes[0] : -1, out_size, ws_size); grid = -1; return; }
        int dev = 0, cus = 0, per_cu = 0;
        if (hipGetDevice(&dev) != hipSuccess || hipDeviceGetAttribute(&cus, hipDeviceAttributeMultiprocessorCount, dev) != hipSuccess) { fprintf(stderr, "kernel_launch: hipGetDevice / hipDeviceGetAttribute failed\n"); grid = -1; return; }
        if (hipFuncSetAttribute((const void*)fwd_megakernel, hipFuncAttributeMaxDynamicSharedMemorySize, LDS_BYTES) != hipSuccess) { fprintf(stderr, "kernel_launch: hipFuncSetAttribute(%d B LDS) failed\n", LDS_BYTES); grid = -1; return; }
        if (hipOccupancyMaxActiveBlocksPerMultiprocessor(&per_cu, (const void*)fwd_megakernel, NWAVES * 64, LDS_BYTES) != hipSuccess || per_cu < 1) { fprintf(stderr, "kernel_launch: occupancy query reports %d workgroups per CU\n", per_cu); per_cu = 1; }
        (void)hipGetLastError();
        grid = cus;
    }
    if (grid < 0) return;
    if (hipMemsetAsync((char*)d_ws + WS_CTL, 0, CTL_ZERO_BYTES, stream) != hipSuccess) { fprintf(stderr, "kernel_launch: hipMemsetAsync failed\n"); return; }
    Args a{};
    for (int i = 0; i < 19; ++i) a.in[i] = (const float*)d_in[i];
    a.out = (float*)d_out; a.ws = (unsigned char*)d_ws;
    if (N_LAUNCHES == 1) {
        a.ph_lo = 0; a.ph_hi = PER_PHASE; a.li = 0;
        void* kargs[] = {&a};
        hipError_t e = hipLaunchCooperativeKernel((const void*)fwd_megakernel, dim3(grid), dim3(NWAVES * 64), kargs, LDS_BYTES, stream);
        if (e != hipSuccess) { fprintf(stderr, "kernel_launch: cooperative launch failed: %s (grid %d)\n", hipGetErrorString(e), grid); (void)hipGetLastError(); }
    } else {
        for (int li = 0; li < PER_PHASE; ++li) { a.ph_lo = li; a.ph_hi = li + 1; a.li = li;
            hipLaunchKernelGGL(fwd_megakernel, dim3(grid), dim3(NWAVES * 64), LDS_BYTES, stream, a);
            const hipError_t le = hipPeekAtLastError(); if (le != hipSuccess) { fprintf(stderr, "kernel_launch: launch %d failed: %s\n", li, hipGetErrorName(le)); break; } }
    }
}
```

```cpp
#include <hip/hip_runtime.h>
#include <hip/hip_bf16.h>
#include <cstdio>
#include <cstdint>
#include <cmath>
#define MK_N_LAUNCHES 1
namespace pg8 {
#define PG8_LAS __attribute__((address_space(3)))
typedef unsigned short bf16_t;
typedef short bf16x8 __attribute__((ext_vector_type(8)));
typedef float f32x4 __attribute__((ext_vector_type(4)));
typedef unsigned u32x4 __attribute__((ext_vector_type(4)));
constexpr int BM = 256, BK = 64, HALF = 128, HTB = HALF * BK * 2  , STAGE_BYTES = 8 * HTB, NXCD = 8, WGM = 8;

__host__ __device__ __forceinline__ int lds_byte(int r, int c) { const int st = (r >> 4) * 2 + (c >> 5), rr = r & 15, cc = c & 31, ob = rr * 64 + cc * 2; return st * 1024 + (ob ^ (((ob >> 9) & 1) << 5)); }
__host__ __device__ __forceinline__ void stage_rc(int b, int& R, int& C) { const int st = b / 1024, sb = b % 1024, swz = sb ^ (((sb >> 9) & 1) << 5); R = (st >> 1) * 16 + swz / 64; C = (st & 1) * 32 + (swz % 64) / 2; }
__host__ __device__ __forceinline__ int perm32(int rho) { const int n = rho >> 4, i = rho & 15; return 8 * (i >> 2) + 4 * n + (i & 3); }

struct Unit { int pm, pn; };
struct Gemm { const bf16_t* A; const bf16_t* Bt; int M, N, K; int gshift; size_t gstride; const int* gidx;
    __device__ __forceinline__ size_t bofs(int pm, int pn) const { return (size_t)(pm >> gshift) * gstride + (size_t)pn * (size_t)(256 * 2) * (size_t)K; } };

struct StaticOrder {
    int nM, nN, nwg, G, c;
    __host__ __device__ void init(int M, int N, int G_, int c_) { nM = M / BM; nN = N / BM; nwg = nM * nN; G = G_; c = c_; }
    __host__ __device__ bool next(int i, Unit& u) const {
        const long L = (long)i * G + c; if (L >= nwg) return false;
        int wgid = (int)L; { const int q = nwg / NXCD, r = nwg % NXCD, xcd = wgid % NXCD, off = wgid / NXCD; wgid = (xcd < r ? xcd * (q + 1) : r * (q + 1) + (xcd - r) * q) + off; }
        const int nig = WGM * nN, gid = wgid / nig, fm = gid * WGM, gsz = (nM - fm) < WGM ? (nM - fm) : WGM;
        u.pm = fm + ((wgid % nig) % gsz); u.pn = (wgid % nig) / gsz; return true;
    }
    __device__ __forceinline__ void a_ready(const Unit&) const {}
    __device__ __forceinline__ void done(const Unit&) const {}
};


typedef float f32x2c __attribute__((ext_vector_type(2))); typedef __bf16 bf16x2c __attribute__((ext_vector_type(2)));
__device__ __forceinline__ unsigned cvt_pk_bf16(float lo, float hi) { const f32x2c v = {lo, hi}; const bf16x2c b = __builtin_convertvector(v, bf16x2c); return __builtin_bit_cast(unsigned, b); }
__device__ __forceinline__ float silu_f(float x) { return x * __builtin_amdgcn_rcpf(1.0f + __expf(-x)); }
__device__ __forceinline__ f32x4 silu4(f32x4 v) { return (f32x4){silu_f(v[0]), silu_f(v[1]), silu_f(v[2]), silu_f(v[3])}; }
__device__ __forceinline__ u32x4 pack8(f32x4 v0, f32x4 v1) { u32x4 w; w.x = cvt_pk_bf16(v0[0], v0[1]); w.y = cvt_pk_bf16(v0[2], v0[3]); w.z = cvt_pk_bf16(v1[0], v1[1]); w.w = cvt_pk_bf16(v1[2], v1[3]); return w; }

struct EpiQKV {
    static constexpr bool PERM = true, AFTER_DRAIN = false;
    bf16_t* O; const float* rc; const float* rs;
    __device__ __forceinline__ void operator()(const f32x4 (&acc)[2][2][4][2], const Unit& u, int wr, int wc, int fr, int fq) const {
        const int colt = u.pn * BM, t = colt >> 10; const bool lat = u.pm < 32;
        const int col0 = colt + wc * 32 + 8 * fq;
        const bool rope = lat && (t == 2 || t == 5);
        const int i0 = (wc & 1) * 16 + 4 * fq;
#pragma unroll
        for (int ai = 0; ai < 2; ++ai)
#pragma unroll
            for (int m = 0; m < 4; ++m) {
                const int row = u.pm * BM + ai * HALF + wr * 64 + m * 16 + fr;
                bf16_t* rowp = O + (size_t)row * 7168 + col0;
                f32x4 c4 = (f32x4){1.f, 1.f, 1.f, 1.f}, s4 = (f32x4){0.f, 0.f, 0.f, 0.f};
                if (rope) { const int tok = row & 4095; const int pos = (wc >> 1) ? (tok & 63) : (tok >> 6); c4 = *(const f32x4*)(rc + pos * 32 + i0); s4 = *(const f32x4*)(rs + pos * 32 + i0); }
#pragma unroll
                for (int bj = 0; bj < 2; ++bj) {
                    f32x4 v0 = acc[ai][bj][m][0], v1 = acc[ai][bj][m][1];
                    if (rope) { const f32x4 a = v0 * c4 - v1 * s4, b = v1 * c4 + v0 * s4; v0 = a; v1 = b; }
                    if (t == 2) { v0 = v0 * 0.08838834764831845f; v1 = v1 * 0.08838834764831845f; }
                    if (t == 6) { v0 = silu4(v0); v1 = silu4(v1); }
                    *(u32x4*)(rowp + bj * HALF) = pack8(v0, v1);
                }
            }
    }
};
struct EpiOut {
    static constexpr bool PERM = false, AFTER_DRAIN = false;
    const float* x; float* out; const float* mod;
    __device__ __forceinline__ void operator()(const f32x4 (&acc)[2][2][4][2], const Unit& u, int wr, int wc, int fr, int fq) const {
        const int b = u.pm >> 4; const float* g2 = mod + b * 12288 + 2 * 2048;
        const int col0 = u.pn * BM + wc * 32 + 4 * fq;
        f32x4 gv[2][2];
#pragma unroll
        for (int bj = 0; bj < 2; ++bj)
#pragma unroll
            for (int n = 0; n < 2; ++n) gv[bj][n] = *(const f32x4*)(g2 + col0 + bj * HALF + n * 16);
#pragma unroll
        for (int ai = 0; ai < 2; ++ai)
#pragma unroll
            for (int m = 0; m < 4; ++m) {
                const size_t off = (size_t)(u.pm * BM + ai * HALF + wr * 64 + m * 16 + fr) * 2048 + col0;
#pragma unroll
                for (int bj = 0; bj < 2; ++bj)
#pragma unroll
                    for (int n = 0; n < 2; ++n) { const f32x4 xv = __builtin_nontemporal_load((const f32x4*)(x + off + bj * HALF + n * 16)); *(f32x4*)(out + off + bj * HALF + n * 16) = xv + gv[bj][n] * acc[ai][bj][m][n]; }
            }
    }
};
struct EpiGU {
    static constexpr bool PERM = true, AFTER_DRAIN = false;
    bf16_t* H;
    __device__ __forceinline__ void operator()(const f32x4 (&acc)[2][2][4][2], const Unit& u, int wr, int wc, int fr, int fq) const {
        const int col0 = u.pn * HALF + wc * 32 + 8 * fq;
#pragma unroll
        for (int ai = 0; ai < 2; ++ai)
#pragma unroll
            for (int m = 0; m < 4; ++m) {
                const int row = u.pm * BM + ai * HALF + wr * 64 + m * 16 + fr;
                const f32x4 h0 = silu4(acc[ai][0][m][0]) * acc[ai][1][m][0], h1 = silu4(acc[ai][0][m][1]) * acc[ai][1][m][1];
                *(u32x4*)(H + (size_t)row * 1024 + col0) = pack8(h0, h1);
            }
    }
};
struct EpiDown {
    static constexpr bool PERM = true, AFTER_DRAIN = false;
    bf16_t* Y; const float* gate;
    __device__ __forceinline__ void operator()(const f32x4 (&acc)[2][2][4][2], const Unit& u, int wr, int wc, int fr, int fq) const {
        const int col0 = u.pn * BM + wc * 32 + 8 * fq;
#pragma unroll
        for (int ai = 0; ai < 2; ++ai)
#pragma unroll
            for (int m = 0; m < 4; ++m) {
                const int row = u.pm * BM + ai * HALF + wr * 64 + m * 16 + fr;
                const float gt = gate[row];
#pragma unroll
                for (int bj = 0; bj < 2; ++bj) *(u32x4*)(Y + (size_t)row * 2048 + col0 + bj * HALF) = pack8(acc[ai][bj][m][0] * gt, acc[ai][bj][m][1] * gt);
            }
    }
};
struct QkvOrder {
    StaticOrder so; int G, c;
    __host__ __device__ void init(int G_, int c_) { so.init(8192, 7168, G_, c_); G = G_; c = c_; }
    __host__ __device__ bool next(int i, Unit& u) const {
        const long L = (long)i * G + c; if (L < so.nwg) return so.next(i, u);
        const int l = (int)(L - so.nwg); if (l >= 32) return false;
        u.pm = 32 + (l & 1); u.pn = l >> 1; return true;
    }
    __device__ __forceinline__ void a_ready(const Unit&) const {}
    __device__ __forceinline__ void done(const Unit&) const {}
};
template <class Epi, class Sched, bool ALIGN_EPI = false, bool SP2 = false, bool GATHER = false>
__device__ __forceinline__ void gemm_phase(PG8_LAS unsigned char* lds, const Gemm g, const Sched& S, const Epi& E) {
    int tid_ = threadIdx.x; asm volatile("" : "+v"(tid_));
    const int tid = tid_, wid = __builtin_amdgcn_readfirstlane(tid >> 6), lane = tid & 63, wr = wid >> 2, wc = wid & 3, fr = lane & 15, fq = lane >> 4;
    const int K = g.K, nt = K / BK;
    unsigned voffA[2], voffB[2];
#pragma unroll
    for (int i = 0; i < 2; ++i) { int R, C; stage_rc(tid * 16 + i * 8192, R, C); const int Rb = Epi::PERM ? ((R & ~31) + perm32(R & 31)) : R;
        voffA[i] = (unsigned)(R * K + C) * 2u; voffB[i] = (unsigned)(Rb * K + C) * 2u; }
    int Rr[2], Cc[2];
#pragma unroll
    for (int i = 0; i < 2; ++i) stage_rc(tid * 16 + i * 8192, Rr[i], Cc[i]);
    unsigned gcur[2][2], gnxt[2][2];
#pragma unroll
    for (int h = 0; h < 2; ++h)
#pragma unroll
        for (int i = 0; i < 2; ++i) { gcur[h][i] = voffA[i]; gnxt[h][i] = voffA[i]; }
#define PG8_GOFF(dst, pm_) do { _Pragma("unroll") for (int h_ = 0; h_ < 2; ++h_) _Pragma("unroll") for (int i_ = 0; i_ < 2; ++i_) { const int vr_ = (pm_) * BM + h_ * HALF + Rr[i_]; \
        const int ar_ = ((vr_ >> 9) & 1) * 4096 + g.gidx[vr_]; dst[h_][i_] = (unsigned)(ar_ * K + Cc[i_]) * 2u; } } while (0)
    const size_t kstep = (size_t)(BK * 2);
    const size_t hstep = (size_t)HALF * K * 2;
    const size_t tstep = 2 * hstep;
    const size_t hstepA = GATHER ? 0 : hstep, tstepA = GATHER ? 0 : tstep;
    const unsigned ldsw = (unsigned)wid * 1024u;
    const int aoff = lds_byte(wr * 64 + fr, fq * 8), boff = lds_byte(wc * 32 + fr, fq * 8);
#define PG8_SA(b, h) (((b) * 2 + (h)) * HTB)
#define PG8_SB(b, h) ((4 + (b) * 2 + (h)) * HTB)
#define PG8_STAGE(bufoff, gbase, voff) do { _Pragma("unroll") for (int _i = 0; _i < 2; ++_i) \
        __builtin_amdgcn_global_load_lds((const unsigned*)((const char*)(gbase) + (voff)[_i]), (PG8_LAS unsigned*)(lds + (bufoff) + ldsw + _i * 8192), 16, 0, 0); } while (0)
#define PG8_LDA(dst, b, h) do { _Pragma("unroll") for (int m = 0; m < 4; ++m) _Pragma("unroll") for (int k = 0; k < 2; ++k) dst[m][k] = *(const PG8_LAS bf16x8*)(lds + PG8_SA(b, h) + aoff + m * 2048 + k * 1024); } while (0)
#define PG8_LDB(dst, b, h) do { _Pragma("unroll") for (int n = 0; n < 2; ++n) _Pragma("unroll") for (int k = 0; k < 2; ++k) dst[n][k] = *(const PG8_LAS bf16x8*)(lds + PG8_SB(b, h) + boff + n * 2048 + k * 1024); } while (0)
#define PG8_MMA(ai, bj, At, Bt) do { __builtin_amdgcn_s_setprio(1); _Pragma("unroll") for (int m = 0; m < 4; ++m) _Pragma("unroll") for (int n = 0; n < 2; ++n) _Pragma("unroll") for (int k = 0; k < 2; ++k) \
        acc[ai][bj][m][n] = __builtin_amdgcn_mfma_f32_16x16x32_bf16(Bt[n][k], At[m][k], acc[ai][bj][m][n], 0, 0, 0); __builtin_amdgcn_s_setprio(0); } while (0)
#define PG8_WAIT_V(n) asm volatile("s_waitcnt vmcnt(" #n ")" ::: "memory")
#define PG8_WAIT_L(n) asm volatile("s_waitcnt lgkmcnt(" #n ")" ::: "memory")
#define PG8_BAR __builtin_amdgcn_s_barrier()
#define PG8_SCHED __builtin_amdgcn_sched_barrier(0)
    Unit cur, nxt; int ui = 0;
    if (!S.next(0, cur)) return;
    f32x4 acc[2][2][4][2];
#pragma unroll
    for (int a = 0; a < 2; ++a)
#pragma unroll
        for (int b = 0; b < 2; ++b)
#pragma unroll
            for (int m = 0; m < 4; ++m)
#pragma unroll
                for (int n = 0; n < 2; ++n) acc[a][b][m][n] = (f32x4){0.f, 0.f, 0.f, 0.f};
    bf16x8 At[4][2], B0[2][2], B1[2][2];
    if constexpr (GATHER) { PG8_GOFF(gcur, cur.pm); }
    const char* cA = (const char*)g.A + (size_t)cur.pm * tstepA; const char* cB = (const char*)g.Bt + g.bofs(cur.pm, cur.pn);
    S.a_ready(cur);
    if constexpr (SP2) {
        PG8_STAGE(PG8_SB(0, 0), cB, voffB); PG8_STAGE(PG8_SB(0, 1), cB + hstep, voffB); PG8_STAGE(PG8_SA(0, 0), cA, gcur[0]); PG8_STAGE(PG8_SA(0, 1), cA + hstepA, gcur[1]);
        if (wr == 1) PG8_BAR;
        PG8_WAIT_V(2); PG8_BAR;
        PG8_STAGE(PG8_SB(1, 0), cB + kstep, voffB); PG8_STAGE(PG8_SA(1, 0), cA + kstep, gcur[0]); PG8_STAGE(PG8_SB(1, 1), cB + hstep + kstep, voffB);
        PG8_WAIT_V(6); PG8_BAR;
    } else {
        PG8_STAGE(PG8_SB(0, 0), cB, voffB); PG8_STAGE(PG8_SA(0, 0), cA, gcur[0]); PG8_STAGE(PG8_SB(0, 1), cB + hstep, voffB); PG8_STAGE(PG8_SA(0, 1), cA + hstepA, gcur[1]);
        if (wr == 1) PG8_BAR;
        PG8_WAIT_V(4); PG8_BAR;
        PG8_STAGE(PG8_SB(1, 0), cB + kstep, voffB); PG8_STAGE(PG8_SA(1, 0), cA + kstep, gcur[0]); PG8_STAGE(PG8_SB(1, 1), cB + hstep + kstep, voffB);
        PG8_WAIT_V(6); PG8_BAR;
    }
    for (;;) {
        const bool has_next = S.next(ui + 1, nxt);
        if constexpr (GATHER) { if (has_next) { PG8_GOFF(gnxt, nxt.pm); } else { _Pragma("unroll") for (int h = 0; h < 2; ++h) _Pragma("unroll") for (int i = 0; i < 2; ++i) gnxt[h][i] = gcur[h][i]; } }
        const char* nA = has_next ? (const char*)g.A + (size_t)nxt.pm * tstepA : cA; const char* nB = has_next ? (const char*)g.Bt + g.bofs(nxt.pm, nxt.pn) : cB;
        for (int t = 0; t < nt; t += 2) {
            const bool last = (t == nt - 2);
            const char* a1 = cA + (size_t)(t + 1) * kstep;
            const char* a2 = last ? nA : cA + (size_t)(t + 2) * kstep; const char* b2 = last ? nB : cB + (size_t)(t + 2) * kstep;
            const char* a3 = a2 + kstep; const char* b3 = b2 + kstep;
            unsigned g2[2][2];
#pragma unroll
            for (int h = 0; h < 2; ++h)
#pragma unroll
                for (int i = 0; i < 2; ++i) g2[h][i] = (GATHER && last) ? gnxt[h][i] : gcur[h][i];
            if (last && has_next) S.a_ready(nxt);
            if constexpr (SP2) {
            PG8_LDB(B0, 0, 0); PG8_LDB(B1, 0, 1); PG8_SCHED; PG8_LDA(At, 0, 0); PG8_STAGE(PG8_SA(1, 1), a1 + hstepA, gcur[1]);
            PG8_WAIT_V(8); PG8_WAIT_L(0); PG8_BAR; PG8_MMA(0, 0, At, B0); PG8_MMA(0, 1, At, B1); PG8_BAR; PG8_SCHED;
            PG8_LDA(At, 0, 1); PG8_STAGE(PG8_SB(0, 0), b2, voffB); PG8_STAGE(PG8_SB(0, 1), b2 + hstep, voffB); PG8_STAGE(PG8_SA(0, 0), a2, g2[0]);
            PG8_WAIT_V(8); PG8_WAIT_L(0); PG8_BAR; PG8_MMA(1, 0, At, B0); PG8_MMA(1, 1, At, B1); PG8_BAR; PG8_SCHED;
            PG8_LDB(B0, 1, 0); PG8_LDB(B1, 1, 1); PG8_SCHED; PG8_LDA(At, 1, 0); PG8_STAGE(PG8_SA(0, 1), a2 + hstepA, g2[1]);
            PG8_WAIT_V(8); PG8_WAIT_L(0); PG8_BAR; PG8_MMA(0, 0, At, B0); PG8_MMA(0, 1, At, B1); PG8_BAR; PG8_SCHED;
            PG8_LDA(At, 1, 1); PG8_STAGE(PG8_SB(1, 0), b3, voffB); PG8_STAGE(PG8_SB(1, 1), b3 + hstep, voffB); PG8_STAGE(PG8_SA(1, 0), a3, g2[0]);
            PG8_WAIT_V(8); PG8_WAIT_L(0); PG8_BAR; PG8_MMA(1, 0, At, B0); PG8_MMA(1, 1, At, B1); PG8_BAR; PG8_SCHED;
            } else {
            PG8_LDB(B0, 0, 0); PG8_SCHED; PG8_LDA(At, 0, 0); PG8_STAGE(PG8_SA(1, 1), a1 + hstepA, gcur[1]);
            PG8_WAIT_L(8); PG8_BAR; PG8_WAIT_L(0); PG8_MMA(0, 0, At, B0); PG8_BAR; PG8_SCHED;
            PG8_LDB(B1, 0, 1); PG8_STAGE(PG8_SB(0, 0), b2, voffB);
            PG8_BAR; PG8_WAIT_L(0); PG8_MMA(0, 1, At, B1); PG8_BAR;
            PG8_LDA(At, 0, 1); PG8_STAGE(PG8_SA(0, 0), a2, g2[0]);
            PG8_BAR; PG8_WAIT_L(0); PG8_MMA(1, 0, At, B0); PG8_BAR; PG8_SCHED;
            PG8_STAGE(PG8_SB(0, 1), b2 + hstep, voffB);
            PG8_WAIT_V(6); PG8_BAR; PG8_MMA(1, 1, At, B1); PG8_BAR;
            PG8_LDB(B0, 1, 0); PG8_SCHED; PG8_LDA(At, 1, 0); PG8_STAGE(PG8_SA(0, 1), a2 + hstepA, g2[1]);
            PG8_WAIT_L(8); PG8_BAR; PG8_WAIT_L(0); PG8_MMA(0, 0, At, B0); PG8_BAR; PG8_SCHED;
            PG8_LDB(B1, 1, 1); PG8_STAGE(PG8_SB(1, 0), b3, voffB);
            PG8_BAR; PG8_WAIT_L(0); PG8_MMA(0, 1, At, B1); PG8_BAR;
            PG8_LDA(At, 1, 1); PG8_STAGE(PG8_SA(1, 0), a3, g2[0]);
            PG8_BAR; PG8_WAIT_L(0); PG8_MMA(1, 0, At, B0); PG8_BAR; PG8_SCHED;
            PG8_STAGE(PG8_SB(1, 1), b3 + hstep, voffB);
            PG8_WAIT_V(6); PG8_BAR; PG8_MMA(1, 1, At, B1); PG8_BAR;
            }
        }
        if constexpr (ALIGN_EPI) { if (wr == 0) PG8_BAR; }
        if constexpr (!Epi::AFTER_DRAIN) { E(acc, cur, wr, wc, fr, fq); S.done(cur); }
        if (!has_next) break;
#pragma unroll
        for (int a = 0; a < 2; ++a)
#pragma unroll
            for (int b = 0; b < 2; ++b)
#pragma unroll
                for (int m = 0; m < 4; ++m)
#pragma unroll
                    for (int n = 0; n < 2; ++n) acc[a][b][m][n] = (f32x4){0.f, 0.f, 0.f, 0.f};
        cur = nxt; cA = nA; cB = nB; ++ui;
#pragma unroll
        for (int h = 0; h < 2; ++h)
#pragma unroll
            for (int i = 0; i < 2; ++i) gcur[h][i] = gnxt[h][i];
        if constexpr (ALIGN_EPI) { if (wr == 1) PG8_BAR; }
    }
    PG8_WAIT_V(0);
    if constexpr (!ALIGN_EPI) { if (wr == 0) PG8_BAR; }
    PG8_BAR;
    if constexpr (Epi::AFTER_DRAIN) { E.fused(acc, cur, wr, wc, fr, fq, lds, wid, lane); S.done(cur); }
#undef PG8_SA
#undef PG8_SB
#undef PG8_STAGE
#undef PG8_LDA
#undef PG8_LDB
#undef PG8_MMA
#undef PG8_WAIT_V
#undef PG8_WAIT_L
#undef PG8_BAR
#undef PG8_SCHED
#undef PG8_GOFF
}
}

constexpr int NWAVES = 8;
#ifndef MK_N_LAUNCHES
#define MK_N_LAUNCHES 1
#endif
constexpr int PER_PHASE = 13;
constexpr int N_LAUNCHES = MK_N_LAUNCHES;

constexpr int DM = 2048, NB = 2, SEQ = 4096, CTXL = 256, NEXP = 16, FF = 1024, CAP = 512;
constexpr int MLAT = NB * SEQ, MALL = MLAT + NB * CTXL, NIN = 7168, NMOD = 6 * DM;
constexpr float EPS = 1e-6f;
constexpr int MOD_KC = 8;

constexpr size_t MiB = 1u << 20, KiB = 1u << 10;
constexpr size_t WS_CTL = 0, CTL_ZERO_BYTES = 64 * KiB;
constexpr size_t WS_MODP = 1 * MiB;
constexpr size_t WS_MOD = 2 * MiB + 512 * KiB;
constexpr size_t WS_ROPE = 2 * MiB + 768 * KiB;
constexpr size_t WS_AFF = 3 * MiB;
constexpr size_t WS_SLOT = 3 * MiB + 512 * KiB;
constexpr size_t WS_IDX = 4 * MiB, WS_GATE = 4 * MiB + 64 * KiB;
constexpr size_t WS_WIN = 8 * MiB, WS_WOUT = 36 * MiB, WS_WGU = 44 * MiB, WS_WDN = 172 * MiB;
constexpr size_t WS_U = 236 * MiB;
constexpr size_t WS_QKV = 270 * MiB;
constexpr size_t WS_XE = 270 * MiB, WS_HID = 334 * MiB;
constexpr size_t WS_MIX = 389 * MiB;
constexpr size_t WS_KV = 421 * MiB;
constexpr size_t WS_YE = 421 * MiB;
constexpr size_t WS_ST = 489 * MiB;
constexpr size_t WS_HLAT = 521 * MiB;
constexpr size_t WS_END = 585 * MiB;
constexpr int CW_BAR = 1024;

constexpr int RING_BYTES = 131072;
constexpr int LDSCTL_OFF = 143360, MISC_OFF = LDSCTL_OFF + 320;
constexpr int LDS_BYTES = 147456;

#define GAS __attribute__((address_space(1)))
#define LAS __attribute__((address_space(3)))
typedef unsigned short bf16;
typedef unsigned v4u __attribute__((ext_vector_type(4)));
typedef unsigned v2u __attribute__((ext_vector_type(2)));
typedef float f32x4 __attribute__((ext_vector_type(4)));
typedef float f32x2 __attribute__((ext_vector_type(2)));
typedef float f32x16 __attribute__((ext_vector_type(16)));
typedef short bf16x8 __attribute__((ext_vector_type(8)));
typedef short s16x4 __attribute__((ext_vector_type(4)));
#define RLX_AGENT __ATOMIC_RELAXED, __HIP_MEMORY_SCOPE_AGENT
#define LDS_WAIT() asm volatile("s_waitcnt lgkmcnt(0)" ::: "memory")
#define VM_WAIT() asm volatile("s_waitcnt vmcnt(0)" ::: "memory")
#define SBAR() __builtin_amdgcn_sched_barrier(0)
typedef __bf16 bf16x2_t __attribute__((ext_vector_type(2)));
__device__ __forceinline__ unsigned cvtpk(float lo, float hi) { const f32x2 v = {lo, hi}; const bf16x2_t b = __builtin_convertvector(v, bf16x2_t); return __builtin_bit_cast(unsigned, b); }
__device__ __forceinline__ float bf2f(unsigned short b) { return __builtin_bit_cast(float, (unsigned)b << 16); }
__device__ __forceinline__ float silu_f(float x) { return x / (1.0f + __expf(-x)); }
__device__ __forceinline__ float log_sigmoid_f(float x) { return -log1pf(expf(-x)); }
#define DPP_ADD(v, ctrl) ((v) + __builtin_bit_cast(float, __builtin_amdgcn_update_dpp(0, __builtin_bit_cast(int, (v)), (ctrl), 0xf, 0xf, true)))
__device__ __forceinline__ float wave_sum(float v) {
    v = DPP_ADD(v, 0xB1); v = DPP_ADD(v, 0x4E); v = DPP_ADD(v, 0x141); v = DPP_ADD(v, 0x140);
    { auto r = __builtin_amdgcn_permlane16_swap(__float_as_uint(v), __float_as_uint(v), false, false); v = __uint_as_float(r[0]) + __uint_as_float(r[1]); }
    { auto r = __builtin_amdgcn_permlane32_swap(__float_as_uint(v), __float_as_uint(v), false, false); v = __uint_as_float(r[0]) + __uint_as_float(r[1]); }
    return v;
}
__device__ __forceinline__ int opq(int v) { asm volatile("" : "+v"(v)); return v; }
__device__ __forceinline__ int crow(int r, int hi) { return (r & 3) + 8 * (r >> 2) + 4 * hi; }

#define XB_TMO      128
#define XB_XCNT(j)  (256  + 64 * (j))
#define XB_XSUB(j)  (1280 + 64 * (j))
#define XB_XGEN(j)  (2304 + 64 * (j))
#define XB_TOP      3328
#define XB_TOPGEN   3392
#define XCD_BAR_WORDS 3456
#define XB_SPIN_CAP (1u << 18)

__device__ __forceinline__ unsigned xb_ld(unsigned* p)              { return __hip_atomic_load(p, __ATOMIC_RELAXED, __HIP_MEMORY_SCOPE_AGENT); }
__device__ __forceinline__ unsigned xb_add(unsigned* p, unsigned v) { return __hip_atomic_fetch_add(p, v, __ATOMIC_RELAXED, __HIP_MEMORY_SCOPE_AGENT); }
__device__ __forceinline__ unsigned xb_xcc_id() { return (unsigned)__builtin_amdgcn_s_getreg((3 << 11) | 20) & 0xFu; }
#define XB_SPIN(cond, bar) do { unsigned _sp = 0; while (cond) { __builtin_amdgcn_s_sleep(1); \
    if ((++_sp & 255u) == 0u) { if (xb_ld(&(bar)[XB_TMO])) break; if (_sp > XB_SPIN_CAP) { atomicAdd(&(bar)[XB_TMO], 1u); break; } } } } while (0)

struct XcdBarrier {
    unsigned* bar; unsigned x;
    volatile LAS unsigned* st;
};

__device__ __forceinline__ XcdBarrier xcd_barrier_post(unsigned* bar, volatile LAS unsigned* st) {
    XcdBarrier b; b.bar = bar; b.x = xb_xcc_id(); b.st = st;
    if (threadIdx.x == 0) (void)xb_add(&bar[XB_XCNT(b.x)], 1u);
    return b;
}
__device__ __forceinline__ void xcd_barrier_complete(unsigned* bar, unsigned x, unsigned& nloc, unsigned& nx) {
    const unsigned G = gridDim.x * gridDim.y * gridDim.z;
    unsigned sum, cnt, mine, sp = 0u;
    for (;;) {
        sum = 0u; cnt = 0u; mine = 0u;
#pragma unroll
        for (unsigned j = 0; j < 16; ++j) { const unsigned c = xb_ld(&bar[XB_XCNT(j)]); sum += c; cnt += (c > 0u) ? 1u : 0u; mine = (j == x) ? c : mine; }
        if (sum == G) break;
        __builtin_amdgcn_s_sleep(1);
        if ((++sp & 255u) == 0u) { if (xb_ld(&bar[XB_TMO])) break; if (sp > XB_SPIN_CAP) { atomicAdd(&bar[XB_TMO], 1u); break; } }
    }
    nloc = mine > 0u ? mine : 1u; nx = cnt > 0u ? cnt : 1u;
}

__device__ __forceinline__ void xcd_barrier(const XcdBarrier& b) {
    asm volatile("s_waitcnt vmcnt(0)" ::: "memory");
    __syncthreads();
    if (threadIdx.x == 0) {
        unsigned* bar = b.bar;
        __builtin_amdgcn_s_waitcnt(0);
        unsigned nloc = b.st[0], nx = b.st[1];
        if (nloc == 0u) { xcd_barrier_complete(bar, b.x, nloc, nx); b.st[0] = nloc; b.st[1] = nx; }
        const unsigned old = xb_add(&bar[XB_XSUB(b.x)], 1u);
        const unsigned gen = old / nloc;
        if (old + 1u == (gen + 1u) * nloc) {
            __builtin_amdgcn_fence(__ATOMIC_RELEASE, "agent");
            asm volatile("s_waitcnt vmcnt(0)" ::: "memory");
            const unsigned og = xb_add(&bar[XB_TOP], 1u);
            const unsigned tg = og / nx;
            if (og + 1u == (tg + 1u) * nx) xb_add(&bar[XB_TOPGEN], 1u);
            else XB_SPIN(xb_ld(&bar[XB_TOPGEN]) == tg, bar);
            __builtin_amdgcn_fence(__ATOMIC_ACQUIRE, "agent");
            xb_add(&bar[XB_XGEN(b.x)], 1u);
            asm volatile("s_waitcnt vmcnt(0)" ::: "memory");
        } else {
            XB_SPIN(xb_ld(&bar[XB_XGEN(b.x)]) == gen, bar);
            __builtin_amdgcn_fence(__ATOMIC_ACQUIRE, "agent");
            asm volatile("s_waitcnt vmcnt(0)" ::: "memory");
        }
    }
    __syncthreads();
}

struct Args { const float* in[19]; float* out; unsigned char* ws; int ph_lo, ph_hi, li, pad; };
struct Ctx {
    const Args* a; unsigned char* lds;
    int wave;
    __device__ __forceinline__ int G() const { return (int)gridDim.x; }
    __device__ __forceinline__ int vcu() const { const int g = (int)gridDim.x, bx = (int)blockIdx.x; return (g % 8 == 0) ? (bx % 8) * (g / 8) + bx / 8 : bx; }
    __device__ __forceinline__ int gw() const { return vcu() * 8 + wave; }
    __device__ __forceinline__ int NGW() const { return (int)gridDim.x * 8; }
    __device__ __forceinline__ const float* x() const { return a->in[0]; } __device__ __forceinline__ const float* c() const { return a->in[1]; } __device__ __forceinline__ const float* ctxt() const { return a->in[2]; } __device__ __forceinline__ const float* c_ctx() const { return a->in[3]; } __device__ __forceinline__ const float* w_mod() const { return a->in[4]; } __device__ __forceinline__ const float* b_mod() const { return a->in[5]; } __device__ __forceinline__ const float* nmix() const { return a->in[6]; } __device__ __forceinline__ const float* nffn() const { return a->in[7]; } __device__ __forceinline__ const float* w_in() const { return a->in[8]; } __device__ __forceinline__ const float* rpb() const { return a->in[9]; } __device__ __forceinline__ const float* dec_f() const { return a->in[10]; } __device__ __forceinline__ const float* dec_b() const { return a->in[11]; } __device__ __forceinline__ const float* gn_w() const { return a->in[12]; } __device__ __forceinline__ const float* w_out() const { return a->in[13]; } __device__ __forceinline__ const float* w_router() const { return a->in[14]; } __device__ __forceinline__ const float* w_gate() const { return a->in[15]; } __device__ __forceinline__ const float* w_up() const { return a->in[16]; } __device__ __forceinline__ const float* w_down() const { return a->in[17]; } __device__ __forceinline__ const float* fin_w() const { return a->in[18]; }
    __device__ __forceinline__ float* out() const { return a->out; } __device__ __forceinline__ unsigned char* ws() const { return a->ws; }
};

__device__ __forceinline__ void p0_modpart(const Ctx& C, int u0, int ustep) {
    const int TID_ = opq((int)threadIdx.x), LANE_ = TID_ & 63;
    float* sv = (float*)(C.lds + C.wave * 16384);
    float* modp = (float*)(C.ws() + WS_MODP);
    for (int unit = u0; unit < 96 * MOD_KC; unit += ustep) {
        const int nc = unit % 96, kc = unit / 96, n0 = nc * 128 + LANE_ * 2;
        f32x2 a0 = {0.f, 0.f}, a1 = {0.f, 0.f}, a2 = {0.f, 0.f};
        for (int sub = 0; sub < 2048 / MOD_KC / 256; ++sub) {
            const int k0 = kc * (2048 / MOD_KC) + sub * 256;
#pragma unroll
            for (int i = 0; i < 4; ++i) { const int kk = LANE_ + 64 * i, k = k0 + kk;
                sv[kk] = silu_f(C.c()[k]); sv[256 + kk] = silu_f(C.c()[2048 + k]); sv[512 + kk] = silu_f(C.c_ctx()[k]); }
            LDS_WAIT();
            const float* wp = C.w_mod() + (size_t)k0 * NMOD + n0;
            for (int kb = 0; kb < 256; kb += 32) {
                f32x2 w[32];
#pragma unroll
                for (int i = 0; i < 32; ++i) w[i] = __builtin_nontemporal_load((const f32x2*)(wp + (size_t)(kb + i) * NMOD));
#pragma unroll
                for (int i = 0; i < 32; ++i) { const float s0 = sv[kb + i], s1 = sv[256 + kb + i], s2 = sv[512 + kb + i]; a0 += w[i] * s0; a1 += w[i] * s1; a2 += w[i] * s2; }
            }
            LDS_WAIT();
        }
        *(f32x2*)(modp + (size_t)(kc * 3 + 0) * NMOD + n0) = a0; *(f32x2*)(modp + (size_t)(kc * 3 + 1) * NMOD + n0) = a1; *(f32x2*)(modp + (size_t)(kc * 3 + 2) * NMOD + n0) = a2;
    }
}
template <int MODE> __device__ __forceinline__ int orow_map(int n) {
    if (MODE == 1) { const int t = n >> 10; if (t == 2 || t == 5) { const int d = n & 127, a = d >> 6, nn = (d >> 5) & 1, i = d & 31; return (n & ~127) + 32 * (2 * a + (i >> 4)) + 8 * ((i >> 2) & 3) + 4 * nn + (i & 3); } return n; }
    if (MODE == 2) return (n >> 7) * 256 + (n & 127);
    if (MODE == 3) return (n >> 7) * 256 + 128 + (n & 127);
    return n;
}
__device__ __forceinline__ int orow_rt(int mode, int n) { return mode == 1 ? orow_map<1>(n) : mode == 2 ? orow_map<2>(n) : mode == 3 ? orow_map<3>(n) : n; }
constexpr int CONV_I_IN = 32 * 224, CONV_I_OUT = 32 * 64, CONV_I_GU = 16 * 1024, CONV_NITEMS = CONV_I_IN + CONV_I_OUT + 3 * CONV_I_GU, CONV_DEFER = 12 * 1024;
constexpr int CONV_P0_END = CONV_I_IN + 2560, CONV_P8_BEGIN = CONV_NITEMS - CONV_DEFER - 5120;
struct ConvDesc { const float* src; bf16* dst; int N, K, mode, n0; };
__device__ __forceinline__ ConvDesc conv_desc(const Ctx& C, int it) {
    const float* W; bf16* WT; int K, N, mode, item; int r = it;
    if (r < CONV_I_IN) { W = C.w_in(); K = 2048; N = NIN; WT = (bf16*)(C.ws() + WS_WIN); mode = 1; item = r; }
    else if ((r -= CONV_I_IN) < CONV_I_OUT) { W = C.w_out(); K = 2048; N = 2048; WT = (bf16*)(C.ws() + WS_WOUT); mode = 0; item = r; }
    else if ((r -= CONV_I_OUT) < CONV_I_GU) { const int e = r >> 10; W = C.w_gate() + (size_t)e * 2048 * 1024; K = 2048; N = 1024; WT = (bf16*)(C.ws() + WS_WGU) + (size_t)e * 2048 * 2048; mode = 2; item = r & 1023; }
    else if ((r -= CONV_I_GU) < CONV_I_GU) { const int e = r >> 10; W = C.w_up() + (size_t)e * 2048 * 1024; K = 2048; N = 1024; WT = (bf16*)(C.ws() + WS_WGU) + (size_t)e * 2048 * 2048; mode = 3; item = r & 1023; }
    else { r -= CONV_I_GU; const int e = r >> 10; W = C.w_down() + (size_t)e * 1024 * 2048; K = 1024; N = 2048; WT = (bf16*)(C.ws() + WS_WDN) + (size_t)e * 2048 * 1024; mode = 0; item = r & 1023; }
    const int nblk = N / 32, kb = item / nblk, nb = item % nblk, k0 = 64 * kb, n0 = 32 * nb;
    ConvDesc d; d.src = W + (size_t)k0 * N + n0; d.dst = WT + k0; d.N = N; d.K = K; d.mode = mode; d.n0 = n0; return d;
}
template <bool NT> __device__ __forceinline__ void conv_load(const ConvDesc& d, float (&tv)[32], int lane) {
#pragma unroll
    for (int i = 0; i < 8; ++i) { const f32x4* p_ = (const f32x4*)(d.src + (size_t)(8 * i + (lane >> 3)) * d.N + 4 * (lane & 7)); const f32x4 t = NT ? __builtin_nontemporal_load(p_) : *p_; tv[4 * i] = t.x; tv[4 * i + 1] = t.y; tv[4 * i + 2] = t.z; tv[4 * i + 3] = t.w; }
}
__device__ __forceinline__ void conv_store(const ConvDesc& d, const float (&tv)[32], float* scr, int lane) {
#pragma unroll
    for (int i = 0; i < 8; ++i) *(f32x4*)((char*)scr + (8 * i + (lane >> 3)) * 128 + (((lane & 7) ^ i) * 16)) = (f32x4){tv[4 * i], tv[4 * i + 1], tv[4 * i + 2], tv[4 * i + 3]};
    LDS_WAIT();
    const int c = lane & 7;
#pragma unroll
    for (int j = 0; j < 4; ++j) { const int n = (lane >> 3) + 8 * j; const char* s = (const char*)scr + (8 * c) * 128 + (((n >> 2) ^ c) * 16) + (n & 3) * 4;
        v4u o; o.x = cvtpk(*(const float*)(s + 0 * 128), *(const float*)(s + 1 * 128)); o.y = cvtpk(*(const float*)(s + 2 * 128), *(const float*)(s + 3 * 128));
        o.z = cvtpk(*(const float*)(s + 4 * 128), *(const float*)(s + 5 * 128)); o.w = cvtpk(*(const float*)(s + 6 * 128), *(const float*)(s + 7 * 128));
        *(v4u*)(d.dst + (size_t)orow_rt(d.mode, d.n0 + n) * d.K + 8 * c) = o; }
    LDS_WAIT();
}
template <bool NT> __device__ __forceinline__ void conv_run(const Ctx& C, int first, int last, int step, float* scr, int lane) {
    if (first >= last) return;
    ConvDesc d0 = conv_desc(C, first); float t0[32]; conv_load<NT>(d0, t0, lane);
    const int i1 = (first + step < last) ? first + step : first;
    ConvDesc d1 = conv_desc(C, i1); float t1[32]; conv_load<NT>(d1, t1, lane);
    for (int it = first; it < last; it += step) {
        const int nx = (it + 2 * step < last) ? it + 2 * step : it;
        const ConvDesc d2 = conv_desc(C, nx); float t2[32]; conv_load<NT>(d2, t2, lane);
        conv_store(d0, t0, scr, lane);
        d0 = d1; d1 = d2;
#pragma unroll
        for (int i = 0; i < 32; ++i) { t0[i] = t1[i]; t1[i] = t2[i]; }
    }
}
__device__ __forceinline__ bool conv_split(const Ctx& C) { return (C.G() & 15) == 0; }
__device__ __forceinline__ void conv_p3(const Ctx& C, int cblk, int ncblk) {
    const int LANE_ = opq((int)threadIdx.x) & 63;
    conv_run<false>(C, CONV_P0_END + cblk * NWAVES + C.wave, CONV_P8_BEGIN, ncblk * NWAVES, (float*)(C.lds + C.wave * 16384), LANE_);
}
__device__ __forceinline__ void conv_p8(const Ctx& C) {
    const int LANE_ = opq((int)threadIdx.x) & 63; const int bx = (int)blockIdx.x, G = C.G();
    const int first_blk = G > NB * NEXP ? NB * NEXP : 0; if (bx < first_blk) return;
    conv_run<false>(C, CONV_P8_BEGIN + (bx - first_blk) * NWAVES + C.wave, CONV_NITEMS - CONV_DEFER, (G - first_blk) * NWAVES, (float*)(C.lds + C.wave * 16384), LANE_);
}
__device__ __forceinline__ void conv_deferred(const Ctx& C, int nunits) {
    const int LANE_ = opq((int)threadIdx.x) & 63;
    const int G = C.G(), rounds = (nunits + G - 1) / G; int cfirst = nunits - (rounds - 1) * G; if (cfirst >= G) cfirst = 0;
    const int bx = (int)blockIdx.x; if (bx < cfirst) return;
    const int nw = (G - cfirst) * NWAVES, lw = (bx - cfirst) * NWAVES + C.wave;
    conv_run<false>(C, CONV_NITEMS - CONV_DEFER + lw, CONV_NITEMS, nw, (float*)(C.lds + C.wave * 16384), LANE_);
}
__device__ __forceinline__ void p0_prologue(const Ctx& C) {
    const int TID_ = opq((int)threadIdx.x), LANE_ = TID_ & 63;
    const int gw = C.gw(), r8 = gw & 7, g8 = gw >> 3, n8 = C.NGW() >> 3;
    const bool host = r8 < 3;
#ifndef PROBE_P0G
#define PROBE_P0G 1
#endif
#ifndef PROBE_P0C
#define PROBE_P0C 1
#endif
    if (host) { for (int pr_ = 0; pr_ < PROBE_P0G; ++pr_) p0_modpart(C, g8 * 3 + r8, n8 * 3); }
    const int tw = g8 * 5 + (r8 - 3), ntw = n8 * 5;
    float* scr = (float*)(C.lds + C.wave * 16384);
    if (!host) { for (int pr_ = 0; pr_ < PROBE_P0C; ++pr_) conv_run<true>(C, tw, conv_split(C) ? CONV_P0_END : CONV_P8_BEGIN, ntw, scr, LANE_); }
    if (blockIdx.x == 0) { float* rc = (float*)(C.ws() + WS_ROPE); float* rs = rc + 2048;
        for (int i = TID_; i < 2048; i += NWAVES * 64) { const int pos = i >> 5, f = i & 31; const float inv = powf(10000.0f, -(float)(2 * f) / 64.0f); const float ang = (float)pos * inv; rc[i] = cosf(ang); rs[i] = sinf(ang); } }
}

__device__ __forceinline__ void p1_rows(const Ctx& C) {
    const int TID_ = opq((int)threadIdx.x), LANE_ = TID_ & 63;
    float* tab = (float*)C.lds;
    const int m0 = C.gw(); f32x4 v[8];
    { const int mq = m0 < MALL ? m0 : 0; const float* src0 = mq < MLAT ? C.x() + (size_t)mq * DM : C.ctxt() + (size_t)(mq - MLAT) * DM;
#pragma unroll
      for (int j = 0; j < 8; ++j) v[j] = __builtin_nontemporal_load((const f32x4*)src0 + LANE_ + 64 * j); }
    const float* modp = (const float*)(C.ws() + WS_MODP);
#pragma unroll
    for (int hh = 0; hh < 2; ++hh) { f32x4 tv[3];
#pragma unroll
      for (int i = 0; i < 3; ++i) { const int q = TID_ + 512 * (3 * hh + i), r = q >> 10, n4 = (q & 1023) * 4; tv[i] = *(const f32x4*)(C.b_mod() + n4);
#pragma unroll
          for (int kc = 0; kc < MOD_KC; ++kc) tv[i] += *(const f32x4*)(modp + (size_t)(kc * 3 + r) * NMOD + n4); }
#pragma unroll
      for (int i = 0; i < 3; ++i) { const int q = TID_ + 512 * (3 * hh + i); *(f32x4*)(tab + q * 4) = tv[i]; } }
    { const int g = blockIdx.x * (NWAVES * 64) + TID_; float* mod = (float*)(C.ws() + WS_MOD);
      for (int q = g; q < 3 * NMOD; q += C.G() * NWAVES * 64) { const int r = q / NMOD, n = q % NMOD; float v = C.b_mod()[n];
#pragma unroll
          for (int kc = 0; kc < MOD_KC; ++kc) v += modp[(size_t)(kc * 3 + r) * NMOD + n];
          mod[q] = v; } }
    __syncthreads();
    bf16* U = (bf16*)(C.ws() + WS_U);
    for (int m = m0; m < MALL; m += C.NGW()) {
        const int r = m < MLAT ? (m >> 12) : 2; const int mn = m + C.NGW();
        f32x4 vn[8];
        { const int mq = mn < MALL ? mn : m; const float* srcn = mq < MLAT ? C.x() + (size_t)mq * DM : C.ctxt() + (size_t)(mq - MLAT) * DM;
#pragma unroll
          for (int j = 0; j < 8; ++j) vn[j] = __builtin_nontemporal_load((const f32x4*)srcn + LANE_ + 64 * j); }
        float s = 0.f;
#pragma unroll
        for (int j = 0; j < 8; ++j) s += (v[j].x * v[j].x + v[j].y * v[j].y) + (v[j].z * v[j].z + v[j].w * v[j].w);
        const float rstd = 1.0f / sqrtf(wave_sum(s) * (1.0f / DM) + EPS);
#pragma unroll
        for (int j = 0; j < 8; ++j) { const int col = (LANE_ + 64 * j) * 4; const f32x4 nw = *(const f32x4*)(C.nmix() + col), sh = *(const f32x4*)(tab + r * 4096 + col), sc = *(const f32x4*)(tab + r * 4096 + 2048 + col);
            const f32x4 u = (v[j] * rstd * nw) * (sc + 1.0f) + sh; v2u o; o.x = cvtpk(u.x, u.y); o.y = cvtpk(u.z, u.w); *(v2u*)(U + (size_t)m * DM + col) = o; }
#pragma unroll
        for (int j = 0; j < 8; ++j) v[j] = vn[j];
    }
    __syncthreads();
}

namespace na {
constexpr float SCALE = 0.088388347648318440f, THR = 8.f;
constexpr int LD = NIN, KVBLK = 64, NT = 16;
constexpr int SHM_V = 16384, SHM_K = 16384, OFF_WS = 65536, OFF_TAB = 65536 + 2048;
#define KSWZ(row, colB) ((row) * 256 + ((colB) ^ (((row) & 7) << 4)))
__device__ __forceinline__ bf16x8 ld8(const bf16* p) { return *reinterpret_cast<const bf16x8*>(p); }
__device__ __forceinline__ void partialSM(f32x16& p0, f32x16& p1, float& m_reg, float& mn, float& alpha) {
  constexpr float C = SCALE * 1.4426950408889634f;
  float pmax = p0[0];
#pragma unroll
  for (int r = 1; r < 16; ++r) pmax = fmaxf(pmax, p0[r]);
#pragma unroll
  for (int r = 0; r < 16; ++r) pmax = fmaxf(pmax, p1[r]);
  { auto rr = __builtin_amdgcn_permlane32_swap(__float_as_uint(pmax), __float_as_uint(pmax), false, false);
    pmax = fmaxf(__uint_as_float(rr[0]), __uint_as_float(rr[1])); }
  if (__builtin_expect(__all(pmax - m_reg <= THR / SCALE), 1)) { mn = m_reg; alpha = 1.f; }
  else { mn = fmaxf(m_reg, pmax); alpha = __builtin_amdgcn_exp2f((m_reg - mn) * C); m_reg = mn; }
  float mnC = -mn * C;
#pragma unroll
  for (int r = 0; r < 16; ++r) p0[r] = fmaf(p0[r], C, mnC);
#pragma unroll
  for (int r = 0; r < 16; ++r) p1[r] = fmaf(p1[r], C, mnC);
#pragma unroll
  for (int r = 0; r < 16; ++r) p0[r] = __builtin_amdgcn_exp2f(p0[r]);
}
#define NA_PK4(P, BASE, OUT) do { unsigned a0 = cvtpk(P[BASE + 0], P[BASE + 1]), a1 = cvtpk(P[BASE + 2], P[BASE + 3]);   \
    unsigned b0 = cvtpk(P[BASE + 4], P[BASE + 5]), b1 = cvtpk(P[BASE + 6], P[BASE + 7]);                              \
    auto r0 = __builtin_amdgcn_permlane32_swap(a0, b0, false, false); auto r1 = __builtin_amdgcn_permlane32_swap(a1, b1, false, false); \
    v4u w = {r0[0], r1[0], r0[1], r1[1]}; OUT = *reinterpret_cast<bf16x8*>(&w); } while (0)
__device__ __forceinline__ void finishSM(f32x16& p0, f32x16& p1, float alpha, float& l_reg, bf16x8& pa0, bf16x8& pa1, bf16x8& pa2, bf16x8& pa3) {
#pragma unroll
  for (int r = 0; r < 16; ++r) p1[r] = __builtin_amdgcn_exp2f(p1[r]);
  float ps = 0;
#pragma unroll
  for (int r = 0; r < 16; ++r) ps += p0[r];
#pragma unroll
  for (int r = 0; r < 16; ++r) ps += p1[r];
  { auto rr = __builtin_amdgcn_permlane32_swap(__float_as_uint(ps), __float_as_uint(ps), false, false);
    ps = __uint_as_float(rr[0]) + __uint_as_float(rr[1]); }
  l_reg = l_reg * alpha + ps;
  NA_PK4(p0, 0, pa0); NA_PK4(p0, 8, pa1); NA_PK4(p1, 0, pa2); NA_PK4(p1, 8, pa3);
}
__device__ __forceinline__ void qkt(f32x16& p0, f32x16& p1, const bf16* Ks, const bf16x8* qr, int r32, int hi) {
  p0 = f32x16{}; p1 = f32x16{};
#pragma unroll
  for (int d0 = 0; d0 < 8; ++d0) { int cb = (d0 * 16 + hi * 8) * 2;
    bf16x8 b0 = *reinterpret_cast<const bf16x8*>((const char*)Ks + KSWZ(r32, cb));
    bf16x8 b1 = *reinterpret_cast<const bf16x8*>((const char*)Ks + KSWZ(32 + r32, cb));
    p0 = __builtin_amdgcn_mfma_f32_32x32x16_bf16(b0, qr[d0], p0, 0, 0, 0);
    p1 = __builtin_amdgcn_mfma_f32_32x32x16_bf16(b1, qr[d0], p1, 0, 0, 0); }
}
__device__ __forceinline__ int v_st(int k, int c) { const int kk = (k & ~0xC) | ((k & 4) << 1) | ((k & 8) >> 1); return ((kk >> 3) * 4 + (c >> 5)) * 512 + ((kk & 7) * 32 + (c & 31)) * 2; }
__device__ __forceinline__ int v_rd_base(int lane) { return ((lane & 3) << 3) | (((lane >> 2) & 3) << 6) | (((lane >> 4) & 1) << 5) | (((lane >> 5) & 1) << 8); }
constexpr int v_rd_off(int d0, int ks, int half) { return d0 * 512 + ks * 4096 + half * 2048; }
template <int OFF> __device__ __forceinline__ s16x4 tr_read(int vb) {
  s16x4 r; asm volatile("ds_read_b64_tr_b16 %0, %1 offset:%2" : "=&v"(r) : "v"(vb), "i"(OFF) : "memory"); return r;
}
template <int D0> __device__ __forceinline__ void pv_one(f32x16& od, int vb, bf16x8 pa0, bf16x8 pa1, bf16x8 pa2, bf16x8 pa3) {
  const s16x4 l0 = tr_read<v_rd_off(D0, 0, 0)>(vb), h0 = tr_read<v_rd_off(D0, 0, 1)>(vb), l1 = tr_read<v_rd_off(D0, 1, 0)>(vb), h1 = tr_read<v_rd_off(D0, 1, 1)>(vb);
  const s16x4 l2 = tr_read<v_rd_off(D0, 2, 0)>(vb), h2 = tr_read<v_rd_off(D0, 2, 1)>(vb), l3 = tr_read<v_rd_off(D0, 3, 0)>(vb), h3 = tr_read<v_rd_off(D0, 3, 1)>(vb);
  asm volatile("s_waitcnt lgkmcnt(0)" ::: "memory"); SBAR();
#define NA_PK(L, H) (bf16x8){L[0], L[1], L[2], L[3], H[0], H[1], H[2], H[3]}
  od = __builtin_amdgcn_mfma_f32_32x32x16_bf16(pa0, NA_PK(l0, h0), od, 0, 0, 0);
  od = __builtin_amdgcn_mfma_f32_32x32x16_bf16(pa1, NA_PK(l1, h1), od, 0, 0, 0);
  od = __builtin_amdgcn_mfma_f32_32x32x16_bf16(pa2, NA_PK(l2, h2), od, 0, 0, 0);
  od = __builtin_amdgcn_mfma_f32_32x32x16_bf16(pa3, NA_PK(l3, h3), od, 0, 0, 0);
}
__device__ __forceinline__ void pv_d0(f32x16* o, int vb, bf16x8 pa0, bf16x8 pa1, bf16x8 pa2, bf16x8 pa3) {
  pv_one<0>(o[0], vb, pa0, pa1, pa2, pa3); pv_one<1>(o[1], vb, pa0, pa1, pa2, pa3); pv_one<2>(o[2], vb, pa0, pa1, pa2, pa3); pv_one<3>(o[3], vb, pa0, pa1, pa2, pa3);
}
__device__ __forceinline__ void na_bias(f32x16& p0, f32x16& p1, int j, int kr_lo, int r, int rs, const float* trow, float pen_a, float pen_b, float pen_c) {
  if (j < 4) return;
  const int kr = kr_lo + j - 4; const bool inwin = (kr >= rs) && (kr < rs + 8); const float NEG = -1e30f;
  if (inwin) {
    const float* brow = trow + (kr - r + 7) * 128;
#pragma unroll
    for (int e = 0; e < 16; ++e) { const int k0 = (e & 3) + 8 * (e >> 2); p0[e] = (p0[e] + brow[k0]) + (e < 8 ? pen_a : pen_b); }
    SBAR();
#pragma unroll
    for (int e = 0; e < 16; ++e) { const int k0 = (e & 3) + 8 * (e >> 2); p1[e] = (p1[e] + brow[k0 + 32]) + (e < 8 ? pen_b : pen_c); }
  } else {
#pragma unroll
    for (int e = 0; e < 16; ++e) { p0[e] = NEG; p1[e] = NEG; }
  }
}
__device__ __forceinline__ void na_unit(const bf16* __restrict__ QKV, bf16* __restrict__ MIX, const float* __restrict__ rpb, int b, int h, int rg, char* lds) {
  const int tid = opq((int)threadIdx.x), wid = __builtin_amdgcn_readfirstlane(tid >> 6), lane = tid & 63, r32 = lane & 31, hi = lane >> 5;
  bf16* V_lds = (bf16*)lds; bf16* K_lds = (bf16*)(lds + 2 * SHM_V);
  float* ws = (float*)(lds + OFF_WS) + wid * 64; float* li_l = ws; float* al_l = ws + 32;
  float* tab = (float*)(lds + OFF_TAB);
  for (int i = tid; i < 2 * 15 * 128; i += 512) { const int t = i / 1920, q = i - t * 1920, ro = q >> 7, xx = (q & 127) - 48;
    const bool inr = t == 0 ? (xx >= 7 && xx <= 22) : (xx >= 0 && xx <= 30);
    tab[i] = inr ? rpb[h * 465 + ro * 31 + xx] * (1.f / SCALE) : (t == 0 ? -1e30f : 0.f); }
  const int r = 4 * rg + (wid >> 1), cq = 32 * (wid & 1) + r32;
  const int rs = min(max(r - 4, 0), 56), kr_lo = min(max(4 * rg - 4, 0), 52);
  const bool edgeL = cq < 8, edgeR = cq > 56; const float penL = edgeL ? -1e30f : 0.f, penR = edgeR ? -1e30f : 0.f;
  const float pen_a = penR, pen_b = penL + penR, pen_c = penL;
  const float* trow = tab + ((edgeL || edgeR) ? 1920 : 0) + 63 - cq + 4 * hi;
  const long rowc = MLAT + b * CTXL, rowl = (long)b * SEQ + kr_lo * 64;
#define NA_TROW(j) ((j) < 4 ? rowc + 64 * (j) : rowl + 64 * ((j) - 4))
  const bf16* Kh = QKV + h * 128; const bf16* Vh = QKV + 1024 + h * 128;
  float m_reg = -1e30f, l_reg = 0; f32x16 o[4] = {}; bf16x8 qr[8];
  const bf16* Qw = QKV + (long)(b * SEQ + rg * 256 + wid * 32 + r32) * LD + 4096 + h * 128 + hi * 8;
#pragma unroll
  for (int d0 = 0; d0 < 8; ++d0) qr[d0] = ld8(Qw + d0 * 16);
  const int sr = tid >> 4, sc = (tid & 15) * 8, vst0 = v_st(sr, sc), vst1 = v_st(32 + sr, sc);
  const int vb0 = (int)(uintptr_t)V_lds + v_rd_base(lane);
  struct { bf16x8 vs0, vs1, ks0, ks1; } sr_[2];
#define NA_SLOAD(i, j) do { const long t0_ = NA_TROW(j); sr_[i].vs0 = ld8(&Vh[(t0_ + sr) * LD + sc]); sr_[i].vs1 = ld8(&Vh[(t0_ + 32 + sr) * LD + sc]); \
    sr_[i].ks0 = ld8(&Kh[(t0_ + sr) * LD + sc]); sr_[i].ks1 = ld8(&Kh[(t0_ + 32 + sr) * LD + sc]); } while (0)
#define NA_SWRITE(bb, i) do { *(bf16x8*)((char*)V_lds + (bb) * SHM_V + vst0) = sr_[i].vs0;          \
    *(bf16x8*)((char*)V_lds + (bb) * SHM_V + vst1) = sr_[i].vs1; int kc = sc * 2;               \
    *(bf16x8*)((char*)K_lds + (bb) * SHM_K + KSWZ(sr, kc)) = sr_[i].ks0;                       \
    *(bf16x8*)((char*)K_lds + (bb) * SHM_K + KSWZ(32 + sr, kc)) = sr_[i].ks1; } while (0)
#define NA_SWAIT() asm volatile("s_waitcnt vmcnt(4)" ::: "memory")
#define NA_RESC(a) do { if (__any((a) < 1.f)) { if (hi == 0) al_l[r32] = (a); asm volatile("s_waitcnt lgkmcnt(0)" ::: "memory"); \
    _Pragma("unroll") for (int d = 0; d < 4; ++d) _Pragma("unroll") for (int rr_ = 0; rr_ < 16; ++rr_) o[d][rr_] *= al_l[crow(rr_, hi)]; } } while (0)
#define NA_BIAS(P0, P1, j) do { SBAR(); na_bias(P0, P1, (j), kr_lo, r, rs, trow, pen_a, pen_b, pen_c); SBAR(); } while (0)
  f32x16 pA0, pA1, pB0, pB1; float mnA, mnB, alA, alB; bf16x8 pa0, pa1, pa2, pa3;
  constexpr int SE = 0, SO = 1;
  NA_SLOAD(SE, 0); asm volatile("s_waitcnt vmcnt(0)" ::: "memory"); NA_SWRITE(0, SE); __syncthreads();
  qkt(pA0, pA1, K_lds, qr, r32, hi); partialSM(pA0, pA1, m_reg, mnA, alA);
  NA_SLOAD(SO, 1); NA_SLOAD(SE, 2);
  NA_SWAIT(); NA_SWRITE(1, SO); __syncthreads();
  for (int j = 1; j + 1 < NT; j += 2) {
    SBAR(); qkt(pB0, pB1, (bf16*)((char*)K_lds + SHM_K), qr, r32, hi);
    finishSM(pA0, pA1, alA, l_reg, pa0, pa1, pa2, pa3); SBAR();
    NA_SLOAD(SO, j + 2); SBAR();
    pv_d0(o, vb0, pa0, pa1, pa2, pa3); NA_BIAS(pB0, pB1, j); partialSM(pB0, pB1, m_reg, mnB, alB);
    __syncthreads(); NA_SWAIT(); NA_SWRITE(0, SE);
    NA_RESC(alB); __syncthreads();
    SBAR(); qkt(pA0, pA1, K_lds, qr, r32, hi);
    finishSM(pB0, pB1, alB, l_reg, pa0, pa1, pa2, pa3); SBAR();
    if (j + 3 < NT) NA_SLOAD(SE, j + 3); SBAR();
    pv_d0(o, vb0 + SHM_V, pa0, pa1, pa2, pa3); NA_BIAS(pA0, pA1, j + 1); partialSM(pA0, pA1, m_reg, mnA, alA);
    __syncthreads(); NA_SWAIT(); NA_SWRITE(1, SO);
    NA_RESC(alA); __syncthreads();
  }
  SBAR(); qkt(pB0, pB1, (bf16*)((char*)K_lds + SHM_K), qr, r32, hi);
  finishSM(pA0, pA1, alA, l_reg, pa0, pa1, pa2, pa3); SBAR();
  pv_d0(o, vb0, pa0, pa1, pa2, pa3); NA_BIAS(pB0, pB1, NT - 1); partialSM(pB0, pB1, m_reg, mnB, alB);
  __syncthreads(); NA_RESC(alB);
  finishSM(pB0, pB1, alB, l_reg, pa0, pa1, pa2, pa3); SBAR();
  pv_d0(o, vb0 + SHM_V, pa0, pa1, pa2, pa3);
  if (hi == 0) li_l[r32] = l_reg; asm volatile("s_waitcnt lgkmcnt(0)" ::: "memory");
  float rli[16];
#pragma unroll
  for (int rr_ = 0; rr_ < 16; ++rr_) rli[rr_] = __builtin_amdgcn_rcpf(li_l[crow(rr_, hi)]);
  bf16* Ow = MIX + (long)(b * SEQ + rg * 256 + wid * 32) * DM + h * 128;
#pragma unroll
  for (int rr_ = 0; rr_ < 16; ++rr_) { const int orow = crow(rr_, hi);
#pragma unroll
    for (int d0 = 0; d0 < 4; d0 += 1) { const unsigned pk = cvtpk(o[d0][rr_] * rli[rr_], 0.f); Ow[(long)orow * DM + d0 * 32 + r32] = (bf16)(pk & 0xffffu); } }
  __syncthreads();
#undef NA_SLOAD
#undef NA_SWRITE
#undef NA_SWAIT
#undef NA_RESC
#undef NA_BIAS
#undef NA_TROW
}
}

namespace ret {
typedef const LAS char* lds_cptr;
typedef short v4i16_t __attribute__((ext_vector_type(4)));
__device__ __forceinline__ s16x4 vtr(lds_cptr p) { return __builtin_bit_cast(s16x4, __builtin_amdgcn_ds_read_tr16_b64_v4i16((LAS v4i16_t*)p)); }
__device__ __forceinline__ bf16x8 tr_frag(lds_cptr base, int pitchB, int t0, int c0, int lane) {
    const int g = lane >> 4, q = (lane & 15) >> 2, p = lane & 3;
    lds_cptr a = base + (t0 + 8 * (g >> 1) + q) * pitchB + (c0 + 16 * (g & 1) + 4 * p) * 2;
    const s16x4 lo = vtr(a), hi4 = vtr(a + 4 * pitchB);
    return (bf16x8){lo[0], lo[1], lo[2], lo[3], hi4[0], hi4[1], hi4[2], hi4[3]};
}
__device__ __forceinline__ bf16x8 scale_frag8(bf16x8 a, f32x4 w0, f32x4 w1) {
    const v4u x = __builtin_bit_cast(v4u, a); v4u o;
    o.x = cvtpk(__builtin_bit_cast(float, x.x << 16) * w0.x, __builtin_bit_cast(float, x.x & 0xffff0000u) * w0.y);
    o.y = cvtpk(__builtin_bit_cast(float, x.y << 16) * w0.z, __builtin_bit_cast(float, x.y & 0xffff0000u) * w0.w);
    o.z = cvtpk(__builtin_bit_cast(float, x.z << 16) * w1.x, __builtin_bit_cast(float, x.z & 0xffff0000u) * w1.y);
    o.w = cvtpk(__builtin_bit_cast(float, x.w << 16) * w1.z, __builtin_bit_cast(float, x.w & 0xffff0000u) * w1.w);
    return __builtin_bit_cast(bf16x8, o);
}
__device__ __forceinline__ bf16x8 scale_frag1(bf16x8 a, float w) { const f32x4 w4 = {w, w, w, w}; return scale_frag8(a, w4, w4); }

constexpr int KV_PITCH = 320;
constexpr int KV_OFF_K = 0, KV_OFF_V = 128 * KV_PITCH, KV_OFF_W = 2 * 128 * KV_PITCH;
__device__ __forceinline__ void kv_item(const Ctx& C, int b, int h, int c) {
    const int TID_ = opq((int)threadIdx.x), LANE_ = TID_ & 63;
    const bf16* QKV = (const bf16*)(C.ws() + WS_QKV); bf16* KVB = (bf16*)(C.ws() + WS_KV);
    char* lds = (char*)C.lds; const int tid = TID_, lane = LANE_, wid = C.wave, r32 = lane & 31, hi = lane >> 5;
    const long rowbase = c < 2 ? (long)MLAT + b * CTXL + c * 128 : (long)b * SEQ + (c - 2) * 128;
    float* wt = (float*)(lds + KV_OFF_W);
    if (tid < 256) { const int d = tid >> 7, t = tid & 127; const float lg = log_sigmoid_f(d ? C.dec_b()[h] : C.dec_f()[h]); wt[tid] = expf(lg * (float)(d ? t : 127 - t)); }
#pragma unroll
    for (int i = 0; i < 4; ++i) { const int piece = tid + 512 * i, row = piece >> 4, cc = piece & 15;
        const bf16* src = QKV + (rowbase + row) * NIN + h * 128 + cc * 8;
        const v4u kx = *(const v4u*)(src + 2048), vx = *(const v4u*)(src + 3072);
        *(v4u*)(lds + KV_OFF_K + row * KV_PITCH + cc * 16) = kx; *(v4u*)(lds + KV_OFF_V + row * KV_PITCH + cc * 16) = vx; }
    __syncthreads();
    const lds_cptr Kb = (lds_cptr)(lds + KV_OFF_K), Vb = (lds_cptr)(lds + KV_OFF_V);
    const int dvb = wid & 3, dk0 = 2 * (wid >> 2);
    f32x16 acc[2][2] = {};
#pragma unroll
    for (int ks = 0; ks < 8; ++ks) {
        const bf16x8 v = tr_frag(Vb, KV_PITCH, 16 * ks, 32 * dvb, lane);
        const f32x4 wf0 = *(const f32x4*)(wt + 16 * ks + 8 * hi), wf1 = *(const f32x4*)(wt + 16 * ks + 8 * hi + 4);
        const f32x4 wb0 = *(const f32x4*)(wt + 128 + 16 * ks + 8 * hi), wb1 = *(const f32x4*)(wt + 128 + 16 * ks + 8 * hi + 4);
        const bf16x8 vf = scale_frag8(v, wf0, wf1), vb = scale_frag8(v, wb0, wb1);
#pragma unroll
        for (int d = 0; d < 2; ++d) { const bf16x8 kf = tr_frag(Kb, KV_PITCH, 16 * ks, 32 * (dk0 + d), lane);
            acc[0][d] = __builtin_amdgcn_mfma_f32_32x32x16_bf16(kf, vf, acc[0][d], 0, 0, 0);
            acc[1][d] = __builtin_amdgcn_mfma_f32_32x32x16_bf16(kf, vb, acc[1][d], 0, 0, 0); }
    }
#pragma unroll
    for (int dir = 0; dir < 2; ++dir)
#pragma unroll
        for (int d = 0; d < 2; ++d) { bf16* dst = KVB + ((size_t)(((b * 8 + h) * 2 + dir) * 34 + c)) * 16384 + (size_t)(32 * dvb + r32) * 128 + 32 * (dk0 + d) + 4 * hi;
#pragma unroll
            for (int g = 0; g < 4; ++g) { v2u o; o.x = cvtpk(acc[dir][d][4 * g], acc[dir][d][4 * g + 1]); o.y = cvtpk(acc[dir][d][4 * g + 2], acc[dir][d][4 * g + 3]); *(v2u*)(dst + 8 * g) = o; } }
    __syncthreads();
}

__device__ __forceinline__ void scan_phase(const Ctx& C) {
    const int TID_ = opq((int)threadIdx.x), LANE_ = TID_ & 63;
    const bf16* KVB = (const bf16*)(C.ws() + WS_KV); bf16* ST = (bf16*)(C.ws() + WS_ST);
    for (int g = blockIdx.x * (NWAVES * 64) + TID_; g < 32 * 4096; g += C.G() * NWAVES * 64) {
        const int grp = g >> 12, e4 = g & 4095, h = (grp >> 1) & 7, dir = grp & 1;
        const float G = expf(128.0f * log_sigmoid_f(dir ? C.dec_b()[h] : C.dec_f()[h]));
        const v2u* kv = (const v2u*)(KVB + (size_t)grp * 34 * 16384) + e4;
        bf16* st = ST + (size_t)grp * 32 * 16384 + e4 * 4;
#define KV4(c_) ({ const v2u t_ = kv[(size_t)(c_) * 4096]; (f32x4){__builtin_bit_cast(float, t_.x << 16), __builtin_bit_cast(float, t_.x & 0xffff0000u), __builtin_bit_cast(float, t_.y << 16), __builtin_bit_cast(float, t_.y & 0xffff0000u)}; })
        f32x4 S;
        if (dir == 0) {
            S = KV4(0) * G + KV4(1); { v2u o; o.x = cvtpk(S.x, S.y); o.y = cvtpk(S.z, S.w); *(v2u*)(st) = o; }
#pragma unroll 4
            for (int n = 0; n < 31; ++n) { S = S * G + KV4(n + 2); v2u o; o.x = cvtpk(S.x, S.y); o.y = cvtpk(S.z, S.w); *(v2u*)(st + (size_t)(n + 1) * 16384) = o; }
        } else {
            S = KV4(0) + KV4(1) * G; { v2u o; o.x = cvtpk(S.x, S.y); o.y = cvtpk(S.z, S.w); *(v2u*)(st + (size_t)31 * 16384) = o; }
#pragma unroll 4
            for (int n = 31; n >= 1; --n) { S = S * G + KV4(n + 2); v2u o; o.x = cvtpk(S.x, S.y); o.y = cvtpk(S.z, S.w); *(v2u*)(st + (size_t)(n - 1) * 16384) = o; }
        }
#undef KV4
    }
}

constexpr int RO_OFF_K = 0, RO_OFF_V = 32768, RO_OFF_SF = 65536, RO_OFF_SB = 98304, RO_OFF_ST = 131072;
__device__ __forceinline__ void ro_item(const Ctx& C, int b, int h, int n) {
    const int TID_ = opq((int)threadIdx.x), LANE_ = TID_ & 63;
    const bf16* QKV = (const bf16*)(C.ws() + WS_QKV); const bf16* ST = (const bf16*)(C.ws() + WS_ST); bf16* MIX = (bf16*)(C.ws() + WS_MIX);
    char* lds = (char*)C.lds; const int tid = TID_, lane = LANE_, wid = C.wave, r32 = lane & 31, hi = lane >> 5;
    const long rowbase = (long)b * SEQ + n * 128;
    const int ib = wid & 3, dh = wid >> 2, iq = 32 * ib + r32;
    bf16x8 qr[8];
    { const bf16* Qw = QKV + (rowbase + iq) * NIN + 5120 + h * 128 + hi * 8;
#pragma unroll
      for (int d0 = 0; d0 < 8; ++d0) qr[d0] = *(const bf16x8*)(Qw + d0 * 16); }
    unsigned gsp[16];
#pragma unroll
    for (int e = 0; e < 16; ++e) { const bf16* gp = QKV + (rowbase + 32 * ib + crow(e, hi)) * NIN + 6144 + h * 128 + 32 * (2 * dh) + r32; gsp[e] = (unsigned)gp[0] | ((unsigned)gp[32] << 16); }
    { const int sr = tid >> 4, sc = (tid & 15) * 8;
#pragma unroll
      for (int i = 0; i < 4; ++i) { const int row = sr + 32 * i; const bf16* src = QKV + (rowbase + row) * NIN + h * 128 + sc;
          const bf16x8 kx = *(const bf16x8*)(src + 2048), vx = *(const bf16x8*)(src + 3072);
          *(bf16x8*)(lds + RO_OFF_K + KSWZ(row, sc * 2)) = kx; *(bf16x8*)(lds + RO_OFF_V + (row >> 6) * 16384 + na::v_st(row & 63, sc)) = vx; }
      const bf16* Sf = ST + ((size_t)(((b * 8 + h) * 2 + 0) * 32 + n)) * 16384; const bf16* Sb = ST + ((size_t)(((b * 8 + h) * 2 + 1) * 32 + n)) * 16384;
#pragma unroll
      for (int i = 0; i < 4; ++i) { const int row = sr + 32 * i; const bf16x8 fx = *(const bf16x8*)(Sf + row * 128 + sc), bx = *(const bf16x8*)(Sb + row * 128 + sc);
          *(bf16x8*)(lds + RO_OFF_SF + KSWZ(row, sc * 2)) = fx; *(bf16x8*)(lds + RO_OFF_SB + KSWZ(row, sc * 2)) = bx; } }
    __syncthreads();
    const float L2E = 1.4426950408889634f; const float lf2 = log_sigmoid_f(C.dec_f()[h]) * L2E, lb2 = log_sigmoid_f(C.dec_b()[h]) * L2E;
    f32x16 o[2] = {};
#pragma unroll
    for (int tile = 0; tile < 2; ++tile) {
        f32x16 p0 = {}, p1 = {};
        const char* Ks = lds + RO_OFF_K;
#pragma unroll
        for (int d0 = 0; d0 < 8; ++d0) { const int cb = (d0 * 16 + hi * 8) * 2;
            const bf16x8 k0 = *(const bf16x8*)(Ks + KSWZ(64 * tile + r32, cb)), k1 = *(const bf16x8*)(Ks + KSWZ(64 * tile + 32 + r32, cb));
            p0 = __builtin_amdgcn_mfma_f32_32x32x16_bf16(k0, qr[d0], p0, 0, 0, 0);
            p1 = __builtin_amdgcn_mfma_f32_32x32x16_bf16(k1, qr[d0], p1, 0, 0, 0); }
        SBAR();
        { int dbi = iq - 64 * tile - 4 * hi; asm volatile("" : "+v"(dbi)); const float dbase = (float)dbi;
#pragma unroll
          for (int e = 0; e < 16; ++e) {
            const float d0_ = dbase - (float)((e & 3) + 8 * (e >> 2)), d1_ = d0_ - 32.0f;
            float f0 = __builtin_amdgcn_exp2f(lf2 * fmaxf(d0_, 0.f) + lb2 * fmaxf(-d0_, 0.f)), f1 = __builtin_amdgcn_exp2f(lf2 * fmaxf(d1_, 0.f) + lb2 * fmaxf(-d1_, 0.f));
            f0 = fmaf(f0, fmaxf(1.0f - fabsf(d0_), 0.f), f0); f1 = fmaf(f1, fmaxf(1.0f - fabsf(d1_), 0.f), f1);
            p0[e] *= f0; p1[e] *= f1; } }
        SBAR();
        bf16x8 pa0, pa1, pa2, pa3;
        NA_PK4(p0, 0, pa0); NA_PK4(p0, 8, pa1); NA_PK4(p1, 0, pa2); NA_PK4(p1, 8, pa3);
        const int vb = (int)(uintptr_t)(lds + RO_OFF_V + tile * 16384) + na::v_rd_base(lane);
        if (dh == 0) { na::pv_one<0>(o[0], vb, pa0, pa1, pa2, pa3); na::pv_one<1>(o[1], vb, pa0, pa1, pa2, pa3); }
        else         { na::pv_one<2>(o[0], vb, pa0, pa1, pa2, pa3); na::pv_one<3>(o[1], vb, pa0, pa1, pa2, pa3); }
    }
    {
        const float cf = __builtin_amdgcn_exp2f(lf2 * (float)(iq + 1)), cb_ = __builtin_amdgcn_exp2f(lb2 * (float)(128 - iq));
#pragma unroll
        for (int ks = 0; ks < 8; ++ks) { const bf16x8 qf = scale_frag1(qr[ks], cf), qb = scale_frag1(qr[ks], cb_);
#pragma unroll
            for (int d = 0; d < 2; ++d) { const int so = KSWZ(32 * (2 * dh + d) + r32, (16 * ks + 8 * hi) * 2);
                const bf16x8 sf = *(const bf16x8*)(lds + RO_OFF_SF + so), sb = *(const bf16x8*)(lds + RO_OFF_SB + so);
                o[d] = __builtin_amdgcn_mfma_f32_32x32x16_bf16(qf, sf, o[d], 0, 0, 0);
                o[d] = __builtin_amdgcn_mfma_f32_32x32x16_bf16(qb, sb, o[d], 0, 0, 0); } }
    }
    float* stats = (float*)(lds + RO_OFF_ST);
    {
      float v32[32];
#pragma unroll
      for (int e = 0; e < 16; ++e) { v32[e] = o[0][e] + o[1][e]; v32[16 + e] = o[0][e] * o[0][e] + o[1][e] * o[1][e]; }
#pragma unroll
      for (int L = 16; L >= 1; L >>= 1) { const bool up = (r32 & L) != 0;
#pragma unroll
          for (int i = 0; i < L; ++i) { const float keep = up ? v32[L + i] : v32[i], send = up ? v32[i] : v32[L + i]; v32[i] = keep + __shfl_xor(send, L); } }
      stats[((ib * 2 + dh) * 32 + crow(r32 & 15, hi)) * 2 + (r32 >> 4)] = v32[0]; }
    __syncthreads();
    const float* gnw = C.gn_w() + h * 128 + 32 * (2 * dh) + r32; const float gw0 = gnw[0], gw1 = gnw[32];
#pragma unroll
    for (int e = 0; e < 16; ++e) { const int q = crow(e, hi); const float* sa = stats + ((ib * 2 + 0) * 32 + q) * 2; const float* sb = stats + ((ib * 2 + 1) * 32 + q) * 2;
        const float mean = (sa[0] + sb[0]) * (1.0f / 128.0f), var = (sa[1] + sb[1]) * (1.0f / 128.0f) - mean * mean, rstd = 1.0f / sqrtf(fmaxf(var, 0.f) + EPS);
        const long row = rowbase + 32 * ib + q;
#pragma unroll
        for (int d = 0; d < 2; ++d) { const int dv = 32 * (2 * dh + d) + r32;
            const float y = (o[d][e] - mean) * rstd * (d ? gw1 : gw0) * __builtin_bit_cast(float, d ? (gsp[e] & 0xffff0000u) : (gsp[e] << 16));
            MIX[row * DM + 1024 + h * 128 + dv] = (bf16)(cvtpk(y, 0.f) & 0xffffu); } }
    __syncthreads();
}
}

__device__ __forceinline__ void p7_rows(const Ctx& C) {
    const int TID_ = opq((int)threadIdx.x), LANE_ = TID_ & 63;
    float* wrT = (float*)C.lds;
    { f32x4 wv[16];
#pragma unroll
      for (int i = 0; i < 16; ++i) wv[i] = ((const f32x4*)C.w_router())[TID_ + 512 * i];
#pragma unroll
      for (int i = 0; i < 16; ++i) { const int q = TID_ + 512 * i, col = q >> 2, e0 = (q & 3) * 4;
          wrT[(e0 + 0) * DM + col] = wv[i].x; wrT[(e0 + 1) * DM + col] = wv[i].y; wrT[(e0 + 2) * DM + col] = wv[i].z; wrT[(e0 + 3) * DM + col] = wv[i].w; } }
    __syncthreads();
    const float* mod = (const float*)(C.ws() + WS_MOD); bf16* U2 = (bf16*)(C.ws() + WS_U); float* AFF = (float*)(C.ws() + WS_AFF);
    const float* HL = (const float*)(C.ws() + WS_HLAT);
    for (int m = 2 * C.gw(); m < MLAT; m += 2 * C.NGW()) {
        const int b = m >> 12, n = m & 4095;
        f32x4 va[8], vb[8]; float sa = 0.f, sb = 0.f;
#pragma unroll
        for (int j = 0; j < 8; ++j) { va[j] = ((const f32x4*)(HL + (size_t)m * DM))[LANE_ + 64 * j]; vb[j] = ((const f32x4*)(HL + (size_t)(m + 1) * DM))[LANE_ + 64 * j]; }
#pragma unroll
        for (int j = 0; j < 8; ++j) { sa += (va[j].x * va[j].x + va[j].y * va[j].y) + (va[j].z * va[j].z + va[j].w * va[j].w); sb += (vb[j].x * vb[j].x + vb[j].y * vb[j].y) + (vb[j].z * vb[j].z + vb[j].w * vb[j].w); }
        const float ra = 1.0f / sqrtf(wave_sum(sa) * (1.0f / DM) + EPS), rb = 1.0f / sqrtf(wave_sum(sb) * (1.0f / DM) + EPS);
#pragma unroll
        for (int j = 0; j < 8; ++j) { const int col = (LANE_ + 64 * j) * 4; const f32x4 nw = *(const f32x4*)(C.nffn() + col), sh = *(const f32x4*)(mod + b * NMOD + 3 * DM + col), sc = *(const f32x4*)(mod + b * NMOD + 4 * DM + col);
            va[j] = (va[j] * ra * nw) * (sc + 1.0f) + sh; vb[j] = (vb[j] * rb * nw) * (sc + 1.0f) + sh;
            v2u oa, ob; oa.x = cvtpk(va[j].x, va[j].y); oa.y = cvtpk(va[j].z, va[j].w); ob.x = cvtpk(vb[j].x, vb[j].y); ob.y = cvtpk(vb[j].z, vb[j].w);
            *(v2u*)(U2 + (size_t)m * DM + col) = oa; *(v2u*)(U2 + (size_t)(m + 1) * DM + col) = ob; if (j & 1) SBAR(); }
        float la[NEXP], lb[NEXP];
        int wo0 = LANE_ * 16, wo1 = LANE_ * 16 + 65536;
        asm volatile("" : "+v"(wo0), "+v"(wo1));
#pragma unroll
        for (int e = 0; e < NEXP; ++e) { f32x4 w[8];
#pragma unroll
            for (int j = 0; j < 8; ++j) w[j] = *(const f32x4*)((const char*)wrT + (e < 8 ? wo0 : wo1) + (e & 7) * 8192 + j * 1024);
            f32x2 a2 = {0.f, 0.f}, c2 = {0.f, 0.f};
#pragma unroll
            for (int j = 0; j < 8; ++j) { const f32x2 wl = {w[j].x, w[j].y}, wh = {w[j].z, w[j].w};
                a2 += (f32x2){va[j].x, va[j].y} * wl; a2 += (f32x2){va[j].z, va[j].w} * wh; c2 += (f32x2){vb[j].x, vb[j].y} * wl; c2 += (f32x2){vb[j].z, vb[j].w} * wh; }
            la[e] = a2.x + a2.y; lb[e] = c2.x + c2.y; if (e & 1) SBAR(); }
#pragma unroll
        for (int L = 8; L >= 1; L >>= 1) { const int B = L * 4; const bool up = (LANE_ & B) != 0;
#pragma unroll
            for (int i = 0; i < L; ++i) { const float ka = up ? la[L + i] : la[i], sa_ = up ? la[i] : la[L + i]; la[i] = ka + __shfl_xor(sa_, B);
                                          const float kb = up ? lb[L + i] : lb[i], sb_ = up ? lb[i] : lb[L + i]; lb[i] = kb + __shfl_xor(sb_, B); } }
        float ta = la[0], tb = lb[0]; ta += __shfl_xor(ta, 1); tb += __shfl_xor(tb, 1); ta += __shfl_xor(ta, 2); tb += __shfl_xor(tb, 2);
        float mxa = ta, mxb = tb;
#pragma unroll
        for (int B = 4; B < 64; B <<= 1) { mxa = fmaxf(mxa, __shfl_xor(mxa, B)); mxb = fmaxf(mxb, __shfl_xor(mxb, B)); }
        const float exa = expf(ta - mxa), exb = expf(tb - mxb); float sma = exa, smb = exb;
#pragma unroll
        for (int B = 4; B < 64; B <<= 1) { sma += __shfl_xor(sma, B); smb += __shfl_xor(smb, B); }
        if ((LANE_ & 3) == 0) { float* ap = AFF + (size_t)(b * NEXP + (LANE_ >> 2)) * SEQ + n; *(f32x2*)ap = (f32x2){exa / sma, exb / smb}; }
    }
    __syncthreads();
}

__device__ __forceinline__ void p8_topk(const Ctx& C, int b, int e) {
    const int TID_ = opq((int)threadIdx.x), LANE_ = TID_ & 63;
    unsigned* hist = (unsigned*)C.lds;
    unsigned* scal = hist + 256; unsigned* wtot = hist + 288;
    const float* aff = (const float*)(C.ws() + WS_AFF) + (size_t)(b * NEXP + e) * SEQ;
    int* SLOT = (int*)(C.ws() + WS_SLOT) + (size_t)(b * NEXP + e) * SEQ; int* IDX = (int*)(C.ws() + WS_IDX) + (e * 2 + b) * CAP; float* GATE = (float*)(C.ws() + WS_GATE) + (e * 2 + b) * CAP;
    const int tid = TID_, base = tid * 8;
    unsigned key[8]; { const v4u a = *(const v4u*)(aff + base), c2 = *(const v4u*)(aff + base + 4); key[0] = a.x; key[1] = a.y; key[2] = a.z; key[3] = a.w; key[4] = c2.x; key[5] = c2.y; key[6] = c2.z; key[7] = c2.w; }
    unsigned prefix = 0u, remaining = CAP;
#pragma unroll
    for (int pass = 0; pass < 4; ++pass) {
        const int shift = 24 - 8 * pass;
        if (tid < 256) hist[tid] = 0u;
        __syncthreads();
#pragma unroll
        for (int i = 0; i < 8; ++i) { const bool match = (pass == 0) || ((key[i] >> (shift + 8)) == (prefix >> (shift + 8))); if (match) atomicAdd(&hist[(key[i] >> shift) & 255u], 1u); }
        __syncthreads();
        {
          unsigned hcnt = 0u, suf = 0u;
          if (tid < 256) { hcnt = hist[tid]; suf = hcnt;
#pragma unroll
              for (int o = 1; o < 64; o <<= 1) { const unsigned t2 = __shfl_down(suf, o); if (LANE_ + o < 64) suf += t2; }
              if (LANE_ == 0) wtot[8 + C.wave] = suf; }
          __syncthreads();
          if (tid < 256) { for (int w = C.wave + 1; w < 4; ++w) suf += wtot[8 + w];
              if (suf >= remaining && suf - hcnt < remaining) { scal[0] = prefix | ((unsigned)tid << shift); scal[1] = remaining - (suf - hcnt); } }
        }
        __syncthreads();
        prefix = scal[0]; remaining = scal[1];
        __syncthreads();
    }
    unsigned cg = 0u, ce = 0u;
#pragma unroll
    for (int i = 0; i < 8; ++i) { cg += key[i] > prefix ? 1u : 0u; ce += key[i] == prefix ? 1u : 0u; }
    unsigned pk = cg | (ce << 16), inc = pk;
#pragma unroll
    for (int o = 1; o < 64; o <<= 1) { const unsigned t = __shfl_up(inc, o); if (LANE_ >= o) inc += t; }
    if (LANE_ == 63) wtot[C.wave] = inc;
    __syncthreads();
    unsigned woff = 0u;
    for (int w = 0; w < C.wave; ++w) woff += wtot[w];
    const unsigned excl = woff + inc - pk; unsigned rg_ = excl & 0xffffu, re_ = excl >> 16;
    const unsigned ngt = CAP - remaining;
#pragma unroll
    for (int i = 0; i < 8; ++i) { int slot = -1;
        if (key[i] > prefix) { slot = (int)rg_; ++rg_; }
        else if (key[i] == prefix) { if (re_ < remaining) slot = (int)(ngt + re_); ++re_; }
        SLOT[base + i] = slot;
        if (slot >= 0) { IDX[slot] = base + i; GATE[slot] = __builtin_bit_cast(float, key[i]); } }
    __syncthreads();
}

__device__ __forceinline__ void p9_gather(const Ctx& C) {
    const int TID_ = opq((int)threadIdx.x), LANE_ = TID_ & 63;
    const bf16* U2 = (const bf16*)(C.ws() + WS_U); bf16* XE = (bf16*)(C.ws() + WS_XE); const int* IDX = (const int*)(C.ws() + WS_IDX);
    for (int R = C.gw(); R < NEXP * NB * CAP; R += C.NGW()) {
        const int b = (R >> 9) & 1; const int tok = IDX[R];
        const v4u* src = (const v4u*)(U2 + (size_t)(b * SEQ + tok) * DM) + LANE_; v4u* dst = (v4u*)(XE + (size_t)R * DM) + LANE_;
        const v4u a0 = src[0], a1 = src[64], a2 = src[128], a3 = src[192];
        dst[0] = a0; dst[64] = a1; dst[128] = a2; dst[192] = a3;
    }
}

__device__ __forceinline__ void p12_final(const Ctx& C) {
    const int TID_ = opq((int)threadIdx.x), LANE_ = TID_ & 63;
    const float* mod = (const float*)(C.ws() + WS_MOD); const bf16* YE = (const bf16*)(C.ws() + WS_YE); const int* SLOT = (const int*)(C.ws() + WS_SLOT);
    const float* HL = (const float*)(C.ws() + WS_HLAT);
    f32x4 hv[8]; int sl;
    { const int mq = C.gw() < MLAT ? C.gw() : 0;
      sl = (LANE_ < NEXP) ? SLOT[(size_t)((mq >> 12) * NEXP + LANE_) * SEQ + (mq & 4095)] : -1;
#pragma unroll
      for (int j = 0; j < 8; ++j) hv[j] = __builtin_nontemporal_load((const f32x4*)(HL + (size_t)mq * DM) + LANE_ + 64 * j); }
    for (int m = C.gw(); m < MLAT; m += C.NGW()) {
        const int b = m >> 12; float* row = C.out() + (size_t)m * DM; const int mn = m + C.NGW();
        f32x4 hvn[8]; int sln;
        { const int mq = mn < MLAT ? mn : m;
          sln = (LANE_ < NEXP) ? SLOT[(size_t)((mq >> 12) * NEXP + LANE_) * SEQ + (mq & 4095)] : -1;
#pragma unroll
          for (int j = 0; j < 8; ++j) hvn[j] = __builtin_nontemporal_load((const f32x4*)(HL + (size_t)mq * DM) + LANE_ + 64 * j); }
        f32x4 acc[8];
#pragma unroll
        for (int j = 0; j < 8; ++j) acc[j] = (f32x4){0.f, 0.f, 0.f, 0.f};
        unsigned mk = (unsigned)__ballot(sl >= 0);
        while (mk) {
            const int e0 = __builtin_ctz(mk); mk &= mk - 1; const bool two = mk != 0u; const int e1 = two ? __builtin_ctz(mk) : e0; if (two) mk &= mk - 1;
            const int s0 = __builtin_amdgcn_readlane(sl, e0), s1 = __builtin_amdgcn_readlane(sl, e1);
            const v2u* y0 = (const v2u*)(YE + (size_t)((e0 * 2 + b) * CAP + s0) * DM) + LANE_; const v2u* y1 = (const v2u*)(YE + (size_t)((e1 * 2 + b) * CAP + s1) * DM) + LANE_;
            v2u a0[8], a1[8];
#pragma unroll
            for (int j = 0; j < 8; ++j) { a0[j] = __builtin_nontemporal_load(y0 + 64 * j); a1[j] = __builtin_nontemporal_load(y1 + 64 * j); }
            const float w1 = two ? 1.0f : 0.0f;
#pragma unroll
            for (int j = 0; j < 8; ++j) {
                acc[j].x += __builtin_bit_cast(float, a0[j].x << 16); acc[j].y += __builtin_bit_cast(float, a0[j].x & 0xffff0000u); acc[j].z += __builtin_bit_cast(float, a0[j].y << 16); acc[j].w += __builtin_bit_cast(float, a0[j].y & 0xffff0000u);
                acc[j].x += w1 * __builtin_bit_cast(float, a1[j].x << 16); acc[j].y += w1 * __builtin_bit_cast(float, a1[j].x & 0xffff0000u); acc[j].z += w1 * __builtin_bit_cast(float, a1[j].y << 16); acc[j].w += w1 * __builtin_bit_cast(float, a1[j].y & 0xffff0000u); }
        }
        f32x4 v[8]; float s2 = 0.f;
#pragma unroll
        for (int j = 0; j < 8; ++j) { const int col = (LANE_ + 64 * j) * 4; const f32x4 g5 = *(const f32x4*)(mod + b * NMOD + 5 * DM + col);
            v[j] = hv[j] + g5 * acc[j]; s2 += (v[j].x * v[j].x + v[j].y * v[j].y) + (v[j].z * v[j].z + v[j].w * v[j].w); }
        const float rstd = 1.0f / sqrtf(wave_sum(s2) * (1.0f / DM) + EPS);
#pragma unroll
        for (int j = 0; j < 8; ++j) { const int col = (LANE_ + 64 * j) * 4; const f32x4 fw = *(const f32x4*)(C.fin_w() + col); __builtin_nontemporal_store(v[j] * rstd * fw, (f32x4*)row + LANE_ + 64 * j); }
#pragma unroll
        for (int j = 0; j < 8; ++j) hv[j] = hvn[j];
        sl = sln;
    }
}

__global__ void __launch_bounds__(NWAVES * 64, 2) fwd_megakernel(Args args) {
    extern __shared__ __attribute__((aligned(16))) unsigned char lds[];
    Ctx C;
    C.a = &args; C.lds = lds;
    C.wave = __builtin_amdgcn_readfirstlane((int)threadIdx.x >> 6);
    volatile LAS unsigned* MISC = (volatile LAS unsigned*)((LAS unsigned char*)lds + MISC_OFF);
    for (int u = threadIdx.x; u < (LDS_BYTES - LDSCTL_OFF) / 4; u += NWAVES * 64) ((LAS unsigned*)((LAS unsigned char*)lds + LDSCTL_OFF))[u] = 0u;
    __syncthreads();
    unsigned* ctl = (unsigned*)(args.ws + WS_CTL);
    XcdBarrier bar; bar.bar = ctl + CW_BAR; bar.x = 0; bar.st = nullptr;
    if (N_LAUNCHES == 1) bar = xcd_barrier_post(ctl + CW_BAR, MISC + 8);
#ifndef PROBE_BARX
#define PROBE_BARX 1
#endif
#define GRID_BAR() do { if (N_LAUNCHES == 1) { for (int bb_ = 0; bb_ < PROBE_BARX; ++bb_) xcd_barrier(bar); } } while (0)
#ifndef PHASE_MASK
#define PHASE_MASK 0x1fff
#endif
#define IN(k) ((((PHASE_MASK) >> (k)) & 1) && args.ph_lo <= (k) && (k) < args.ph_hi)
#define BOTH(k) (IN(k) && IN((k) + 1))
#ifndef PROBE_MASK
#define PROBE_MASK 0
#endif
#define REPS(k) ((((PROBE_MASK) >> (k)) & 1) ? 2 : 1)
    PG8_LAS unsigned char* ring = (PG8_LAS unsigned char*)lds;
#ifdef PROBE_STAMP
    unsigned long long t_start_ = __builtin_amdgcn_s_memrealtime(), t_mark_ = t_start_;
#define STAMP(k) do { if ((k) == PROBE_STAMP) t_mark_ = __builtin_amdgcn_s_memrealtime(); } while (0)
#else
#define STAMP(k) do { } while (0)
#endif

    if (IN(0)) for (int rep_ = 0; rep_ < REPS(0); ++rep_) { p0_prologue(C); if (BOTH(0) || rep_ + 1 < REPS(0)) GRID_BAR(); }
    STAMP(0);
    if (IN(1)) for (int rep_ = 0; rep_ < REPS(1); ++rep_) { p1_rows(C); if (BOTH(1) || rep_ + 1 < REPS(1)) GRID_BAR(); }
    STAMP(1);
    if (IN(2)) for (int rep_ = 0; rep_ < REPS(2); ++rep_) {
        pg8::Gemm g{(const pg8::bf16_t*)(args.ws + WS_U), (const pg8::bf16_t*)(args.ws + WS_WIN), MALL, NIN, DM, 0, 0, nullptr};
        pg8::QkvOrder S; S.init(C.G(), (int)blockIdx.x);
        pg8::EpiQKV E{(pg8::bf16_t*)(args.ws + WS_QKV), (const float*)(args.ws + WS_ROPE), (const float*)(args.ws + WS_ROPE) + 2048};
        pg8::gemm_phase<pg8::EpiQKV, pg8::QkvOrder, true, true>(ring, g, S, E);
        conv_deferred(C, 928);
        if (BOTH(2) || rep_ + 1 < REPS(2)) GRID_BAR();
    }
    STAMP(2);
    if (IN(3)) for (int rep_ = 0; rep_ < REPS(3); ++rep_) {
#ifndef NO_NA
        if (conv_split(C)) {
            const int bx = (int)blockIdx.x, G = C.G(), q = (bx & 7) * (G >> 4) + (bx >> 4);
            if (((bx >> 3) & 1) == 0) { for (int u = 2 * q; u < 256; u += G) { na::na_unit((const bf16*)(args.ws + WS_QKV), (bf16*)(args.ws + WS_MIX), C.rpb(), u >> 7, (u >> 4) & 7, u & 15, (char*)lds);
                                                                                na::na_unit((const bf16*)(args.ws + WS_QKV), (bf16*)(args.ws + WS_MIX), C.rpb(), (u + 1) >> 7, ((u + 1) >> 4) & 7, (u + 1) & 15, (char*)lds); } }
            else { conv_p3(C, q, G >> 1); __syncthreads(); }
        } else
        for (int u = C.vcu(); u < 256; u += C.G()) { const int bh = u >> 4; na::na_unit((const bf16*)(args.ws + WS_QKV), (bf16*)(args.ws + WS_MIX), C.rpb(), bh >> 3, bh & 7, u & 15, (char*)lds); }
#endif
#ifndef NO_KV
        for (int it = C.vcu(); it < 544; it += C.G()) { const int bh = it / 34; ret::kv_item(C, bh >> 3, bh & 7, it % 34); }
#endif
        if (BOTH(3) || rep_ + 1 < REPS(3)) GRID_BAR();
    }
    STAMP(3);
    if (IN(4)) for (int rep_ = 0; rep_ < REPS(4); ++rep_) { ret::scan_phase(C); if (BOTH(4) || rep_ + 1 < REPS(4)) GRID_BAR(); }
    STAMP(4);
    if (IN(5)) for (int rep_ = 0; rep_ < REPS(5); ++rep_) {
        for (int it = C.vcu(); it < 512; it += C.G()) ret::ro_item(C, it >> 8, (it >> 5) & 7, it & 31);
        if (BOTH(5) || rep_ + 1 < REPS(5)) GRID_BAR();
    }
    STAMP(5);
    if (IN(6)) for (int rep_ = 0; rep_ < REPS(6); ++rep_) {
        pg8::Gemm g{(const pg8::bf16_t*)(args.ws + WS_MIX), (const pg8::bf16_t*)(args.ws + WS_WOUT), MLAT, DM, DM, 0, 0, nullptr};
        pg8::StaticOrder S; S.init(MLAT, DM, C.G(), (int)blockIdx.x);
        pg8::EpiOut E{C.x(), (float*)(args.ws + WS_HLAT), (const float*)(args.ws + WS_MOD)};
        pg8::gemm_phase<pg8::EpiOut, pg8::StaticOrder, true, true>(ring, g, S, E);
        if (BOTH(6) || rep_ + 1 < REPS(6)) GRID_BAR();
    }
    STAMP(6);
    if (IN(7)) for (int rep_ = 0; rep_ < REPS(7); ++rep_) { p7_rows(C); if (BOTH(7) || rep_ + 1 < REPS(7)) GRID_BAR(); }
    STAMP(7);
    if (IN(8)) for (int rep_ = 0; rep_ < REPS(8); ++rep_) { for (int it = blockIdx.x; it < NB * NEXP; it += C.G()) p8_topk(C, it >> 4, it & 15); conv_p8(C); if (BOTH(8) || rep_ + 1 < REPS(8)) GRID_BAR(); }
    STAMP(8);
    if (IN(9)) for (int rep_ = 0; rep_ < REPS(9); ++rep_) {   }
    STAMP(9);
    if (IN(10)) for (int rep_ = 0; rep_ < REPS(10); ++rep_) {
        pg8::Gemm g{(const pg8::bf16_t*)(args.ws + WS_U), (const pg8::bf16_t*)(args.ws + WS_WGU), NEXP * NB * CAP, 2 * FF, DM, 2, (size_t)2048 * 2048 * 2, (const int*)(args.ws + WS_IDX)};
        pg8::StaticOrder S; S.init(NEXP * NB * CAP, 2 * FF, C.G(), (int)blockIdx.x);
        pg8::EpiGU E{(pg8::bf16_t*)(args.ws + WS_HID)};
        pg8::gemm_phase<pg8::EpiGU, pg8::StaticOrder, true, true, true>(ring, g, S, E);
        if (BOTH(10) || rep_ + 1 < REPS(10)) GRID_BAR();
    }
    STAMP(10);
    if (IN(11)) for (int rep_ = 0; rep_ < REPS(11); ++rep_) {
        pg8::Gemm g{(const pg8::bf16_t*)(args.ws + WS_HID), (const pg8::bf16_t*)(args.ws + WS_WDN), NEXP * NB * CAP, DM, FF, 2, (size_t)2048 * 1024 * 2, nullptr};
        pg8::StaticOrder S; S.init(NEXP * NB * CAP, DM, C.G(), (int)blockIdx.x);
        pg8::EpiDown E{(pg8::bf16_t*)(args.ws + WS_YE), (const float*)(args.ws + WS_GATE)};
        pg8::gemm_phase<pg8::EpiDown, pg8::StaticOrder, true, true>(ring, g, S, E);
        if (BOTH(11) || rep_ + 1 < REPS(11)) GRID_BAR();
    }
    STAMP(11);
    if (IN(12)) for (int rep_ = 0; rep_ < REPS(12); ++rep_) { p12_final(C); }
#ifdef PROBE_STAMP
    if (blockIdx.x == 0 && threadIdx.x == 0) { const unsigned long long t_end_ = __builtin_amdgcn_s_memrealtime(), wait_ = t_mark_ - t_start_;
        while (__builtin_amdgcn_s_memrealtime() - t_end_ < wait_) __builtin_amdgcn_s_sleep(8); }
#endif
#undef IN
#undef BOTH
#undef GRID_BAR
}

extern "C" void kernel_launch(void* const* d_in, const int* in_sizes, int n_in, void* d_out, int out_size, void* d_ws, size_t ws_size, hipStream_t stream) {
    static int grid = 0;
    if (grid == 0) {
        if (n_in != 19 || in_sizes[0] != MLAT * DM || out_size != MLAT * DM || ws_size < WS_END) { fprintf(stderr, "kernel_launch: built for 19 inputs, x/out of %d floats, >= %zu bytes of workspace; got n_in %d in0 %d out %d ws %zu; nothing launched\n", MLAT * DM, (size_t)WS_END, n_in, n_in > 0 ? in_sizes[0] : -1, out_size, ws_size); grid = -1; return; }
        int dev = 0, cus = 0, per_cu = 0;
        if (hipGetDevice(&dev) != hipSuccess || hipDeviceGetAttribute(&cus, hipDeviceAttributeMultiprocessorCount, dev) != hipSuccess) { fprintf(stderr, "kernel_launch: hipGetDevice / hipDeviceGetAttribute failed\n"); grid = -1; return; }
        if (hipFuncSetAttribute((const void*)fwd_megakernel, hipFuncAttributeMaxDynamicSharedMemorySize, LDS_BYTES) != hipSuccess) { fprintf(stderr, "kernel_launch: hipFuncSetAttribute(%d B LDS) failed\n", LDS_BYTES); grid = -1; return; }
        if (hipOccupancyMaxActiveBlocksPerMultiprocessor(&per_cu, (const void*)fwd_megakernel, NWAVES * 64, LDS_BYTES) != hipSuccess || per_cu < 1) { fprintf(stderr, "kernel_launch: occupancy query reports %d workgroups per CU\n", per_cu); per_cu = 1; }
        (void)hipGetLastError();
        grid = cus;
    }
    if (grid < 0) return;
    if (hipMemsetAsync((char*)d_ws + WS_CTL, 0, CTL_ZERO_BYTES, stream) != hipSuccess) { fprintf(stderr, "kernel_launch: hipMemsetAsync failed\n"); return; }
    Args a{};
    for (int i = 0; i < 19; ++i) a.in[i] = (const float*)d_in[i];
    a.out = (float*)d_out; a.ws = (unsigned char*)d_ws;
    if (N_LAUNCHES == 1) {
        a.ph_lo = 0; a.ph_hi = PER_PHASE; a.li = 0;
        void* kargs[] = {&a};
        hipError_t e = hipLaunchCooperativeKernel((const void*)fwd_megakernel, dim3(grid), dim3(NWAVES * 64), kargs, LDS_BYTES, stream);
        if (e != hipSuccess) { fprintf(stderr, "kernel_launch: cooperative launch failed: %s (grid %d)\n", hipGetErrorString(e), grid); (void)hipGetLastError(); }
    } else {
        for (int li = 0; li < PER_PHASE; ++li) { a.ph_lo = li; a.ph_hi = li + 1; a.li = li;
            hipLaunchKernelGGL(fwd_megakernel, dim3(grid), dim3(NWAVES * 64), LDS_BYTES, stream, a);
            const hipError_t le = hipPeekAtLastError(); if (le != hipSuccess) { fprintf(stderr, "kernel_launch: launch %d failed: %s\n", li, hipGetErrorName(le)); break; } }
    }
}
```

```cpp
#include <hip/hip_runtime.h>
#include <hip/hip_bf16.h>
#include <cstdio>
#include <cstdint>
#include <cmath>
#define MK_N_LAUNCHES 1
namespace pg8 {
#define PG8_LAS __attribute__((address_space(3)))
typedef unsigned short bf16_t;
typedef short bf16x8 __attribute__((ext_vector_type(8)));
typedef float f32x4 __attribute__((ext_vector_type(4)));
typedef unsigned u32x4 __attribute__((ext_vector_type(4)));
constexpr int BM = 256, BK = 64, HALF = 128, HTB = HALF * BK * 2  , STAGE_BYTES = 8 * HTB, NXCD = 8, WGM = 8;

__host__ __device__ __forceinline__ int lds_byte(int r, int c) { const int st = (r >> 4) * 2 + (c >> 5), rr = r & 15, cc = c & 31, ob = rr * 64 + cc * 2; return st * 1024 + (ob ^ (((ob >> 9) & 1) << 5)); }
__host__ __device__ __forceinline__ void stage_rc(int b, int& R, int& C) { const int st = b / 1024, sb = b % 1024, swz = sb ^ (((sb >> 9) & 1) << 5); R = (st >> 1) * 16 + swz / 64; C = (st & 1) * 32 + (swz % 64) / 2; }
__host__ __device__ __forceinline__ int perm32(int rho) { const int n = rho >> 4, i = rho & 15; return 8 * (i >> 2) + 4 * n + (i & 3); }

struct Unit { int pm, pn; };
struct Gemm { const bf16_t* A; const bf16_t* Bt; int M, N, K; int gshift; size_t gstride; const int* gidx;
    __device__ __forceinline__ size_t bofs(int pm, int pn) const { return (size_t)(pm >> gshift) * gstride + (size_t)pn * (size_t)(256 * 2) * (size_t)K; } };

struct StaticOrder {
    int nM, nN, nwg, G, c;
    __host__ __device__ void init(int M, int N, int G_, int c_) { nM = M / BM; nN = N / BM; nwg = nM * nN; G = G_; c = c_; }
    __host__ __device__ bool next(int i, Unit& u) const {
        const long L = (long)i * G + c; if (L >= nwg) return false;
        int wgid = (int)L; { const int q = nwg / NXCD, r = nwg % NXCD, xcd = wgid % NXCD, off = wgid / NXCD; wgid = (xcd < r ? xcd * (q + 1) : r * (q + 1) + (xcd - r) * q) + off; }
        const int nig = WGM * nN, gid = wgid / nig, fm = gid * WGM, gsz = (nM - fm) < WGM ? (nM - fm) : WGM;
        u.pm = fm + ((wgid % nig) % gsz); u.pn = (wgid % nig) / gsz; return true;
    }
    __device__ __forceinline__ void a_ready(const Unit&) const {}
    __device__ __forceinline__ void done(const Unit&) const {}
};


typedef float f32x2c __attribute__((ext_vector_type(2))); typedef __bf16 bf16x2c __attribute__((ext_vector_type(2)));
__device__ __forceinline__ unsigned cvt_pk_bf16(float lo, float hi) { const f32x2c v = {lo, hi}; const bf16x2c b = __builtin_convertvector(v, bf16x2c); return __builtin_bit_cast(unsigned, b); }
__device__ __forceinline__ float silu_f(float x) { return x * __builtin_amdgcn_rcpf(1.0f + __expf(-x)); }
__device__ __forceinline__ f32x4 silu4(f32x4 v) { return (f32x4){silu_f(v[0]), silu_f(v[1]), silu_f(v[2]), silu_f(v[3])}; }
__device__ __forceinline__ u32x4 pack8(f32x4 v0, f32x4 v1) { u32x4 w; w.x = cvt_pk_bf16(v0[0], v0[1]); w.y = cvt_pk_bf16(v0[2], v0[3]); w.z = cvt_pk_bf16(v1[0], v1[1]); w.w = cvt_pk_bf16(v1[2], v1[3]); return w; }

struct EpiQKV {
    static constexpr bool PERM = true, AFTER_DRAIN = false;
    bf16_t* O; const float* rc; const float* rs;
    __device__ __forceinline__ void operator()(const f32x4 (&acc)[2][2][4][2], const Unit& u, int wr, int wc, int fr, int fq) const {
        const int colt = u.pn * BM, t = colt >> 10; const bool lat = u.pm < 32;
        const int col0 = colt + wc * 32 + 8 * fq;
        const bool rope = lat && (t == 2 || t == 5);
        const int i0 = (wc & 1) * 16 + 4 * fq;
#pragma unroll
        for (int ai = 0; ai < 2; ++ai) {
            f32x4 c4[4], s4[4];
#pragma unroll
            for (int m = 0; m < 4; ++m) { c4[m] = (f32x4){1.f, 1.f, 1.f, 1.f}; s4[m] = (f32x4){0.f, 0.f, 0.f, 0.f};
                if (rope) { const int tok = (u.pm * BM + ai * HALF + wr * 64 + m * 16 + fr) & 4095; const int pos = (wc >> 1) ? (tok & 63) : (tok >> 6); c4[m] = *(const f32x4*)(rc + pos * 32 + i0); s4[m] = *(const f32x4*)(rs + pos * 32 + i0); } }
#pragma unroll
            for (int m = 0; m < 4; ++m) {
                const int row = u.pm * BM + ai * HALF + wr * 64 + m * 16 + fr;
                bf16_t* rowp = O + (size_t)row * 7168 + col0;
#pragma unroll
                for (int bj = 0; bj < 2; ++bj) {
                    f32x4 v0 = acc[ai][bj][m][0], v1 = acc[ai][bj][m][1];
                    if (rope) { const f32x4 a = v0 * c4[m] - v1 * s4[m], b = v1 * c4[m] + v0 * s4[m]; v0 = a; v1 = b; }
                    if (t == 2) { v0 = v0 * 0.08838834764831845f; v1 = v1 * 0.08838834764831845f; }
                    if (t == 6) { v0 = silu4(v0); v1 = silu4(v1); }
                    *(u32x4*)(rowp + bj * HALF) = pack8(v0, v1);
                }
            }
        }
    }
};
struct EpiOut {
    static constexpr bool PERM = false, AFTER_DRAIN = false;
    const float* x; float* out; const float* mod;
    __device__ __forceinline__ void operator()(const f32x4 (&acc)[2][2][4][2], const Unit& u, int wr, int wc, int fr, int fq) const {
        const int b = u.pm >> 4; const float* g2 = mod + b * 12288 + 2 * 2048;
        const int col0 = u.pn * BM + wc * 32 + 4 * fq;
        f32x4 gv[2][2];
#pragma unroll
        for (int bj = 0; bj < 2; ++bj)
#pragma unroll
            for (int n = 0; n < 2; ++n) gv[bj][n] = *(const f32x4*)(g2 + col0 + bj * HALF + n * 16);
#pragma unroll
        for (int ai = 0; ai < 2; ++ai)
#pragma unroll
            for (int mp = 0; mp < 2; ++mp) {
                f32x4 xv[2][2][2];
#pragma unroll
                for (int mm = 0; mm < 2; ++mm) { const size_t off = (size_t)(u.pm * BM + ai * HALF + wr * 64 + (2 * mp + mm) * 16 + fr) * 2048 + col0;
#pragma unroll
                    for (int bj = 0; bj < 2; ++bj)
#pragma unroll
                        for (int n = 0; n < 2; ++n) xv[mm][bj][n] = __builtin_nontemporal_load((const f32x4*)(x + off + bj * HALF + n * 16)); }
#pragma unroll
                for (int mm = 0; mm < 2; ++mm) { const int m = 2 * mp + mm; const size_t off = (size_t)(u.pm * BM + ai * HALF + wr * 64 + m * 16 + fr) * 2048 + col0;
#pragma unroll
                    for (int bj = 0; bj < 2; ++bj)
#pragma unroll
                        for (int n = 0; n < 2; ++n) *(f32x4*)(out + off + bj * HALF + n * 16) = xv[mm][bj][n] + gv[bj][n] * acc[ai][bj][m][n]; }
                __builtin_amdgcn_sched_barrier(0);
            }
    }
};
struct EpiGU {
    static constexpr bool PERM = true, AFTER_DRAIN = false;
    bf16_t* H;
    __device__ __forceinline__ void operator()(const f32x4 (&acc)[2][2][4][2], const Unit& u, int wr, int wc, int fr, int fq) const {
        const int col0 = u.pn * HALF + wc * 32 + 8 * fq;
#pragma unroll
        for (int ai = 0; ai < 2; ++ai)
#pragma unroll
            for (int m = 0; m < 4; ++m) {
                const int row = u.pm * BM + ai * HALF + wr * 64 + m * 16 + fr;
                const f32x4 h0 = silu4(acc[ai][0][m][0]) * acc[ai][1][m][0], h1 = silu4(acc[ai][0][m][1]) * acc[ai][1][m][1];
                *(u32x4*)(H + (size_t)row * 1024 + col0) = pack8(h0, h1);
            }
    }
};
struct EpiDown {
    static constexpr bool PERM = true, AFTER_DRAIN = false;
    bf16_t* Y; const float* gate;
    __device__ __forceinline__ void operator()(const f32x4 (&acc)[2][2][4][2], const Unit& u, int wr, int wc, int fr, int fq) const {
        const int col0 = u.pn * BM + wc * 32 + 8 * fq;
        float gt[2][4];
#pragma unroll
        for (int ai = 0; ai < 2; ++ai)
#pragma unroll
            for (int m = 0; m < 4; ++m) gt[ai][m] = gate[u.pm * BM + ai * HALF + wr * 64 + m * 16 + fr];
#pragma unroll
        for (int ai = 0; ai < 2; ++ai)
#pragma unroll
            for (int m = 0; m < 4; ++m) {
                const int row = u.pm * BM + ai * HALF + wr * 64 + m * 16 + fr;
#pragma unroll
                for (int bj = 0; bj < 2; ++bj) *(u32x4*)(Y + (size_t)row * 2048 + col0 + bj * HALF) = pack8(acc[ai][bj][m][0] * gt[ai][m], acc[ai][bj][m][1] * gt[ai][m]);
            }
    }
};
struct QkvOrder {
    StaticOrder so; int G, c;
    __host__ __device__ void init(int G_, int c_) { so.init(8192, 7168, G_, c_); G = G_; c = c_; }
    __host__ __device__ bool next(int i, Unit& u) const {
        const long L = (long)i * G + c; if (L < so.nwg) return so.next(i, u);
        const int l = (int)(L - so.nwg); if (l >= 32) return false;
        u.pm = 32 + (l & 1); u.pn = l >> 1; return true;
    }
    __device__ __forceinline__ void a_ready(const Unit&) const {}
    __device__ __forceinline__ void done(const Unit&) const {}
};
template <class Epi, class Sched, bool ALIGN_EPI = false, bool SP2 = false, bool GATHER = false>
__device__ __forceinline__ void gemm_phase(PG8_LAS unsigned char* lds, const Gemm g, const Sched& S, const Epi& E) {
    int tid_ = threadIdx.x; asm volatile("" : "+v"(tid_));
    const int tid = tid_, wid = __builtin_amdgcn_readfirstlane(tid >> 6), lane = tid & 63, wr = wid >> 2, wc = wid & 3, fr = lane & 15, fq = lane >> 4;
    const int K = g.K, nt = K / BK;
    unsigned voffA[2], voffB[2];
#pragma unroll
    for (int i = 0; i < 2; ++i) { int R, C; stage_rc(tid * 16 + i * 8192, R, C); const int Rb = Epi::PERM ? ((R & ~31) + perm32(R & 31)) : R;
        voffA[i] = (unsigned)(R * K + C) * 2u; voffB[i] = (unsigned)(Rb * K + C) * 2u; }
    int Rr[2], Cc[2];
#pragma unroll
    for (int i = 0; i < 2; ++i) stage_rc(tid * 16 + i * 8192, Rr[i], Cc[i]);
    unsigned gcur[2][2], gnxt[2][2];
#pragma unroll
    for (int h = 0; h < 2; ++h)
#pragma unroll
        for (int i = 0; i < 2; ++i) { gcur[h][i] = voffA[i]; gnxt[h][i] = voffA[i]; }
#define PG8_GOFF(dst, pm_) do { _Pragma("unroll") for (int h_ = 0; h_ < 2; ++h_) _Pragma("unroll") for (int i_ = 0; i_ < 2; ++i_) { const int vr_ = (pm_) * BM + h_ * HALF + Rr[i_]; \
        const int ar_ = ((vr_ >> 9) & 1) * 4096 + g.gidx[vr_]; dst[h_][i_] = (unsigned)(ar_ * K + Cc[i_]) * 2u; } } while (0)
    const size_t kstep = (size_t)(BK * 2);
    const size_t hstep = (size_t)HALF * K * 2;
    const size_t tstep = 2 * hstep;
    const size_t hstepA = GATHER ? 0 : hstep, tstepA = GATHER ? 0 : tstep;
    const unsigned ldsw = (unsigned)wid * 1024u;
    const int aoff = lds_byte(wr * 64 + fr, fq * 8), boff = lds_byte(wc * 32 + fr, fq * 8);
#define PG8_SA(b, h) (((b) * 2 + (h)) * HTB)
#define PG8_SB(b, h) ((4 + (b) * 2 + (h)) * HTB)
#define PG8_STAGE(bufoff, gbase, voff) do { _Pragma("unroll") for (int _i = 0; _i < 2; ++_i) \
        __builtin_amdgcn_global_load_lds((const unsigned*)((const char*)(gbase) + (voff)[_i]), (PG8_LAS unsigned*)(lds + (bufoff) + ldsw + _i * 8192), 16, 0, 0); } while (0)
#define PG8_LDA(dst, b, h) do { _Pragma("unroll") for (int m = 0; m < 4; ++m) _Pragma("unroll") for (int k = 0; k < 2; ++k) dst[m][k] = *(const PG8_LAS bf16x8*)(lds + PG8_SA(b, h) + aoff + m * 2048 + k * 1024); } while (0)
#define PG8_LDB(dst, b, h) do { _Pragma("unroll") for (int n = 0; n < 2; ++n) _Pragma("unroll") for (int k = 0; k < 2; ++k) dst[n][k] = *(const PG8_LAS bf16x8*)(lds + PG8_SB(b, h) + boff + n * 2048 + k * 1024); } while (0)
#define PG8_MMA(ai, bj, At, Bt) do { __builtin_amdgcn_s_setprio(1); _Pragma("unroll") for (int m = 0; m < 4; ++m) _Pragma("unroll") for (int n = 0; n < 2; ++n) _Pragma("unroll") for (int k = 0; k < 2; ++k) \
        acc[ai][bj][m][n] = __builtin_amdgcn_mfma_f32_16x16x32_bf16(Bt[n][k], At[m][k], acc[ai][bj][m][n], 0, 0, 0); __builtin_amdgcn_s_setprio(0); } while (0)
#define PG8_WAIT_V(n) asm volatile("s_waitcnt vmcnt(" #n ")" ::: "memory")
#define PG8_WAIT_L(n) asm volatile("s_waitcnt lgkmcnt(" #n ")" ::: "memory")
#define PG8_BAR __builtin_amdgcn_s_barrier()
#define PG8_SCHED __builtin_amdgcn_sched_barrier(0)
    Unit cur, nxt; int ui = 0;
    if (!S.next(0, cur)) return;
    f32x4 acc[2][2][4][2];
#pragma unroll
    for (int a = 0; a < 2; ++a)
#pragma unroll
        for (int b = 0; b < 2; ++b)
#pragma unroll
            for (int m = 0; m < 4; ++m)
#pragma unroll
                for (int n = 0; n < 2; ++n) acc[a][b][m][n] = (f32x4){0.f, 0.f, 0.f, 0.f};
    bf16x8 At[4][2], B0[2][2], B1[2][2];
    if constexpr (GATHER) { PG8_GOFF(gcur, cur.pm); }
    const char* cA = (const char*)g.A + (size_t)cur.pm * tstepA; const char* cB = (const char*)g.Bt + g.bofs(cur.pm, cur.pn);
    S.a_ready(cur);
    if constexpr (SP2) {
        PG8_STAGE(PG8_SB(0, 0), cB, voffB); PG8_STAGE(PG8_SB(0, 1), cB + hstep, voffB); PG8_STAGE(PG8_SA(0, 0), cA, gcur[0]); PG8_STAGE(PG8_SA(0, 1), cA + hstepA, gcur[1]);
        if (wr == 1) PG8_BAR;
        PG8_WAIT_V(2); PG8_BAR;
        PG8_STAGE(PG8_SB(1, 0), cB + kstep, voffB); PG8_STAGE(PG8_SA(1, 0), cA + kstep, gcur[0]); PG8_STAGE(PG8_SB(1, 1), cB + hstep + kstep, voffB);
        PG8_WAIT_V(6); PG8_BAR;
    } else {
        PG8_STAGE(PG8_SB(0, 0), cB, voffB); PG8_STAGE(PG8_SA(0, 0), cA, gcur[0]); PG8_STAGE(PG8_SB(0, 1), cB + hstep, voffB); PG8_STAGE(PG8_SA(0, 1), cA + hstepA, gcur[1]);
        if (wr == 1) PG8_BAR;
        PG8_WAIT_V(4); PG8_BAR;
        PG8_STAGE(PG8_SB(1, 0), cB + kstep, voffB); PG8_STAGE(PG8_SA(1, 0), cA + kstep, gcur[0]); PG8_STAGE(PG8_SB(1, 1), cB + hstep + kstep, voffB);
        PG8_WAIT_V(6); PG8_BAR;
    }
    for (;;) {
        const bool has_next = S.next(ui + 1, nxt);
        if constexpr (GATHER) { if (has_next) { PG8_GOFF(gnxt, nxt.pm); } else { _Pragma("unroll") for (int h = 0; h < 2; ++h) _Pragma("unroll") for (int i = 0; i < 2; ++i) gnxt[h][i] = gcur[h][i]; } }
        const char* nA = has_next ? (const char*)g.A + (size_t)nxt.pm * tstepA : cA; const char* nB = has_next ? (const char*)g.Bt + g.bofs(nxt.pm, nxt.pn) : cB;
        for (int t = 0; t < nt; t += 2) {
            const bool last = (t == nt - 2);
            const char* a1 = cA + (size_t)(t + 1) * kstep;
            const char* a2 = last ? nA : cA + (size_t)(t + 2) * kstep; const char* b2 = last ? nB : cB + (size_t)(t + 2) * kstep;
            const char* a3 = a2 + kstep; const char* b3 = b2 + kstep;
            unsigned g2[2][2];
#pragma unroll
            for (int h = 0; h < 2; ++h)
#pragma unroll
                for (int i = 0; i < 2; ++i) g2[h][i] = (GATHER && last) ? gnxt[h][i] : gcur[h][i];
            if (last && has_next) S.a_ready(nxt);
            if constexpr (SP2) {
            PG8_LDB(B0, 0, 0); PG8_LDB(B1, 0, 1); PG8_SCHED; PG8_LDA(At, 0, 0); PG8_STAGE(PG8_SA(1, 1), a1 + hstepA, gcur[1]);
            PG8_WAIT_V(8); PG8_WAIT_L(0); PG8_BAR; PG8_MMA(0, 0, At, B0); PG8_MMA(0, 1, At, B1); PG8_BAR; PG8_SCHED;
            PG8_LDA(At, 0, 1); PG8_STAGE(PG8_SB(0, 0), b2, voffB); PG8_STAGE(PG8_SB(0, 1), b2 + hstep, voffB); PG8_STAGE(PG8_SA(0, 0), a2, g2[0]);
            PG8_WAIT_V(8); PG8_WAIT_L(0); PG8_BAR; PG8_MMA(1, 0, At, B0); PG8_MMA(1, 1, At, B1); PG8_BAR; PG8_SCHED;
            PG8_LDB(B0, 1, 0); PG8_LDB(B1, 1, 1); PG8_SCHED; PG8_LDA(At, 1, 0); PG8_STAGE(PG8_SA(0, 1), a2 + hstepA, g2[1]);
            PG8_WAIT_V(8); PG8_WAIT_L(0); PG8_BAR; PG8_MMA(0, 0, At, B0); PG8_MMA(0, 1, At, B1); PG8_BAR; PG8_SCHED;
            PG8_LDA(At, 1, 1); PG8_STAGE(PG8_SB(1, 0), b3, voffB); PG8_STAGE(PG8_SB(1, 1), b3 + hstep, voffB); PG8_STAGE(PG8_SA(1, 0), a3, g2[0]);
            PG8_WAIT_V(8); PG8_WAIT_L(0); PG8_BAR; PG8_MMA(1, 0, At, B0); PG8_MMA(1, 1, At, B1); PG8_BAR; PG8_SCHED;
            } else {
            PG8_LDB(B0, 0, 0); PG8_SCHED; PG8_LDA(At, 0, 0); PG8_STAGE(PG8_SA(1, 1), a1 + hstepA, gcur[1]);
            PG8_WAIT_L(8); PG8_BAR; PG8_WAIT_L(0); PG8_MMA(0, 0, At, B0); PG8_BAR; PG8_SCHED;
            PG8_LDB(B1, 0, 1); PG8_STAGE(PG8_SB(0, 0), b2, voffB);
            PG8_BAR; PG8_WAIT_L(0); PG8_MMA(0, 1, At, B1); PG8_BAR;
            PG8_LDA(At, 0, 1); PG8_STAGE(PG8_SA(0, 0), a2, g2[0]);
            PG8_BAR; PG8_WAIT_L(0); PG8_MMA(1, 0, At, B0); PG8_BAR; PG8_SCHED;
            PG8_STAGE(PG8_SB(0, 1), b2 + hstep, voffB);
            PG8_WAIT_V(6); PG8_BAR; PG8_MMA(1, 1, At, B1); PG8_BAR;
            PG8_LDB(B0, 1, 0); PG8_SCHED; PG8_LDA(At, 1, 0); PG8_STAGE(PG8_SA(0, 1), a2 + hstepA, g2[1]);
            PG8_WAIT_L(8); PG8_BAR; PG8_WAIT_L(0); PG8_MMA(0, 0, At, B0); PG8_BAR; PG8_SCHED;
            PG8_LDB(B1, 1, 1); PG8_STAGE(PG8_SB(1, 0), b3, voffB);
            PG8_BAR; PG8_WAIT_L(0); PG8_MMA(0, 1, At, B1); PG8_BAR;
            PG8_LDA(At, 1, 1); PG8_STAGE(PG8_SA(1, 0), a3, g2[0]);
            PG8_BAR; PG8_WAIT_L(0); PG8_MMA(1, 0, At, B0); PG8_BAR; PG8_SCHED;
            PG8_STAGE(PG8_SB(1, 1), b3 + hstep, voffB);
            PG8_WAIT_V(6); PG8_BAR; PG8_MMA(1, 1, At, B1); PG8_BAR;
            }
        }
        if constexpr (ALIGN_EPI) { if (wr == 0) PG8_BAR; }
        if constexpr (!Epi::AFTER_DRAIN) { E(acc, cur, wr, wc, fr, fq); S.done(cur); }
        if (!has_next) break;
#pragma unroll
        for (int a = 0; a < 2; ++a)
#pragma unroll
            for (int b = 0; b < 2; ++b)
#pragma unroll
                for (int m = 0; m < 4; ++m)
#pragma unroll
                    for (int n = 0; n < 2; ++n) acc[a][b][m][n] = (f32x4){0.f, 0.f, 0.f, 0.f};
        cur = nxt; cA = nA; cB = nB; ++ui;
#pragma unroll
        for (int h = 0; h < 2; ++h)
#pragma unroll
            for (int i = 0; i < 2; ++i) gcur[h][i] = gnxt[h][i];
        if constexpr (ALIGN_EPI) { if (wr == 1) PG8_BAR; }
    }
    PG8_WAIT_V(0);
    if constexpr (!ALIGN_EPI) { if (wr == 0) PG8_BAR; }
    PG8_BAR;
    if constexpr (Epi::AFTER_DRAIN) { E.fused(acc, cur, wr, wc, fr, fq, lds, wid, lane); S.done(cur); }
#undef PG8_SA
#undef PG8_SB
#undef PG8_STAGE
#undef PG8_LDA
#undef PG8_LDB
#undef PG8_MMA
#undef PG8_WAIT_V
#undef PG8_WAIT_L
#undef PG8_BAR
#undef PG8_SCHED
#undef PG8_GOFF
}
}

constexpr int NWAVES = 8;
#ifndef MK_N_LAUNCHES
#define MK_N_LAUNCHES 1
#endif
constexpr int PER_PHASE = 13;
constexpr int N_LAUNCHES = MK_N_LAUNCHES;

constexpr int DM = 2048, NB = 2, SEQ = 4096, CTXL = 256, NEXP = 16, FF = 1024, CAP = 512;
constexpr int MLAT = NB * SEQ, MALL = MLAT + NB * CTXL, NIN = 7168, NMOD = 6 * DM;
constexpr float EPS = 1e-6f;
constexpr int MOD_KC = 8;

constexpr size_t MiB = 1u << 20, KiB = 1u << 10;
constexpr size_t WS_CTL = 0, CTL_ZERO_BYTES = 64 * KiB;
constexpr size_t WS_MODP = 1 * MiB;
constexpr size_t WS_MOD = 2 * MiB + 512 * KiB;
constexpr size_t WS_ROPE = 2 * MiB + 768 * KiB;
constexpr size_t WS_AFF = 3 * MiB;
constexpr size_t WS_SLOT = 3 * MiB + 512 * KiB;
constexpr size_t WS_IDX = 4 * MiB, WS_GATE = 4 * MiB + 64 * KiB;
constexpr size_t WS_WIN = 8 * MiB, WS_WOUT = 36 * MiB, WS_WGU = 44 * MiB, WS_WDN = 172 * MiB;
constexpr size_t WS_U = 236 * MiB;
constexpr size_t WS_QKV = 270 * MiB;
constexpr size_t WS_XE = 270 * MiB, WS_HID = 334 * MiB;
constexpr size_t WS_MIX = 389 * MiB;
constexpr size_t WS_KV = 421 * MiB;
constexpr size_t WS_YE = 421 * MiB;
constexpr size_t WS_ST = 489 * MiB;
constexpr size_t WS_HLAT = 521 * MiB;
constexpr size_t WS_END = 585 * MiB;
constexpr int CW_BAR = 1024;

constexpr int RING_BYTES = 131072;
constexpr int LDSCTL_OFF = 143360, MISC_OFF = LDSCTL_OFF + 320;
constexpr int LDS_BYTES = 147456;

#define GAS __attribute__((address_space(1)))
#define LAS __attribute__((address_space(3)))
typedef unsigned short bf16;
typedef unsigned v4u __attribute__((ext_vector_type(4)));
typedef unsigned v2u __attribute__((ext_vector_type(2)));
typedef float f32x4 __attribute__((ext_vector_type(4)));
typedef float f32x2 __attribute__((ext_vector_type(2)));
typedef float f32x16 __attribute__((ext_vector_type(16)));
typedef short bf16x8 __attribute__((ext_vector_type(8)));
typedef short s16x4 __attribute__((ext_vector_type(4)));
#define RLX_AGENT __ATOMIC_RELAXED, __HIP_MEMORY_SCOPE_AGENT
#define LDS_WAIT() asm volatile("s_waitcnt lgkmcnt(0)" ::: "memory")
#define VM_WAIT() asm volatile("s_waitcnt vmcnt(0)" ::: "memory")
#define SBAR() __builtin_amdgcn_sched_barrier(0)
typedef __bf16 bf16x2_t __attribute__((ext_vector_type(2)));
__device__ __forceinline__ unsigned cvtpk(float lo, float hi) { const f32x2 v = {lo, hi}; const bf16x2_t b = __builtin_convertvector(v, bf16x2_t); return __builtin_bit_cast(unsigned, b); }
__device__ __forceinline__ float bf2f(unsigned short b) { return __builtin_bit_cast(float, (unsigned)b << 16); }
__device__ __forceinline__ float silu_f(float x) { return x / (1.0f + __expf(-x)); }
__device__ __forceinline__ float log_sigmoid_f(float x) { return -log1pf(expf(-x)); }
#define DPP_ADD(v, ctrl) ((v) + __builtin_bit_cast(float, __builtin_amdgcn_update_dpp(0, __builtin_bit_cast(int, (v)), (ctrl), 0xf, 0xf, true)))
__device__ __forceinline__ float wave_sum(float v) {
    v = DPP_ADD(v, 0xB1); v = DPP_ADD(v, 0x4E); v = DPP_ADD(v, 0x141); v = DPP_ADD(v, 0x140);
    { auto r = __builtin_amdgcn_permlane16_swap(__float_as_uint(v), __float_as_uint(v), false, false); v = __uint_as_float(r[0]) + __uint_as_float(r[1]); }
    { auto r = __builtin_amdgcn_permlane32_swap(__float_as_uint(v), __float_as_uint(v), false, false); v = __uint_as_float(r[0]) + __uint_as_float(r[1]); }
    return v;
}
__device__ __forceinline__ int opq(int v) { asm volatile("" : "+v"(v)); return v; }
__device__ __forceinline__ int crow(int r, int hi) { return (r & 3) + 8 * (r >> 2) + 4 * hi; }

#define XB_TMO      128
#define XB_XCNT(j)  (256  + 64 * (j))
#define XB_XSUB(j)  (1280 + 64 * (j))
#define XB_XGEN(j)  (2304 + 64 * (j))
#define XB_TOP      3328
#define XB_TOPGEN   3392
#define XCD_BAR_WORDS 3456
#define XB_SPIN_CAP (1u << 18)

__device__ __forceinline__ unsigned xb_ld(unsigned* p)              { return __hip_atomic_load(p, __ATOMIC_RELAXED, __HIP_MEMORY_SCOPE_AGENT); }
__device__ __forceinline__ unsigned xb_add(unsigned* p, unsigned v) { return __hip_atomic_fetch_add(p, v, __ATOMIC_RELAXED, __HIP_MEMORY_SCOPE_AGENT); }
__device__ __forceinline__ unsigned xb_xcc_id() { return (unsigned)__builtin_amdgcn_s_getreg((3 << 11) | 20) & 0xFu; }
#define XB_SPIN(cond, bar) do { unsigned _sp = 0; while (cond) { __builtin_amdgcn_s_sleep(1); \
    if ((++_sp & 255u) == 0u) { if (xb_ld(&(bar)[XB_TMO])) break; if (_sp > XB_SPIN_CAP) { atomicAdd(&(bar)[XB_TMO], 1u); break; } } } } while (0)

struct XcdBarrier {
    unsigned* bar; unsigned x;
    volatile LAS unsigned* st;
};

__device__ __forceinline__ XcdBarrier xcd_barrier_post(unsigned* bar, volatile LAS unsigned* st) {
    XcdBarrier b; b.bar = bar; b.x = xb_xcc_id(); b.st = st;
    if (threadIdx.x == 0) (void)xb_add(&bar[XB_XCNT(b.x)], 1u);
    return b;
}
__device__ __forceinline__ void xcd_barrier_complete(unsigned* bar, unsigned x, unsigned& nloc, unsigned& nx) {
    const unsigned G = gridDim.x * gridDim.y * gridDim.z;
    unsigned sum, cnt, mine, sp = 0u;
    for (;;) {
        sum = 0u; cnt = 0u; mine = 0u;
#pragma unroll
        for (unsigned j = 0; j < 16; ++j) { const unsigned c = xb_ld(&bar[XB_XCNT(j)]); sum += c; cnt += (c > 0u) ? 1u : 0u; mine = (j == x) ? c : mine; }
        if (sum == G) break;
        __builtin_amdgcn_s_sleep(1);
        if ((++sp & 255u) == 0u) { if (xb_ld(&bar[XB_TMO])) break; if (sp > XB_SPIN_CAP) { atomicAdd(&bar[XB_TMO], 1u); break; } }
    }
    nloc = mine > 0u ? mine : 1u; nx = cnt > 0u ? cnt : 1u;
}

__device__ __forceinline__ void xcd_barrier(const XcdBarrier& b) {
    asm volatile("s_waitcnt vmcnt(0)" ::: "memory");
    __syncthreads();
    if (threadIdx.x == 0) {
        unsigned* bar = b.bar;
        __builtin_amdgcn_s_waitcnt(0);
        unsigned nloc = b.st[0], nx = b.st[1];
        if (nloc == 0u) { xcd_barrier_complete(bar, b.x, nloc, nx); b.st[0] = nloc; b.st[1] = nx; }
        const unsigned old = xb_add(&bar[XB_XSUB(b.x)], 1u);
        const unsigned gen = old / nloc;
        if (old + 1u == (gen + 1u) * nloc) {
            __builtin_amdgcn_fence(__ATOMIC_RELEASE, "agent");
            asm volatile("s_waitcnt vmcnt(0)" ::: "memory");
            const unsigned og = xb_add(&bar[XB_TOP], 1u);
            const unsigned tg = og / nx;
            if (og + 1u == (tg + 1u) * nx) xb_add(&bar[XB_TOPGEN], 1u);
            else XB_SPIN(xb_ld(&bar[XB_TOPGEN]) == tg, bar);
            __builtin_amdgcn_fence(__ATOMIC_ACQUIRE, "agent");
            xb_add(&bar[XB_XGEN(b.x)], 1u);
            asm volatile("s_waitcnt vmcnt(0)" ::: "memory");
        } else {
            XB_SPIN(xb_ld(&bar[XB_XGEN(b.x)]) == gen, bar);
            __builtin_amdgcn_fence(__ATOMIC_ACQUIRE, "agent");
            asm volatile("s_waitcnt vmcnt(0)" ::: "memory");
        }
    }
    __syncthreads();
}

struct Args { const float* in[19]; float* out; unsigned char* ws; int ph_lo, ph_hi, li, pad; };
struct Ctx {
    const Args* a; unsigned char* lds;
    int wave;
    __device__ __forceinline__ int G() const { return (int)gridDim.x; }
    __device__ __forceinline__ int vcu() const { const int g = (int)gridDim.x, bx = (int)blockIdx.x; return (g % 8 == 0) ? (bx % 8) * (g / 8) + bx / 8 : bx; }
    __device__ __forceinline__ int gw() const { return vcu() * 8 + wave; }
    __device__ __forceinline__ int NGW() const { return (int)gridDim.x * 8; }
    __device__ __forceinline__ const float* x() const { return a->in[0]; } __device__ __forceinline__ const float* c() const { return a->in[1]; } __device__ __forceinline__ const float* ctxt() const { return a->in[2]; } __device__ __forceinline__ const float* c_ctx() const { return a->in[3]; } __device__ __forceinline__ const float* w_mod() const { return a->in[4]; } __device__ __forceinline__ const float* b_mod() const { return a->in[5]; } __device__ __forceinline__ const float* nmix() const { return a->in[6]; } __device__ __forceinline__ const float* nffn() const { return a->in[7]; } __device__ __forceinline__ const float* w_in() const { return a->in[8]; } __device__ __forceinline__ const float* rpb() const { return a->in[9]; } __device__ __forceinline__ const float* dec_f() const { return a->in[10]; } __device__ __forceinline__ const float* dec_b() const { return a->in[11]; } __device__ __forceinline__ const float* gn_w() const { return a->in[12]; } __device__ __forceinline__ const float* w_out() const { return a->in[13]; } __device__ __forceinline__ const float* w_router() const { return a->in[14]; } __device__ __forceinline__ const float* w_gate() const { return a->in[15]; } __device__ __forceinline__ const float* w_up() const { return a->in[16]; } __device__ __forceinline__ const float* w_down() const { return a->in[17]; } __device__ __forceinline__ const float* fin_w() const { return a->in[18]; }
    __device__ __forceinline__ float* out() const { return a->out; } __device__ __forceinline__ unsigned char* ws() const { return a->ws; }
};

__device__ __forceinline__ void p0_modpart(const Ctx& C, int u0, int ustep) {
    const int TID_ = opq((int)threadIdx.x), LANE_ = TID_ & 63;
    float* sv = (float*)(C.lds + C.wave * 16384);
    float* modp = (float*)(C.ws() + WS_MODP);
    for (int unit = u0; unit < 96 * MOD_KC; unit += ustep) {
        const int nc = unit % 96, kc = unit / 96, n0 = nc * 128 + LANE_ * 2;
        f32x2 a0 = {0.f, 0.f}, a1 = {0.f, 0.f}, a2 = {0.f, 0.f};
        for (int sub = 0; sub < 2048 / MOD_KC / 256; ++sub) {
            const int k0 = kc * (2048 / MOD_KC) + sub * 256;
#pragma unroll
            for (int i = 0; i < 4; ++i) { const int kk = LANE_ + 64 * i, k = k0 + kk;
                sv[kk] = silu_f(C.c()[k]); sv[256 + kk] = silu_f(C.c()[2048 + k]); sv[512 + kk] = silu_f(C.c_ctx()[k]); }
            LDS_WAIT();
            const float* wp = C.w_mod() + (size_t)k0 * NMOD + n0;
            for (int kb = 0; kb < 256; kb += 32) {
                f32x2 w[32];
#pragma unroll
                for (int i = 0; i < 32; ++i) w[i] = __builtin_nontemporal_load((const f32x2*)(wp + (size_t)(kb + i) * NMOD));
#pragma unroll
                for (int i = 0; i < 32; ++i) { const float s0 = sv[kb + i], s1 = sv[256 + kb + i], s2 = sv[512 + kb + i]; a0 += w[i] * s0; a1 += w[i] * s1; a2 += w[i] * s2; }
            }
            LDS_WAIT();
        }
        *(f32x2*)(modp + (size_t)(kc * 3 + 0) * NMOD + n0) = a0; *(f32x2*)(modp + (size_t)(kc * 3 + 1) * NMOD + n0) = a1; *(f32x2*)(modp + (size_t)(kc * 3 + 2) * NMOD + n0) = a2;
    }
}
template <int MODE> __device__ __forceinline__ int orow_map(int n) {
    if (MODE == 1) { const int t = n >> 10; if (t == 2 || t == 5) { const int d = n & 127, a = d >> 6, nn = (d >> 5) & 1, i = d & 31; return (n & ~127) + 32 * (2 * a + (i >> 4)) + 8 * ((i >> 2) & 3) + 4 * nn + (i & 3); } return n; }
    if (MODE == 2) return (n >> 7) * 256 + (n & 127);
    if (MODE == 3) return (n >> 7) * 256 + 128 + (n & 127);
    return n;
}
__device__ __forceinline__ int orow_rt(int mode, int n) { return mode == 1 ? orow_map<1>(n) : mode == 2 ? orow_map<2>(n) : mode == 3 ? orow_map<3>(n) : n; }
constexpr int CONV_I_IN = 32 * 224, CONV_I_OUT = 32 * 64, CONV_I_GU = 16 * 1024, CONV_NITEMS = CONV_I_IN + CONV_I_OUT + 3 * CONV_I_GU, CONV_DEFER = 12 * 1024;
constexpr int CONV_P0_END = CONV_I_IN + 2560, CONV_P8_BEGIN = CONV_NITEMS - CONV_DEFER - 5120;
struct ConvDesc { const float* src; bf16* dst; int N, K, mode, n0; };
__device__ __forceinline__ ConvDesc conv_desc(const Ctx& C, int it) {
    const float* W; bf16* WT; int K, N, mode, item; int r = it;
    if (r < CONV_I_IN) { W = C.w_in(); K = 2048; N = NIN; WT = (bf16*)(C.ws() + WS_WIN); mode = 1; item = r; }
    else if ((r -= CONV_I_IN) < CONV_I_OUT) { W = C.w_out(); K = 2048; N = 2048; WT = (bf16*)(C.ws() + WS_WOUT); mode = 0; item = r; }
    else if ((r -= CONV_I_OUT) < CONV_I_GU) { const int e = r >> 10; W = C.w_gate() + (size_t)e * 2048 * 1024; K = 2048; N = 1024; WT = (bf16*)(C.ws() + WS_WGU) + (size_t)e * 2048 * 2048; mode = 2; item = r & 1023; }
    else if ((r -= CONV_I_GU) < CONV_I_GU) { const int e = r >> 10; W = C.w_up() + (size_t)e * 2048 * 1024; K = 2048; N = 1024; WT = (bf16*)(C.ws() + WS_WGU) + (size_t)e * 2048 * 2048; mode = 3; item = r & 1023; }
    else { r -= CONV_I_GU; const int e = r >> 10; W = C.w_down() + (size_t)e * 1024 * 2048; K = 1024; N = 2048; WT = (bf16*)(C.ws() + WS_WDN) + (size_t)e * 2048 * 1024; mode = 0; item = r & 1023; }
    const int nblk = N / 32, kb = item / nblk, nb = item % nblk, k0 = 64 * kb, n0 = 32 * nb;
    ConvDesc d; d.src = W + (size_t)k0 * N + n0; d.dst = WT + k0; d.N = N; d.K = K; d.mode = mode; d.n0 = n0; return d;
}
template <bool NT> __device__ __forceinline__ void conv_load(const ConvDesc& d, float (&tv)[32], int lane) {
#pragma unroll
    for (int i = 0; i < 8; ++i) { const f32x4* p_ = (const f32x4*)(d.src + (size_t)(8 * i + (lane >> 3)) * d.N + 4 * (lane & 7)); const f32x4 t = NT ? __builtin_nontemporal_load(p_) : *p_; tv[4 * i] = t.x; tv[4 * i + 1] = t.y; tv[4 * i + 2] = t.z; tv[4 * i + 3] = t.w; }
}
__device__ __forceinline__ void conv_store(const ConvDesc& d, const float (&tv)[32], float* scr, int lane) {
#pragma unroll
    for (int i = 0; i < 8; ++i) *(f32x4*)((char*)scr + (8 * i + (lane >> 3)) * 128 + (((lane & 7) ^ i) * 16)) = (f32x4){tv[4 * i], tv[4 * i + 1], tv[4 * i + 2], tv[4 * i + 3]};
    LDS_WAIT();
    const int c = lane & 7;
#pragma unroll
    for (int j = 0; j < 4; ++j) { const int n = (lane >> 3) + 8 * j; const char* s = (const char*)scr + (8 * c) * 128 + (((n >> 2) ^ c) * 16) + (n & 3) * 4;
        v4u o; o.x = cvtpk(*(const float*)(s + 0 * 128), *(const float*)(s + 1 * 128)); o.y = cvtpk(*(const float*)(s + 2 * 128), *(const float*)(s + 3 * 128));
        o.z = cvtpk(*(const float*)(s + 4 * 128), *(const float*)(s + 5 * 128)); o.w = cvtpk(*(const float*)(s + 6 * 128), *(const float*)(s + 7 * 128));
        *(v4u*)(d.dst + (size_t)orow_rt(d.mode, d.n0 + n) * d.K + 8 * c) = o; }
    LDS_WAIT();
}
template <bool NT> __device__ __forceinline__ void conv_run(const Ctx& C, int first, int last, int step, float* scr, int lane) {
    if (first >= last) return;
    ConvDesc d0 = conv_desc(C, first); float t0[32]; conv_load<NT>(d0, t0, lane);
    const int i1 = (first + step < last) ? first + step : first;
    ConvDesc d1 = conv_desc(C, i1); float t1[32]; conv_load<NT>(d1, t1, lane);
    for (int it = first; it < last; it += step) {
        const int nx = (it + 2 * step < last) ? it + 2 * step : it;
        const ConvDesc d2 = conv_desc(C, nx); float t2[32]; conv_load<NT>(d2, t2, lane);
        conv_store(d0, t0, scr, lane);
        d0 = d1; d1 = d2;
#pragma unroll
        for (int i = 0; i < 32; ++i) { t0[i] = t1[i]; t1[i] = t2[i]; }
    }
}
__device__ __forceinline__ bool conv_split(const Ctx& C) { return (C.G() & 15) == 0; }
__device__ __forceinline__ void conv_p3(const Ctx& C, int cblk, int ncblk) {
    const int LANE_ = opq((int)threadIdx.x) & 63;
    conv_run<false>(C, CONV_P0_END + cblk * NWAVES + C.wave, CONV_P8_BEGIN, ncblk * NWAVES, (float*)(C.lds + C.wave * 16384), LANE_);
}
__device__ __forceinline__ void conv_p8(const Ctx& C) {
    const int LANE_ = opq((int)threadIdx.x) & 63; const int bx = (int)blockIdx.x, G = C.G();
    const int first_blk = G > NB * NEXP ? NB * NEXP : 0; if (bx < first_blk) return;
    conv_run<false>(C, CONV_P8_BEGIN + (bx - first_blk) * NWAVES + C.wave, CONV_NITEMS - CONV_DEFER, (G - first_blk) * NWAVES, (float*)(C.lds + C.wave * 16384), LANE_);
}
__device__ __forceinline__ void conv_deferred(const Ctx& C, int nunits) {
    const int LANE_ = opq((int)threadIdx.x) & 63;
    const int G = C.G(), rounds = (nunits + G - 1) / G; int cfirst = nunits - (rounds - 1) * G; if (cfirst >= G) cfirst = 0;
    const int bx = (int)blockIdx.x; if (bx < cfirst) return;
    const int nw = (G - cfirst) * NWAVES, lw = (bx - cfirst) * NWAVES + C.wave;
    conv_run<false>(C, CONV_NITEMS - CONV_DEFER + lw, CONV_NITEMS, nw, (float*)(C.lds + C.wave * 16384), LANE_);
}
__device__ __forceinline__ void p0_prologue(const Ctx& C) {
    const int TID_ = opq((int)threadIdx.x), LANE_ = TID_ & 63;
    const int gw = C.gw(), r8 = gw & 7, g8 = gw >> 3, n8 = C.NGW() >> 3;
    const bool host = r8 < 3;
#ifndef PROBE_P0G
#define PROBE_P0G 1
#endif
#ifndef PROBE_P0C
#define PROBE_P0C 1
#endif
    if (host) { for (int pr_ = 0; pr_ < PROBE_P0G; ++pr_) p0_modpart(C, g8 * 3 + r8, n8 * 3); }
    const int tw = g8 * 5 + (r8 - 3), ntw = n8 * 5;
    float* scr = (float*)(C.lds + C.wave * 16384);
    if (!host) { for (int pr_ = 0; pr_ < PROBE_P0C; ++pr_) conv_run<true>(C, tw, conv_split(C) ? CONV_P0_END : CONV_P8_BEGIN, ntw, scr, LANE_); }
    if (blockIdx.x == 0) { float* rc = (float*)(C.ws() + WS_ROPE); float* rs = rc + 2048;
        for (int i = TID_; i < 2048; i += NWAVES * 64) { const int pos = i >> 5, f = i & 31; const float inv = powf(10000.0f, -(float)(2 * f) / 64.0f); const float ang = (float)pos * inv; rc[i] = cosf(ang); rs[i] = sinf(ang); } }
}

__device__ __forceinline__ void p1_rows(const Ctx& C) {
    const int TID_ = opq((int)threadIdx.x), LANE_ = TID_ & 63;
    float* tab = (float*)C.lds;
    const int m0 = C.gw(); f32x4 v[8];
    { const int mq = m0 < MALL ? m0 : 0; const float* src0 = mq < MLAT ? C.x() + (size_t)mq * DM : C.ctxt() + (size_t)(mq - MLAT) * DM;
#pragma unroll
      for (int j = 0; j < 8; ++j) v[j] = __builtin_nontemporal_load((const f32x4*)src0 + LANE_ + 64 * j); }
    const float* modp = (const float*)(C.ws() + WS_MODP);
#pragma unroll
    for (int hh = 0; hh < 2; ++hh) { f32x4 tv[3];
#pragma unroll
      for (int i = 0; i < 3; ++i) { const int q = TID_ + 512 * (3 * hh + i), r = q >> 10, n4 = (q & 1023) * 4; tv[i] = *(const f32x4*)(C.b_mod() + n4);
#pragma unroll
          for (int kc = 0; kc < MOD_KC; ++kc) tv[i] += *(const f32x4*)(modp + (size_t)(kc * 3 + r) * NMOD + n4); }
#pragma unroll
      for (int i = 0; i < 3; ++i) { const int q = TID_ + 512 * (3 * hh + i); *(f32x4*)(tab + q * 4) = tv[i]; } }
    { const int g = blockIdx.x * (NWAVES * 64) + TID_; float* mod = (float*)(C.ws() + WS_MOD);
      for (int q = g; q < 3 * NMOD; q += C.G() * NWAVES * 64) { const int r = q / NMOD, n = q % NMOD; float v = C.b_mod()[n];
#pragma unroll
          for (int kc = 0; kc < MOD_KC; ++kc) v += modp[(size_t)(kc * 3 + r) * NMOD + n];
          mod[q] = v; } }
    __syncthreads();
    bf16* U = (bf16*)(C.ws() + WS_U);
    f32x4 nwv[8];
#pragma unroll
    for (int j = 0; j < 8; ++j) nwv[j] = *(const f32x4*)(C.nmix() + (LANE_ + 64 * j) * 4);
    for (int m = m0; m < MALL; m += C.NGW()) {
        const int r = m < MLAT ? (m >> 12) : 2; const int mn = m + C.NGW();
        f32x4 vn[8];
        { const int mq = mn < MALL ? mn : m; const float* srcn = mq < MLAT ? C.x() + (size_t)mq * DM : C.ctxt() + (size_t)(mq - MLAT) * DM;
#pragma unroll
          for (int j = 0; j < 8; ++j) vn[j] = __builtin_nontemporal_load((const f32x4*)srcn + LANE_ + 64 * j); }
        float s = 0.f;
#pragma unroll
        for (int j = 0; j < 8; ++j) s += (v[j].x * v[j].x + v[j].y * v[j].y) + (v[j].z * v[j].z + v[j].w * v[j].w);
        const float rstd = 1.0f / sqrtf(wave_sum(s) * (1.0f / DM) + EPS);
#pragma unroll
        for (int j = 0; j < 8; ++j) { const int col = (LANE_ + 64 * j) * 4; const f32x4 nw = nwv[j], sh = *(const f32x4*)(tab + r * 4096 + col), sc = *(const f32x4*)(tab + r * 4096 + 2048 + col);
            const f32x4 u = (v[j] * rstd * nw) * (sc + 1.0f) + sh; v2u o; o.x = cvtpk(u.x, u.y); o.y = cvtpk(u.z, u.w); *(v2u*)(U + (size_t)m * DM + col) = o; }
#pragma unroll
        for (int j = 0; j < 8; ++j) v[j] = vn[j];
    }
    __syncthreads();
}

namespace na {
constexpr float SCALE = 0.088388347648318440f, THR = 8.f;
constexpr int LD = NIN, KVBLK = 64, NT = 16;
constexpr int SHM_V = 16384, SHM_K = 16384, OFF_WS = 65536, OFF_TAB = 65536 + 2048;
#define KSWZ(row, colB) ((row) * 256 + ((colB) ^ (((row) & 7) << 4)))
__device__ __forceinline__ bf16x8 ld8(const bf16* p) { return *reinterpret_cast<const bf16x8*>(p); }
__device__ __forceinline__ void partialSM(f32x16& p0, f32x16& p1, float& m_reg, float& mn, float& alpha) {
  constexpr float C = SCALE * 1.4426950408889634f;
  float pmax = p0[0];
#pragma unroll
  for (int r = 1; r < 16; ++r) pmax = fmaxf(pmax, p0[r]);
#pragma unroll
  for (int r = 0; r < 16; ++r) pmax = fmaxf(pmax, p1[r]);
  { auto rr = __builtin_amdgcn_permlane32_swap(__float_as_uint(pmax), __float_as_uint(pmax), false, false);
    pmax = fmaxf(__uint_as_float(rr[0]), __uint_as_float(rr[1])); }
  if (__builtin_expect(__all(pmax - m_reg <= THR / SCALE), 1)) { mn = m_reg; alpha = 1.f; }
  else { mn = fmaxf(m_reg, pmax); alpha = __builtin_amdgcn_exp2f((m_reg - mn) * C); m_reg = mn; }
  float mnC = -mn * C;
#pragma unroll
  for (int r = 0; r < 16; ++r) p0[r] = fmaf(p0[r], C, mnC);
#pragma unroll
  for (int r = 0; r < 16; ++r) p1[r] = fmaf(p1[r], C, mnC);
#pragma unroll
  for (int r = 0; r < 16; ++r) p0[r] = __builtin_amdgcn_exp2f(p0[r]);
}
#define NA_PK4(P, BASE, OUT) do { unsigned a0 = cvtpk(P[BASE + 0], P[BASE + 1]), a1 = cvtpk(P[BASE + 2], P[BASE + 3]);   \
    unsigned b0 = cvtpk(P[BASE + 4], P[BASE + 5]), b1 = cvtpk(P[BASE + 6], P[BASE + 7]);                              \
    auto r0 = __builtin_amdgcn_permlane32_swap(a0, b0, false, false); auto r1 = __builtin_amdgcn_permlane32_swap(a1, b1, false, false); \
    v4u w = {r0[0], r1[0], r0[1], r1[1]}; OUT = *reinterpret_cast<bf16x8*>(&w); } while (0)
__device__ __forceinline__ void finishSM(f32x16& p0, f32x16& p1, float alpha, float& l_reg, bf16x8& pa0, bf16x8& pa1, bf16x8& pa2, bf16x8& pa3) {
#pragma unroll
  for (int r = 0; r < 16; ++r) p1[r] = __builtin_amdgcn_exp2f(p1[r]);
  float ps = 0;
#pragma unroll
  for (int r = 0; r < 16; ++r) ps += p0[r];
#pragma unroll
  for (int r = 0; r < 16; ++r) ps += p1[r];
  { auto rr = __builtin_amdgcn_permlane32_swap(__float_as_uint(ps), __float_as_uint(ps), false, false);
    ps = __uint_as_float(rr[0]) + __uint_as_float(rr[1]); }
  l_reg = l_reg * alpha + ps;
  NA_PK4(p0, 0, pa0); NA_PK4(p0, 8, pa1); NA_PK4(p1, 0, pa2); NA_PK4(p1, 8, pa3);
}
__device__ __forceinline__ void qkt(f32x16& p0, f32x16& p1, const bf16* Ks, const bf16x8* qr, int r32, int hi) {
  p0 = f32x16{}; p1 = f32x16{};
#pragma unroll
  for (int d0 = 0; d0 < 8; ++d0) { int cb = (d0 * 16 + hi * 8) * 2;
    bf16x8 b0 = *reinterpret_cast<const bf16x8*>((const char*)Ks + KSWZ(r32, cb));
    bf16x8 b1 = *reinterpret_cast<const bf16x8*>((const char*)Ks + KSWZ(32 + r32, cb));
    p0 = __builtin_amdgcn_mfma_f32_32x32x16_bf16(b0, qr[d0], p0, 0, 0, 0);
    p1 = __builtin_amdgcn_mfma_f32_32x32x16_bf16(b1, qr[d0], p1, 0, 0, 0); }
}
__device__ __forceinline__ int v_st(int k, int c) { const int kk = (k & ~0xC) | ((k & 4) << 1) | ((k & 8) >> 1); return ((kk >> 3) * 4 + (c >> 5)) * 512 + ((kk & 7) * 32 + (c & 31)) * 2; }
__device__ __forceinline__ int v_rd_base(int lane) { return ((lane & 3) << 3) | (((lane >> 2) & 3) << 6) | (((lane >> 4) & 1) << 5) | (((lane >> 5) & 1) << 8); }
constexpr int v_rd_off(int d0, int ks, int half) { return d0 * 512 + ks * 4096 + half * 2048; }
template <int OFF> __device__ __forceinline__ s16x4 tr_read(int vb) {
  s16x4 r; asm volatile("ds_read_b64_tr_b16 %0, %1 offset:%2" : "=&v"(r) : "v"(vb), "i"(OFF) : "memory"); return r;
}
template <int D0> __device__ __forceinline__ void pv_one(f32x16& od, int vb, bf16x8 pa0, bf16x8 pa1, bf16x8 pa2, bf16x8 pa3) {
  const s16x4 l0 = tr_read<v_rd_off(D0, 0, 0)>(vb), h0 = tr_read<v_rd_off(D0, 0, 1)>(vb), l1 = tr_read<v_rd_off(D0, 1, 0)>(vb), h1 = tr_read<v_rd_off(D0, 1, 1)>(vb);
  const s16x4 l2 = tr_read<v_rd_off(D0, 2, 0)>(vb), h2 = tr_read<v_rd_off(D0, 2, 1)>(vb), l3 = tr_read<v_rd_off(D0, 3, 0)>(vb), h3 = tr_read<v_rd_off(D0, 3, 1)>(vb);
  asm volatile("s_waitcnt lgkmcnt(0)" ::: "memory"); SBAR();
#define NA_PK(L, H) (bf16x8){L[0], L[1], L[2], L[3], H[0], H[1], H[2], H[3]}
  od = __builtin_amdgcn_mfma_f32_32x32x16_bf16(pa0, NA_PK(l0, h0), od, 0, 0, 0);
  od = __builtin_amdgcn_mfma_f32_32x32x16_bf16(pa1, NA_PK(l1, h1), od, 0, 0, 0);
  od = __builtin_amdgcn_mfma_f32_32x32x16_bf16(pa2, NA_PK(l2, h2), od, 0, 0, 0);
  od = __builtin_amdgcn_mfma_f32_32x32x16_bf16(pa3, NA_PK(l3, h3), od, 0, 0, 0);
}
__device__ __forceinline__ void pv_d0(f32x16* o, int vb, bf16x8 pa0, bf16x8 pa1, bf16x8 pa2, bf16x8 pa3) {
  pv_one<0>(o[0], vb, pa0, pa1, pa2, pa3); pv_one<1>(o[1], vb, pa0, pa1, pa2, pa3); pv_one<2>(o[2], vb, pa0, pa1, pa2, pa3); pv_one<3>(o[3], vb, pa0, pa1, pa2, pa3);
}
__device__ __forceinline__ void na_bias(f32x16& p0, f32x16& p1, int j, int kr_lo, int r, int rs, const float* trow, float pen_a, float pen_b, float pen_c) {
  if (j < 4) return;
  const int kr = kr_lo + j - 4; const bool inwin = (kr >= rs) && (kr < rs + 8); const float NEG = -1e30f;
  if (inwin) {
    const float* brow = trow + (kr - r + 7) * 128;
#pragma unroll
    for (int e = 0; e < 16; ++e) { const int k0 = (e & 3) + 8 * (e >> 2); p0[e] = (p0[e] + brow[k0]) + (e < 8 ? pen_a : pen_b); }
    SBAR();
#pragma unroll
    for (int e = 0; e < 16; ++e) { const int k0 = (e & 3) + 8 * (e >> 2); p1[e] = (p1[e] + brow[k0 + 32]) + (e < 8 ? pen_b : pen_c); }
  } else {
#pragma unroll
    for (int e = 0; e < 16; ++e) { p0[e] = NEG; p1[e] = NEG; }
  }
}
__device__ __forceinline__ void na_unit(const bf16* __restrict__ QKV, bf16* __restrict__ MIX, const float* __restrict__ rpb, int b, int h, int rg, char* lds) {
  const int tid = opq((int)threadIdx.x), wid = __builtin_amdgcn_readfirstlane(tid >> 6), lane = tid & 63, r32 = lane & 31, hi = lane >> 5;
  bf16* V_lds = (bf16*)lds; bf16* K_lds = (bf16*)(lds + 2 * SHM_V);
  float* ws = (float*)(lds + OFF_WS) + wid * 64; float* li_l = ws; float* al_l = ws + 32;
  float* tab = (float*)(lds + OFF_TAB);
  for (int i = tid; i < 2 * 15 * 128; i += 512) { const int t = i / 1920, q = i - t * 1920, ro = q >> 7, xx = (q & 127) - 48;
    const bool inr = t == 0 ? (xx >= 7 && xx <= 22) : (xx >= 0 && xx <= 30);
    tab[i] = inr ? rpb[h * 465 + ro * 31 + xx] * (1.f / SCALE) : (t == 0 ? -1e30f : 0.f); }
  const int r = 4 * rg + (wid >> 1), cq = 32 * (wid & 1) + r32;
  const int rs = min(max(r - 4, 0), 56), kr_lo = min(max(4 * rg - 4, 0), 52);
  const bool edgeL = cq < 8, edgeR = cq > 56; const float penL = edgeL ? -1e30f : 0.f, penR = edgeR ? -1e30f : 0.f;
  const float pen_a = penR, pen_b = penL + penR, pen_c = penL;
  const float* trow = tab + ((edgeL || edgeR) ? 1920 : 0) + 63 - cq + 4 * hi;
  const long rowc = MLAT + b * CTXL, rowl = (long)b * SEQ + kr_lo * 64;
#define NA_TROW(j) ((j) < 4 ? rowc + 64 * (j) : rowl + 64 * ((j) - 4))
  const bf16* Kh = QKV + h * 128; const bf16* Vh = QKV + 1024 + h * 128;
  float m_reg = -1e30f, l_reg = 0; f32x16 o[4] = {}; bf16x8 qr[8];
  const bf16* Qw = QKV + (long)(b * SEQ + rg * 256 + wid * 32 + r32) * LD + 4096 + h * 128 + hi * 8;
#pragma unroll
  for (int d0 = 0; d0 < 8; ++d0) qr[d0] = ld8(Qw + d0 * 16);
  const int sr = tid >> 4, sc = (tid & 15) * 8, vst0 = v_st(sr, sc), vst1 = v_st(32 + sr, sc);
  const int vb0 = (int)(uintptr_t)V_lds + v_rd_base(lane);
  struct { bf16x8 vs0, vs1, ks0, ks1; } sr_[2];
#define NA_SLOAD(i, j) do { const long t0_ = NA_TROW(j); sr_[i].vs0 = ld8(&Vh[(t0_ + sr) * LD + sc]); sr_[i].vs1 = ld8(&Vh[(t0_ + 32 + sr) * LD + sc]); \
    sr_[i].ks0 = ld8(&Kh[(t0_ + sr) * LD + sc]); sr_[i].ks1 = ld8(&Kh[(t0_ + 32 + sr) * LD + sc]); } while (0)
#define NA_SWRITE(bb, i) do { *(bf16x8*)((char*)V_lds + (bb) * SHM_V + vst0) = sr_[i].vs0;          \
    *(bf16x8*)((char*)V_lds + (bb) * SHM_V + vst1) = sr_[i].vs1; int kc = sc * 2;               \
    *(bf16x8*)((char*)K_lds + (bb) * SHM_K + KSWZ(sr, kc)) = sr_[i].ks0;                       \
    *(bf16x8*)((char*)K_lds + (bb) * SHM_K + KSWZ(32 + sr, kc)) = sr_[i].ks1; } while (0)
#define NA_SWAIT() asm volatile("s_waitcnt vmcnt(4)" ::: "memory")
#define NA_RESC(a) do { if (__any((a) < 1.f)) { if (hi == 0) al_l[r32] = (a); asm volatile("s_waitcnt lgkmcnt(0)" ::: "memory"); \
    _Pragma("unroll") for (int d = 0; d < 4; ++d) _Pragma("unroll") for (int rr_ = 0; rr_ < 16; ++rr_) o[d][rr_] *= al_l[crow(rr_, hi)]; } } while (0)
#define NA_BIAS(P0, P1, j) do { SBAR(); na_bias(P0, P1, (j), kr_lo, r, rs, trow, pen_a, pen_b, pen_c); SBAR(); } while (0)
  f32x16 pA0, pA1, pB0, pB1; float mnA, mnB, alA, alB; bf16x8 pa0, pa1, pa2, pa3;
  constexpr int SE = 0, SO = 1;
  NA_SLOAD(SE, 0); asm volatile("s_waitcnt vmcnt(0)" ::: "memory"); NA_SWRITE(0, SE); __syncthreads();
  qkt(pA0, pA1, K_lds, qr, r32, hi); partialSM(pA0, pA1, m_reg, mnA, alA);
  NA_SLOAD(SO, 1); NA_SLOAD(SE, 2);
  NA_SWAIT(); NA_SWRITE(1, SO); __syncthreads();
  for (int j = 1; j + 1 < NT; j += 2) {
    SBAR(); qkt(pB0, pB1, (bf16*)((char*)K_lds + SHM_K), qr, r32, hi);
    finishSM(pA0, pA1, alA, l_reg, pa0, pa1, pa2, pa3); SBAR();
    NA_SLOAD(SO, j + 2); SBAR();
    pv_d0(o, vb0, pa0, pa1, pa2, pa3); NA_BIAS(pB0, pB1, j); partialSM(pB0, pB1, m_reg, mnB, alB);
    __syncthreads(); NA_SWAIT(); NA_SWRITE(0, SE);
    NA_RESC(alB); __syncthreads();
    SBAR(); qkt(pA0, pA1, K_lds, qr, r32, hi);
    finishSM(pB0, pB1, alB, l_reg, pa0, pa1, pa2, pa3); SBAR();
    if (j + 3 < NT) NA_SLOAD(SE, j + 3); SBAR();
    pv_d0(o, vb0 + SHM_V, pa0, pa1, pa2, pa3); NA_BIAS(pA0, pA1, j + 1); partialSM(pA0, pA1, m_reg, mnA, alA);
    __syncthreads(); NA_SWAIT(); NA_SWRITE(1, SO);
    NA_RESC(alA); __syncthreads();
  }
  SBAR(); qkt(pB0, pB1, (bf16*)((char*)K_lds + SHM_K), qr, r32, hi);
  finishSM(pA0, pA1, alA, l_reg, pa0, pa1, pa2, pa3); SBAR();
  pv_d0(o, vb0, pa0, pa1, pa2, pa3); NA_BIAS(pB0, pB1, NT - 1); partialSM(pB0, pB1, m_reg, mnB, alB);
  __syncthreads(); NA_RESC(alB);
  finishSM(pB0, pB1, alB, l_reg, pa0, pa1, pa2, pa3); SBAR();
  pv_d0(o, vb0 + SHM_V, pa0, pa1, pa2, pa3);
  if (hi == 0) li_l[r32] = l_reg; asm volatile("s_waitcnt lgkmcnt(0)" ::: "memory");
  float rli[16];
#pragma unroll
  for (int rr_ = 0; rr_ < 16; ++rr_) rli[rr_] = __builtin_amdgcn_rcpf(li_l[crow(rr_, hi)]);
  bf16* Ow = MIX + (long)(b * SEQ + rg * 256 + wid * 32) * DM + h * 128;
#pragma unroll
  for (int rr_ = 0; rr_ < 16; ++rr_) { const int orow = crow(rr_, hi);
#pragma unroll
    for (int d0 = 0; d0 < 4; d0 += 1) { const unsigned pk = cvtpk(o[d0][rr_] * rli[rr_], 0.f); Ow[(long)orow * DM + d0 * 32 + r32] = (bf16)(pk & 0xffffu); } }
  __syncthreads();
#undef NA_SLOAD
#undef NA_SWRITE
#undef NA_SWAIT
#undef NA_RESC
#undef NA_BIAS
#undef NA_TROW
}
}

namespace ret {
typedef const LAS char* lds_cptr;
typedef short v4i16_t __attribute__((ext_vector_type(4)));
__device__ __forceinline__ s16x4 vtr(lds_cptr p) { return __builtin_bit_cast(s16x4, __builtin_amdgcn_ds_read_tr16_b64_v4i16((LAS v4i16_t*)p)); }
__device__ __forceinline__ bf16x8 tr_frag(lds_cptr base, int pitchB, int t0, int c0, int lane) {
    const int g = lane >> 4, q = (lane & 15) >> 2, p = lane & 3;
    lds_cptr a = base + (t0 + 8 * (g >> 1) + q) * pitchB + (c0 + 16 * (g & 1) + 4 * p) * 2;
    const s16x4 lo = vtr(a), hi4 = vtr(a + 4 * pitchB);
    return (bf16x8){lo[0], lo[1], lo[2], lo[3], hi4[0], hi4[1], hi4[2], hi4[3]};
}
__device__ __forceinline__ bf16x8 scale_frag8(bf16x8 a, f32x4 w0, f32x4 w1) {
    const v4u x = __builtin_bit_cast(v4u, a); v4u o;
    o.x = cvtpk(__builtin_bit_cast(float, x.x << 16) * w0.x, __builtin_bit_cast(float, x.x & 0xffff0000u) * w0.y);
    o.y = cvtpk(__builtin_bit_cast(float, x.y << 16) * w0.z, __builtin_bit_cast(float, x.y & 0xffff0000u) * w0.w);
    o.z = cvtpk(__builtin_bit_cast(float, x.z << 16) * w1.x, __builtin_bit_cast(float, x.z & 0xffff0000u) * w1.y);
    o.w = cvtpk(__builtin_bit_cast(float, x.w << 16) * w1.z, __builtin_bit_cast(float, x.w & 0xffff0000u) * w1.w);
    return __builtin_bit_cast(bf16x8, o);
}
__device__ __forceinline__ bf16x8 scale_frag1(bf16x8 a, float w) { const f32x4 w4 = {w, w, w, w}; return scale_frag8(a, w4, w4); }

constexpr int KV_PITCH = 320;
constexpr int KV_OFF_K = 0, KV_OFF_V = 128 * KV_PITCH, KV_OFF_W = 2 * 128 * KV_PITCH;
__device__ __forceinline__ void kv_item(const Ctx& C, int b, int h, int c) {
    const int TID_ = opq((int)threadIdx.x), LANE_ = TID_ & 63;
    const bf16* QKV = (const bf16*)(C.ws() + WS_QKV); bf16* KVB = (bf16*)(C.ws() + WS_KV);
    char* lds = (char*)C.lds; const int tid = TID_, lane = LANE_, wid = C.wave, r32 = lane & 31, hi = lane >> 5;
    const long rowbase = c < 2 ? (long)MLAT + b * CTXL + c * 128 : (long)b * SEQ + (c - 2) * 128;
    float* wt = (float*)(lds + KV_OFF_W);
    if (tid < 256) { const int d = tid >> 7, t = tid & 127; const float lg = log_sigmoid_f(d ? C.dec_b()[h] : C.dec_f()[h]); wt[tid] = expf(lg * (float)(d ? t : 127 - t)); }
#pragma unroll
    for (int i = 0; i < 4; ++i) { const int piece = tid + 512 * i, row = piece >> 4, cc = piece & 15;
        const bf16* src = QKV + (rowbase + row) * NIN + h * 128 + cc * 8;
        const v4u kx = *(const v4u*)(src + 2048), vx = *(const v4u*)(src + 3072);
        *(v4u*)(lds + KV_OFF_K + row * KV_PITCH + cc * 16) = kx; *(v4u*)(lds + KV_OFF_V + row * KV_PITCH + cc * 16) = vx; }
    __syncthreads();
    const lds_cptr Kb = (lds_cptr)(lds + KV_OFF_K), Vb = (lds_cptr)(lds + KV_OFF_V);
    const int dvb = wid & 3, dk0 = 2 * (wid >> 2);
    f32x16 acc[2][2] = {};
#pragma unroll
    for (int ks = 0; ks < 8; ++ks) {
        const bf16x8 v = tr_frag(Vb, KV_PITCH, 16 * ks, 32 * dvb, lane);
        const f32x4 wf0 = *(const f32x4*)(wt + 16 * ks + 8 * hi), wf1 = *(const f32x4*)(wt + 16 * ks + 8 * hi + 4);
        const f32x4 wb0 = *(const f32x4*)(wt + 128 + 16 * ks + 8 * hi), wb1 = *(const f32x4*)(wt + 128 + 16 * ks + 8 * hi + 4);
        const bf16x8 vf = scale_frag8(v, wf0, wf1), vb = scale_frag8(v, wb0, wb1);
#pragma unroll
        for (int d = 0; d < 2; ++d) { const bf16x8 kf = tr_frag(Kb, KV_PITCH, 16 * ks, 32 * (dk0 + d), lane);
            acc[0][d] = __builtin_amdgcn_mfma_f32_32x32x16_bf16(kf, vf, acc[0][d], 0, 0, 0);
            acc[1][d] = __builtin_amdgcn_mfma_f32_32x32x16_bf16(kf, vb, acc[1][d], 0, 0, 0); }
    }
#pragma unroll
    for (int dir = 0; dir < 2; ++dir)
#pragma unroll
        for (int d = 0; d < 2; ++d) { bf16* dst = KVB + ((size_t)(((b * 8 + h) * 2 + dir) * 34 + c)) * 16384 + (size_t)(32 * dvb + r32) * 128 + 32 * (dk0 + d) + 4 * hi;
#pragma unroll
            for (int g = 0; g < 4; ++g) { v2u o; o.x = cvtpk(acc[dir][d][4 * g], acc[dir][d][4 * g + 1]); o.y = cvtpk(acc[dir][d][4 * g + 2], acc[dir][d][4 * g + 3]); *(v2u*)(dst + 8 * g) = o; } }
    __syncthreads();
}

__device__ __forceinline__ void scan_phase(const Ctx& C) {
    const int TID_ = opq((int)threadIdx.x), LANE_ = TID_ & 63;
    const bf16* KVB = (const bf16*)(C.ws() + WS_KV); bf16* ST = (bf16*)(C.ws() + WS_ST);
    for (int g = blockIdx.x * (NWAVES * 64) + TID_; g < 32 * 4096; g += C.G() * NWAVES * 64) {
        const int grp = g >> 12, e4 = g & 4095, h = (grp >> 1) & 7, dir = grp & 1;
        const float G = expf(128.0f * log_sigmoid_f(dir ? C.dec_b()[h] : C.dec_f()[h]));
        const v2u* kv = (const v2u*)(KVB + (size_t)grp * 34 * 16384) + e4;
        bf16* st = ST + (size_t)grp * 32 * 16384 + e4 * 4;
#define KV4(c_) ({ const v2u t_ = kv[(size_t)(c_) * 4096]; (f32x4){__builtin_bit_cast(float, t_.x << 16), __builtin_bit_cast(float, t_.x & 0xffff0000u), __builtin_bit_cast(float, t_.y << 16), __builtin_bit_cast(float, t_.y & 0xffff0000u)}; })
        f32x4 S;
        if (dir == 0) {
            S = KV4(0) * G + KV4(1); { v2u o; o.x = cvtpk(S.x, S.y); o.y = cvtpk(S.z, S.w); *(v2u*)(st) = o; }
#pragma unroll 4
            for (int n = 0; n < 31; ++n) { S = S * G + KV4(n + 2); v2u o; o.x = cvtpk(S.x, S.y); o.y = cvtpk(S.z, S.w); *(v2u*)(st + (size_t)(n + 1) * 16384) = o; }
        } else {
            S = KV4(0) + KV4(1) * G; { v2u o; o.x = cvtpk(S.x, S.y); o.y = cvtpk(S.z, S.w); *(v2u*)(st + (size_t)31 * 16384) = o; }
#pragma unroll 4
            for (int n = 31; n >= 1; --n) { S = S * G + KV4(n + 2); v2u o; o.x = cvtpk(S.x, S.y); o.y = cvtpk(S.z, S.w); *(v2u*)(st + (size_t)(n - 1) * 16384) = o; }
        }
#undef KV4
    }
}

constexpr int RO_OFF_K = 0, RO_OFF_V = 32768, RO_OFF_SF = 65536, RO_OFF_SB = 98304, RO_OFF_ST = 131072;
__device__ __forceinline__ void ro_item(const Ctx& C, int b, int h, int n) {
    const int TID_ = opq((int)threadIdx.x), LANE_ = TID_ & 63;
    const bf16* QKV = (const bf16*)(C.ws() + WS_QKV); const bf16* ST = (const bf16*)(C.ws() + WS_ST); bf16* MIX = (bf16*)(C.ws() + WS_MIX);
    char* lds = (char*)C.lds; const int tid = TID_, lane = LANE_, wid = C.wave, r32 = lane & 31, hi = lane >> 5;
    const long rowbase = (long)b * SEQ + n * 128;
    const int ib = wid & 3, dh = wid >> 2, iq = 32 * ib + r32;
    bf16x8 qr[8];
    { const bf16* Qw = QKV + (rowbase + iq) * NIN + 5120 + h * 128 + hi * 8;
#pragma unroll
      for (int d0 = 0; d0 < 8; ++d0) qr[d0] = *(const bf16x8*)(Qw + d0 * 16); }
    unsigned gsp[16];
#pragma unroll
    for (int e = 0; e < 16; ++e) { const bf16* gp = QKV + (rowbase + 32 * ib + crow(e, hi)) * NIN + 6144 + h * 128 + 32 * (2 * dh) + r32; gsp[e] = (unsigned)gp[0] | ((unsigned)gp[32] << 16); }
    { const int sr = tid >> 4, sc = (tid & 15) * 8;
#pragma unroll
      for (int i = 0; i < 4; ++i) { const int row = sr + 32 * i; const bf16* src = QKV + (rowbase + row) * NIN + h * 128 + sc;
          const bf16x8 kx = *(const bf16x8*)(src + 2048), vx = *(const bf16x8*)(src + 3072);
          *(bf16x8*)(lds + RO_OFF_K + KSWZ(row, sc * 2)) = kx; *(bf16x8*)(lds + RO_OFF_V + (row >> 6) * 16384 + na::v_st(row & 63, sc)) = vx; }
      const bf16* Sf = ST + ((size_t)(((b * 8 + h) * 2 + 0) * 32 + n)) * 16384; const bf16* Sb = ST + ((size_t)(((b * 8 + h) * 2 + 1) * 32 + n)) * 16384;
#pragma unroll
      for (int i = 0; i < 4; ++i) { const int row = sr + 32 * i; const bf16x8 fx = *(const bf16x8*)(Sf + row * 128 + sc), bx = *(const bf16x8*)(Sb + row * 128 + sc);
          *(bf16x8*)(lds + RO_OFF_SF + KSWZ(row, sc * 2)) = fx; *(bf16x8*)(lds + RO_OFF_SB + KSWZ(row, sc * 2)) = bx; } }
    __syncthreads();
    const float L2E = 1.4426950408889634f; const float lf2 = log_sigmoid_f(C.dec_f()[h]) * L2E, lb2 = log_sigmoid_f(C.dec_b()[h]) * L2E;
    f32x16 o[2] = {};
#pragma unroll
    for (int tile = 0; tile < 2; ++tile) {
        f32x16 p0 = {}, p1 = {};
        const char* Ks = lds + RO_OFF_K;
#pragma unroll
        for (int d0 = 0; d0 < 8; ++d0) { const int cb = (d0 * 16 + hi * 8) * 2;
            const bf16x8 k0 = *(const bf16x8*)(Ks + KSWZ(64 * tile + r32, cb)), k1 = *(const bf16x8*)(Ks + KSWZ(64 * tile + 32 + r32, cb));
            p0 = __builtin_amdgcn_mfma_f32_32x32x16_bf16(k0, qr[d0], p0, 0, 0, 0);
            p1 = __builtin_amdgcn_mfma_f32_32x32x16_bf16(k1, qr[d0], p1, 0, 0, 0); }
        SBAR();
        { int dbi = iq - 64 * tile - 4 * hi; asm volatile("" : "+v"(dbi)); const float dbase = (float)dbi;
#pragma unroll
          for (int e = 0; e < 16; ++e) {
            const float d0_ = dbase - (float)((e & 3) + 8 * (e >> 2)), d1_ = d0_ - 32.0f;
            float f0 = __builtin_amdgcn_exp2f(lf2 * fmaxf(d0_, 0.f) + lb2 * fmaxf(-d0_, 0.f)), f1 = __builtin_amdgcn_exp2f(lf2 * fmaxf(d1_, 0.f) + lb2 * fmaxf(-d1_, 0.f));
            f0 = fmaf(f0, fmaxf(1.0f - fabsf(d0_), 0.f), f0); f1 = fmaf(f1, fmaxf(1.0f - fabsf(d1_), 0.f), f1);
            p0[e] *= f0; p1[e] *= f1; } }
        SBAR();
        bf16x8 pa0, pa1, pa2, pa3;
        NA_PK4(p0, 0, pa0); NA_PK4(p0, 8, pa1); NA_PK4(p1, 0, pa2); NA_PK4(p1, 8, pa3);
        const int vb = (int)(uintptr_t)(lds + RO_OFF_V + tile * 16384) + na::v_rd_base(lane);
        if (dh == 0) { na::pv_one<0>(o[0], vb, pa0, pa1, pa2, pa3); na::pv_one<1>(o[1], vb, pa0, pa1, pa2, pa3); }
        else         { na::pv_one<2>(o[0], vb, pa0, pa1, pa2, pa3); na::pv_one<3>(o[1], vb, pa0, pa1, pa2, pa3); }
    }
    {
        const float cf = __builtin_amdgcn_exp2f(lf2 * (float)(iq + 1)), cb_ = __builtin_amdgcn_exp2f(lb2 * (float)(128 - iq));
#pragma unroll
        for (int ks = 0; ks < 8; ++ks) { const bf16x8 qf = scale_frag1(qr[ks], cf), qb = scale_frag1(qr[ks], cb_);
#pragma unroll
            for (int d = 0; d < 2; ++d) { const int so = KSWZ(32 * (2 * dh + d) + r32, (16 * ks + 8 * hi) * 2);
                const bf16x8 sf = *(const bf16x8*)(lds + RO_OFF_SF + so), sb = *(const bf16x8*)(lds + RO_OFF_SB + so);
                o[d] = __builtin_amdgcn_mfma_f32_32x32x16_bf16(qf, sf, o[d], 0, 0, 0);
                o[d] = __builtin_amdgcn_mfma_f32_32x32x16_bf16(qb, sb, o[d], 0, 0, 0); } }
    }
    float* stats = (float*)(lds + RO_OFF_ST);
    {
      float v32[32];
#pragma unroll
      for (int e = 0; e < 16; ++e) { v32[e] = o[0][e] + o[1][e]; v32[16 + e] = o[0][e] * o[0][e] + o[1][e] * o[1][e]; }
#pragma unroll
      for (int L = 16; L >= 1; L >>= 1) { const bool up = (r32 & L) != 0;
#pragma unroll
          for (int i = 0; i < L; ++i) { const float keep = up ? v32[L + i] : v32[i], send = up ? v32[i] : v32[L + i]; v32[i] = keep + __shfl_xor(send, L); } }
      stats[((ib * 2 + dh) * 32 + crow(r32 & 15, hi)) * 2 + (r32 >> 4)] = v32[0]; }
    __syncthreads();
    const float* gnw = C.gn_w() + h * 128 + 32 * (2 * dh) + r32; const float gw0 = gnw[0], gw1 = gnw[32];
#pragma unroll
    for (int e = 0; e < 16; ++e) { const int q = crow(e, hi); const float* sa = stats + ((ib * 2 + 0) * 32 + q) * 2; const float* sb = stats + ((ib * 2 + 1) * 32 + q) * 2;
        const float mean = (sa[0] + sb[0]) * (1.0f / 128.0f), var = (sa[1] + sb[1]) * (1.0f / 128.0f) - mean * mean, rstd = 1.0f / sqrtf(fmaxf(var, 0.f) + EPS);
        const long row = rowbase + 32 * ib + q;
#pragma unroll
        for (int d = 0; d < 2; ++d) { const int dv = 32 * (2 * dh + d) + r32;
            const float y = (o[d][e] - mean) * rstd * (d ? gw1 : gw0) * __builtin_bit_cast(float, d ? (gsp[e] & 0xffff0000u) : (gsp[e] << 16));
            MIX[row * DM + 1024 + h * 128 + dv] = (bf16)(cvtpk(y, 0.f) & 0xffffu); } }
    __syncthreads();
}
}

__device__ __forceinline__ void p7_rows(const Ctx& C) {
    const int TID_ = opq((int)threadIdx.x), LANE_ = TID_ & 63;
    float* wrT = (float*)C.lds;
    { f32x4 wv[16];
#pragma unroll
      for (int i = 0; i < 16; ++i) wv[i] = ((const f32x4*)C.w_router())[TID_ + 512 * i];
#pragma unroll
      for (int i = 0; i < 16; ++i) { const int q = TID_ + 512 * i, col = q >> 2, e0 = (q & 3) * 4;
          wrT[(e0 + 0) * DM + col] = wv[i].x; wrT[(e0 + 1) * DM + col] = wv[i].y; wrT[(e0 + 2) * DM + col] = wv[i].z; wrT[(e0 + 3) * DM + col] = wv[i].w; } }
    __syncthreads();
    const float* mod = (const float*)(C.ws() + WS_MOD); bf16* U2 = (bf16*)(C.ws() + WS_U); float* AFF = (float*)(C.ws() + WS_AFF);
    const float* HL = (const float*)(C.ws() + WS_HLAT);
    for (int m = 2 * C.gw(); m < MLAT; m += 2 * C.NGW()) {
        const int b = m >> 12, n = m & 4095;
        f32x4 va[8], vb[8]; float sa = 0.f, sb = 0.f;
#pragma unroll
        for (int j = 0; j < 8; ++j) { va[j] = ((const f32x4*)(HL + (size_t)m * DM))[LANE_ + 64 * j]; vb[j] = ((const f32x4*)(HL + (size_t)(m + 1) * DM))[LANE_ + 64 * j]; }
#pragma unroll
        for (int j = 0; j < 8; ++j) { sa += (va[j].x * va[j].x + va[j].y * va[j].y) + (va[j].z * va[j].z + va[j].w * va[j].w); sb += (vb[j].x * vb[j].x + vb[j].y * vb[j].y) + (vb[j].z * vb[j].z + vb[j].w * vb[j].w); }
        const float ra = 1.0f / sqrtf(wave_sum(sa) * (1.0f / DM) + EPS), rb = 1.0f / sqrtf(wave_sum(sb) * (1.0f / DM) + EPS);
#pragma unroll
        for (int hq = 0; hq < 2; ++hq) {
            f32x4 nw[4], sh[4], sc[4];
#pragma unroll
            for (int jj = 0; jj < 4; ++jj) { const int col = (LANE_ + 64 * (4 * hq + jj)) * 4; nw[jj] = *(const f32x4*)(C.nffn() + col); sh[jj] = *(const f32x4*)(mod + b * NMOD + 3 * DM + col); sc[jj] = *(const f32x4*)(mod + b * NMOD + 4 * DM + col); }
#pragma unroll
            for (int jj = 0; jj < 4; ++jj) { const int j = 4 * hq + jj, col = (LANE_ + 64 * j) * 4;
                va[j] = (va[j] * ra * nw[jj]) * (sc[jj] + 1.0f) + sh[jj]; vb[j] = (vb[j] * rb * nw[jj]) * (sc[jj] + 1.0f) + sh[jj];
                v2u oa, ob; oa.x = cvtpk(va[j].x, va[j].y); oa.y = cvtpk(va[j].z, va[j].w); ob.x = cvtpk(vb[j].x, vb[j].y); ob.y = cvtpk(vb[j].z, vb[j].w);
                *(v2u*)(U2 + (size_t)m * DM + col) = oa; *(v2u*)(U2 + (size_t)(m + 1) * DM + col) = ob; }
            SBAR(); }
        float la[NEXP], lb[NEXP];
        int wo0 = LANE_ * 16, wo1 = LANE_ * 16 + 65536;
        asm volatile("" : "+v"(wo0), "+v"(wo1));
#pragma unroll
        for (int e = 0; e < NEXP; ++e) { f32x4 w[8];
#pragma unroll
            for (int j = 0; j < 8; ++j) w[j] = *(const f32x4*)((const char*)wrT + (e < 8 ? wo0 : wo1) + (e & 7) * 8192 + j * 1024);
            f32x2 a2 = {0.f, 0.f}, c2 = {0.f, 0.f};
#pragma unroll
            for (int j = 0; j < 8; ++j) { const f32x2 wl = {w[j].x, w[j].y}, wh = {w[j].z, w[j].w};
                a2 += (f32x2){va[j].x, va[j].y} * wl; a2 += (f32x2){va[j].z, va[j].w} * wh; c2 += (f32x2){vb[j].x, vb[j].y} * wl; c2 += (f32x2){vb[j].z, vb[j].w} * wh; }
            la[e] = a2.x + a2.y; lb[e] = c2.x + c2.y; if (e & 1) SBAR(); }
#pragma unroll
        for (int L = 8; L >= 1; L >>= 1) { const int B = L * 4; const bool up = (LANE_ & B) != 0;
#pragma unroll
            for (int i = 0; i < L; ++i) { const float ka = up ? la[L + i] : la[i], sa_ = up ? la[i] : la[L + i]; la[i] = ka + __shfl_xor(sa_, B);
                                          const float kb = up ? lb[L + i] : lb[i], sb_ = up ? lb[i] : lb[L + i]; lb[i] = kb + __shfl_xor(sb_, B); } }
        float ta = la[0], tb = lb[0]; ta += __shfl_xor(ta, 1); tb += __shfl_xor(tb, 1); ta += __shfl_xor(ta, 2); tb += __shfl_xor(tb, 2);
        float mxa = ta, mxb = tb;
#pragma unroll
        for (int B = 4; B < 64; B <<= 1) { mxa = fmaxf(mxa, __shfl_xor(mxa, B)); mxb = fmaxf(mxb, __shfl_xor(mxb, B)); }
        const float exa = expf(ta - mxa), exb = expf(tb - mxb); float sma = exa, smb = exb;
#pragma unroll
        for (int B = 4; B < 64; B <<= 1) { sma += __shfl_xor(sma, B); smb += __shfl_xor(smb, B); }
        if ((LANE_ & 3) == 0) { float* ap = AFF + (size_t)(b * NEXP + (LANE_ >> 2)) * SEQ + n; *(f32x2*)ap = (f32x2){exa / sma, exb / smb}; }
    }
    __syncthreads();
}

__device__ __forceinline__ void p8_topk(const Ctx& C, int b, int e) {
    const int TID_ = opq((int)threadIdx.x), LANE_ = TID_ & 63;
    unsigned* hist = (unsigned*)C.lds;
    unsigned* scal = hist + 256; unsigned* wtot = hist + 288;
    const float* aff = (const float*)(C.ws() + WS_AFF) + (size_t)(b * NEXP + e) * SEQ;
    int* SLOT = (int*)(C.ws() + WS_SLOT) + (size_t)(b * NEXP + e) * SEQ; int* IDX = (int*)(C.ws() + WS_IDX) + (e * 2 + b) * CAP; float* GATE = (float*)(C.ws() + WS_GATE) + (e * 2 + b) * CAP;
    const int tid = TID_, base = tid * 8;
    unsigned key[8]; { const v4u a = *(const v4u*)(aff + base), c2 = *(const v4u*)(aff + base + 4); key[0] = a.x; key[1] = a.y; key[2] = a.z; key[3] = a.w; key[4] = c2.x; key[5] = c2.y; key[6] = c2.z; key[7] = c2.w; }
    unsigned prefix = 0u, remaining = CAP;
#pragma unroll
    for (int pass = 0; pass < 4; ++pass) {
        const int shift = 24 - 8 * pass;
        if (tid < 256) hist[tid] = 0u;
        __syncthreads();
#pragma unroll
        for (int i = 0; i < 8; ++i) { const bool match = (pass == 0) || ((key[i] >> (shift + 8)) == (prefix >> (shift + 8))); if (match) atomicAdd(&hist[(key[i] >> shift) & 255u], 1u); }
        __syncthreads();
        {
          unsigned hcnt = 0u, suf = 0u;
          if (tid < 256) { hcnt = hist[tid]; suf = hcnt;
#pragma unroll
              for (int o = 1; o < 64; o <<= 1) { const unsigned t2 = __shfl_down(suf, o); if (LANE_ + o < 64) suf += t2; }
              if (LANE_ == 0) wtot[8 + C.wave] = suf; }
          __syncthreads();
          if (tid < 256) { for (int w = C.wave + 1; w < 4; ++w) suf += wtot[8 + w];
              if (suf >= remaining && suf - hcnt < remaining) { scal[0] = prefix | ((unsigned)tid << shift); scal[1] = remaining - (suf - hcnt); } }
        }
        __syncthreads();
        prefix = scal[0]; remaining = scal[1];
        __syncthreads();
    }
    unsigned cg = 0u, ce = 0u;
#pragma unroll
    for (int i = 0; i < 8; ++i) { cg += key[i] > prefix ? 1u : 0u; ce += key[i] == prefix ? 1u : 0u; }
    unsigned pk = cg | (ce << 16), inc = pk;
#pragma unroll
    for (int o = 1; o < 64; o <<= 1) { const unsigned t = __shfl_up(inc, o); if (LANE_ >= o) inc += t; }
    if (LANE_ == 63) wtot[C.wave] = inc;
    __syncthreads();
    unsigned woff = 0u;
    for (int w = 0; w < C.wave; ++w) woff += wtot[w];
    const unsigned excl = woff + inc - pk; unsigned rg_ = excl & 0xffffu, re_ = excl >> 16;
    const unsigned ngt = CAP - remaining;
#pragma unroll
    for (int i = 0; i < 8; ++i) { int slot = -1;
        if (key[i] > prefix) { slot = (int)rg_; ++rg_; }
        else if (key[i] == prefix) { if (re_ < remaining) slot = (int)(ngt + re_); ++re_; }
        SLOT[base + i] = slot;
        if (slot >= 0) { IDX[slot] = base + i; GATE[slot] = __builtin_bit_cast(float, key[i]); } }
    __syncthreads();
}

__device__ __forceinline__ void p9_gather(const Ctx& C) {
    const int TID_ = opq((int)threadIdx.x), LANE_ = TID_ & 63;
    const bf16* U2 = (const bf16*)(C.ws() + WS_U); bf16* XE = (bf16*)(C.ws() + WS_XE); const int* IDX = (const int*)(C.ws() + WS_IDX);
    for (int R = C.gw(); R < NEXP * NB * CAP; R += C.NGW()) {
        const int b = (R >> 9) & 1; const int tok = IDX[R];
        const v4u* src = (const v4u*)(U2 + (size_t)(b * SEQ + tok) * DM) + LANE_; v4u* dst = (v4u*)(XE + (size_t)R * DM) + LANE_;
        const v4u a0 = src[0], a1 = src[64], a2 = src[128], a3 = src[192];
        dst[0] = a0; dst[64] = a1; dst[128] = a2; dst[192] = a3;
    }
}

__device__ __forceinline__ void p12_final(const Ctx& C) {
    const int TID_ = opq((int)threadIdx.x), LANE_ = TID_ & 63;
    const float* mod = (const float*)(C.ws() + WS_MOD); const bf16* YE = (const bf16*)(C.ws() + WS_YE); const int* SLOT = (const int*)(C.ws() + WS_SLOT);
    const float* HL = (const float*)(C.ws() + WS_HLAT);
    f32x4 hv[8]; int sl;
    { const int mq = C.gw() < MLAT ? C.gw() : 0;
      sl = (LANE_ < NEXP) ? SLOT[(size_t)((mq >> 12) * NEXP + LANE_) * SEQ + (mq & 4095)] : -1;
#pragma unroll
      for (int j = 0; j < 8; ++j) hv[j] = __builtin_nontemporal_load((const f32x4*)(HL + (size_t)mq * DM) + LANE_ + 64 * j); }
    for (int m = C.gw(); m < MLAT; m += C.NGW()) {
        const int b = m >> 12; float* row = C.out() + (size_t)m * DM; const int mn = m + C.NGW();
        f32x4 hvn[8]; int sln;
        { const int mq = mn < MLAT ? mn : m;
          sln = (LANE_ < NEXP) ? SLOT[(size_t)((mq >> 12) * NEXP + LANE_) * SEQ + (mq & 4095)] : -1;
#pragma unroll
          for (int j = 0; j < 8; ++j) hvn[j] = __builtin_nontemporal_load((const f32x4*)(HL + (size_t)mq * DM) + LANE_ + 64 * j); }
        f32x4 acc[8];
#pragma unroll
        for (int j = 0; j < 8; ++j) acc[j] = (f32x4){0.f, 0.f, 0.f, 0.f};
        unsigned mk = (unsigned)__ballot(sl >= 0);
        while (mk) {
            const int e0 = __builtin_ctz(mk); mk &= mk - 1; const bool two = mk != 0u; const int e1 = two ? __builtin_ctz(mk) : e0; if (two) mk &= mk - 1;
            const int s0 = __builtin_amdgcn_readlane(sl, e0), s1 = __builtin_amdgcn_readlane(sl, e1);
            const v2u* y0 = (const v2u*)(YE + (size_t)((e0 * 2 + b) * CAP + s0) * DM) + LANE_; const v2u* y1 = (const v2u*)(YE + (size_t)((e1 * 2 + b) * CAP + s1) * DM) + LANE_;
            v2u a0[8], a1[8];
#pragma unroll
            for (int j = 0; j < 8; ++j) { a0[j] = __builtin_nontemporal_load(y0 + 64 * j); a1[j] = __builtin_nontemporal_load(y1 + 64 * j); }
            const float w1 = two ? 1.0f : 0.0f;
#pragma unroll
            for (int j = 0; j < 8; ++j) {
                acc[j].x += __builtin_bit_cast(float, a0[j].x << 16); acc[j].y += __builtin_bit_cast(float, a0[j].x & 0xffff0000u); acc[j].z += __builtin_bit_cast(float, a0[j].y << 16); acc[j].w += __builtin_bit_cast(float, a0[j].y & 0xffff0000u);
                acc[j].x += w1 * __builtin_bit_cast(float, a1[j].x << 16); acc[j].y += w1 * __builtin_bit_cast(float, a1[j].x & 0xffff0000u); acc[j].z += w1 * __builtin_bit_cast(float, a1[j].y << 16); acc[j].w += w1 * __builtin_bit_cast(float, a1[j].y & 0xffff0000u); }
        }
        f32x4 v[8]; float s2 = 0.f;
#pragma unroll
        for (int j = 0; j < 8; ++j) { const int col = (LANE_ + 64 * j) * 4; const f32x4 g5 = *(const f32x4*)(mod + b * NMOD + 5 * DM + col);
            v[j] = hv[j] + g5 * acc[j]; s2 += (v[j].x * v[j].x + v[j].y * v[j].y) + (v[j].z * v[j].z + v[j].w * v[j].w); }
        const float rstd = 1.0f / sqrtf(wave_sum(s2) * (1.0f / DM) + EPS);
        f32x4 fwv[8];
#pragma unroll
        for (int j = 0; j < 8; ++j) fwv[j] = *(const f32x4*)(C.fin_w() + (LANE_ + 64 * j) * 4);
#pragma unroll
        for (int j = 0; j < 8; ++j) __builtin_nontemporal_store(v[j] * rstd * fwv[j], (f32x4*)row + LANE_ + 64 * j);
#pragma unroll
        for (int j = 0; j < 8; ++j) hv[j] = hvn[j];
        sl = sln;
    }
}

__global__ void __launch_bounds__(NWAVES * 64, 2) fwd_megakernel(Args args) {
    extern __shared__ __attribute__((aligned(16))) unsigned char lds[];
    Ctx C;
    C.a = &args; C.lds = lds;
    C.wave = __builtin_amdgcn_readfirstlane((int)threadIdx.x >> 6);
    volatile LAS unsigned* MISC = (volatile LAS unsigned*)((LAS unsigned char*)lds + MISC_OFF);
    for (int u = threadIdx.x; u < (LDS_BYTES - LDSCTL_OFF) / 4; u += NWAVES * 64) ((LAS unsigned*)((LAS unsigned char*)lds + LDSCTL_OFF))[u] = 0u;
    __syncthreads();
    unsigned* ctl = (unsigned*)(args.ws + WS_CTL);
    XcdBarrier bar; bar.bar = ctl + CW_BAR; bar.x = 0; bar.st = nullptr;
    if (N_LAUNCHES == 1) bar = xcd_barrier_post(ctl + CW_BAR, MISC + 8);
#ifndef PROBE_BARX
#define PROBE_BARX 1
#endif
#define GRID_BAR() do { if (N_LAUNCHES == 1) { for (int bb_ = 0; bb_ < PROBE_BARX; ++bb_) xcd_barrier(bar); } } while (0)
#ifndef PHASE_MASK
#define PHASE_MASK 0x1fff
#endif
#define IN(k) ((((PHASE_MASK) >> (k)) & 1) && args.ph_lo <= (k) && (k) < args.ph_hi)
#define BOTH(k) (IN(k) && IN((k) + 1))
#ifndef PROBE_MASK
#define PROBE_MASK 0
#endif
#define REPS(k) ((((PROBE_MASK) >> (k)) & 1) ? 2 : 1)
    PG8_LAS unsigned char* ring = (PG8_LAS unsigned char*)lds;
#ifdef PROBE_STAMP
    unsigned long long t_start_ = __builtin_amdgcn_s_memrealtime(), t_mark_ = t_start_;
#define STAMP(k) do { if ((k) == PROBE_STAMP) t_mark_ = __builtin_amdgcn_s_memrealtime(); } while (0)
#else
#define STAMP(k) do { } while (0)
#endif

    if (IN(0)) for (int rep_ = 0; rep_ < REPS(0); ++rep_) { p0_prologue(C); if (BOTH(0) || rep_ + 1 < REPS(0)) GRID_BAR(); }
    STAMP(0);
    if (IN(1)) for (int rep_ = 0; rep_ < REPS(1); ++rep_) { p1_rows(C); if (BOTH(1) || rep_ + 1 < REPS(1)) GRID_BAR(); }
    STAMP(1);
    if (IN(2)) for (int rep_ = 0; rep_ < REPS(2); ++rep_) {
        pg8::Gemm g{(const pg8::bf16_t*)(args.ws + WS_U), (const pg8::bf16_t*)(args.ws + WS_WIN), MALL, NIN, DM, 0, 0, nullptr};
        pg8::QkvOrder S; S.init(C.G(), (int)blockIdx.x);
        pg8::EpiQKV E{(pg8::bf16_t*)(args.ws + WS_QKV), (const float*)(args.ws + WS_ROPE), (const float*)(args.ws + WS_ROPE) + 2048};
        pg8::gemm_phase<pg8::EpiQKV, pg8::QkvOrder, true, true>(ring, g, S, E);
        conv_deferred(C, 928);
        if (BOTH(2) || rep_ + 1 < REPS(2)) GRID_BAR();
    }
    STAMP(2);
    if (IN(3)) for (int rep_ = 0; rep_ < REPS(3); ++rep_) {
#ifndef NO_NA
        if (conv_split(C)) {
            const int bx = (int)blockIdx.x, G = C.G(), q = (bx & 7) * (G >> 4) + (bx >> 4);
            if (((bx >> 3) & 1) == 0) { for (int u = 2 * q; u < 256; u += G) { na::na_unit((const bf16*)(args.ws + WS_QKV), (bf16*)(args.ws + WS_MIX), C.rpb(), u >> 7, (u >> 4) & 7, u & 15, (char*)lds);
                                                                                na::na_unit((const bf16*)(args.ws + WS_QKV), (bf16*)(args.ws + WS_MIX), C.rpb(), (u + 1) >> 7, ((u + 1) >> 4) & 7, (u + 1) & 15, (char*)lds); } }
            else { conv_p3(C, q, G >> 1); __syncthreads(); }
        } else
        for (int u = C.vcu(); u < 256; u += C.G()) { const int bh = u >> 4; na::na_unit((const bf16*)(args.ws + WS_QKV), (bf16*)(args.ws + WS_MIX), C.rpb(), bh >> 3, bh & 7, u & 15, (char*)lds); }
#endif
#ifndef NO_KV
        for (int it = C.vcu(); it < 544; it += C.G()) { const int bh = it / 34; ret::kv_item(C, bh >> 3, bh & 7, it % 34); }
#endif
        if (BOTH(3) || rep_ + 1 < REPS(3)) GRID_BAR();
    }
    STAMP(3);
    if (IN(4)) for (int rep_ = 0; rep_ < REPS(4); ++rep_) { ret::scan_phase(C); if (BOTH(4) || rep_ + 1 < REPS(4)) GRID_BAR(); }
    STAMP(4);
    if (IN(5)) for (int rep_ = 0; rep_ < REPS(5); ++rep_) {
        for (int it = C.vcu(); it < 512; it += C.G()) ret::ro_item(C, it >> 8, (it >> 5) & 7, it & 31);
        if (BOTH(5) || rep_ + 1 < REPS(5)) GRID_BAR();
    }
    STAMP(5);
    if (IN(6)) for (int rep_ = 0; rep_ < REPS(6); ++rep_) {
        pg8::Gemm g{(const pg8::bf16_t*)(args.ws + WS_MIX), (const pg8::bf16_t*)(args.ws + WS_WOUT), MLAT, DM, DM, 0, 0, nullptr};
        pg8::StaticOrder S; S.init(MLAT, DM, C.G(), (int)blockIdx.x);
        pg8::EpiOut E{C.x(), (float*)(args.ws + WS_HLAT), (const float*)(args.ws + WS_MOD)};
        pg8::gemm_phase<pg8::EpiOut, pg8::StaticOrder, true, true>(ring, g, S, E);
        if (BOTH(6) || rep_ + 1 < REPS(6)) GRID_BAR();
    }
    STAMP(6);
    if (IN(7)) for (int rep_ = 0; rep_ < REPS(7); ++rep_) { p7_rows(C); if (BOTH(7) || rep_ + 1 < REPS(7)) GRID_BAR(); }
    STAMP(7);
    if (IN(8)) for (int rep_ = 0; rep_ < REPS(8); ++rep_) { for (int it = blockIdx.x; it < NB * NEXP; it += C.G()) p8_topk(C, it >> 4, it & 15); conv_p8(C); if (BOTH(8) || rep_ + 1 < REPS(8)) GRID_BAR(); }
    STAMP(8);
    if (IN(9)) for (int rep_ = 0; rep_ < REPS(9); ++rep_) {   }
    STAMP(9);
    if (IN(10)) for (int rep_ = 0; rep_ < REPS(10); ++rep_) {
        pg8::Gemm g{(const pg8::bf16_t*)(args.ws + WS_U), (const pg8::bf16_t*)(args.ws + WS_WGU), NEXP * NB * CAP, 2 * FF, DM, 2, (size_t)2048 * 2048 * 2, (const int*)(args.ws + WS_IDX)};
        pg8::StaticOrder S; S.init(NEXP * NB * CAP, 2 * FF, C.G(), (int)blockIdx.x);
        pg8::EpiGU E{(pg8::bf16_t*)(args.ws + WS_HID)};
        pg8::gemm_phase<pg8::EpiGU, pg8::StaticOrder, true, true, true>(ring, g, S, E);
        if (BOTH(10) || rep_ + 1 < REPS(10)) GRID_BAR();
    }
    STAMP(10);
    if (IN(11)) for (int rep_ = 0; rep_ < REPS(11); ++rep_) {
        pg8::Gemm g{(const pg8::bf16_t*)(args.ws + WS_HID), (const pg8::bf16_t*)(args.ws + WS_WDN), NEXP * NB * CAP, DM, FF, 2, (size_t)2048 * 1024 * 2, nullptr};
        pg8::StaticOrder S; S.init(NEXP * NB * CAP, DM, C.G(), (int)blockIdx.x);
        pg8::EpiDown E{(pg8::bf16_t*)(args.ws + WS_YE), (const float*)(args.ws + WS_GATE)};
        pg8::gemm_phase<pg8::EpiDown, pg8::StaticOrder, true, true>(ring, g, S, E);
        if (BOTH(11) || rep_ + 1 < REPS(11)) GRID_BAR();
    }
    STAMP(11);
    if (IN(12)) for (int rep_ = 0; rep_ < REPS(12); ++rep_) { p12_final(C); }
#ifdef PROBE_STAMP
    if (blockIdx.x == 0 && threadIdx.x == 0) { const unsigned long long t_end_ = __builtin_amdgcn_s_memrealtime(), wait_ = t_mark_ - t_start_;
        while (__builtin_amdgcn_s_memrealtime() - t_end_ < wait_) __builtin_amdgcn_s_sleep(8); }
#endif
#undef IN
#undef BOTH
#undef GRID_BAR
}

extern "C" void kernel_launch(void* const* d_in, const int* in_sizes, int n_in, void* d_out, int out_size, void* d_ws, size_t ws_size, hipStream_t stream) {
    static int grid = 0;
    if (grid == 0) {
        if (n_in != 19 || in_sizes[0] != MLAT * DM || out_size != MLAT * DM || ws_size < WS_END) { fprintf(stderr, "kernel_launch: built for 19 inputs, x/out of %d floats, >= %zu bytes of workspace; got n_in %d in0 %d out %d ws %zu; nothing launched\n", MLAT * DM, (size_t)WS_END, n_in, n_in > 0 ? in_sizes[0] : -1, out_size, ws_size); grid = -1; return; }
        int dev = 0, cus = 0, per_cu = 0;
        if (hipGetDevice(&dev) != hipSuccess || hipDeviceGetAttribute(&cus, hipDeviceAttributeMultiprocessorCount, dev) != hipSuccess) { fprintf(stderr, "kernel_launch: hipGetDevice / hipDeviceGetAttribute failed\n"); grid = -1; return; }
        if (hipFuncSetAttribute((const void*)fwd_megakernel, hipFuncAttributeMaxDynamicSharedMemorySize, LDS_BYTES) != hipSuccess) { fprintf(stderr, "kernel_launch: hipFuncSetAttribute(%d B LDS) failed\n", LDS_BYTES); grid = -1; return; }
        if (hipOccupancyMaxActiveBlocksPerMultiprocessor(&per_cu, (const void*)fwd_megakernel, NWAVES * 64, LDS_BYTES) != hipSuccess || per_cu < 1) { fprintf(stderr, "kernel_launch: occupancy query reports %d workgroups per CU\n", per_cu); per_cu = 1; }
        (void)hipGetLastError();
        grid = cus;
    }
    if (grid < 0) return;
    if (hipMemsetAsync((char*)d_ws + WS_CTL, 0, CTL_ZERO_BYTES, stream) != hipSuccess) { fprintf(stderr, "kernel_launch: hipMemsetAsync failed\n"); return; }
    Args a{};
    for (int i = 0; i < 19; ++i) a.in[i] = (const float*)d_in[i];
    a.out = (float*)d_out; a.ws = (unsigned char*)d_ws;
    if (N_LAUNCHES == 1) {
        a.ph_lo = 0; a.ph_hi = PER_PHASE; a.li = 0;
        void* kargs[] = {&a};
        hipError_t e = hipLaunchCooperativeKernel((const void*)fwd_megakernel, dim3(grid), dim3(NWAVES * 64), kargs, LDS_BYTES, stream);
        if (e != hipSuccess) { fprintf(stderr, "kernel_launch: cooperative launch failed: %s (grid %d)\n", hipGetErrorString(e), grid); (void)hipGetLastError(); }
    } else {
        for (int li = 0; li < PER_PHASE; ++li) { a.ph_lo = li; a.ph_hi = li + 1; a.li = li;
            hipLaunchKernelGGL(fwd_megakernel, dim3(grid), dim3(NWAVES * 64), LDS_BYTES, stream, a);
            const hipError_t le = hipPeekAtLastError(); if (le != hipSuccess) { fprintf(stderr, "kernel_launch: launch %d failed: %s\n", li, hipGetErrorName(le)); break; } }
    }
}
```

```cpp
#include <hip/hip_runtime.h>
#include <hip/hip_bf16.h>
#include <cstdio>
#include <cstdint>
#include <cmath>
#define MK_N_LAUNCHES 1
namespace pg8 {
#define PG8_LAS __attribute__((address_space(3)))
typedef unsigned short bf16_t;
typedef short bf16x8 __attribute__((ext_vector_type(8)));
typedef float f32x4 __attribute__((ext_vector_type(4)));
typedef unsigned u32x4 __attribute__((ext_vector_type(4)));
constexpr int BM = 256, BK = 64, HALF = 128, HTB = HALF * BK * 2  , STAGE_BYTES = 8 * HTB, NXCD = 8, WGM = 8;

__host__ __device__ __forceinline__ int lds_byte(int r, int c) { const int st = (r >> 4) * 2 + (c >> 5), rr = r & 15, cc = c & 31, ob = rr * 64 + cc * 2; return st * 1024 + (ob ^ (((ob >> 9) & 1) << 5)); }
__host__ __device__ __forceinline__ void stage_rc(int b, int& R, int& C) { const int st = b / 1024, sb = b % 1024, swz = sb ^ (((sb >> 9) & 1) << 5); R = (st >> 1) * 16 + swz / 64; C = (st & 1) * 32 + (swz % 64) / 2; }
__host__ __device__ __forceinline__ int perm32(int rho) { const int n = rho >> 4, i = rho & 15; return 8 * (i >> 2) + 4 * n + (i & 3); }

struct Unit { int pm, pn; };
struct Gemm { const bf16_t* A; const bf16_t* Bt; int M, N, K; int gshift; size_t gstride; const int* gidx;
    __device__ __forceinline__ size_t bofs(int pm, int pn) const { return (size_t)(pm >> gshift) * gstride + (size_t)pn * (size_t)(256 * 2) * (size_t)K; } };

struct StaticOrder {
    int nM, nN, nwg, G, c;
    __host__ __device__ void init(int M, int N, int G_, int c_) { nM = M / BM; nN = N / BM; nwg = nM * nN; G = G_; c = c_; }
    __host__ __device__ bool next(int i, Unit& u) const {
        const long L = (long)i * G + c; if (L >= nwg) return false;
        int wgid = (int)L; { const int q = nwg / NXCD, r = nwg % NXCD, xcd = wgid % NXCD, off = wgid / NXCD; wgid = (xcd < r ? xcd * (q + 1) : r * (q + 1) + (xcd - r) * q) + off; }
        const int nig = WGM * nN, gid = wgid / nig, fm = gid * WGM, gsz = (nM - fm) < WGM ? (nM - fm) : WGM;
        u.pm = fm + ((wgid % nig) % gsz); u.pn = (wgid % nig) / gsz; return true;
    }
    __device__ __forceinline__ void a_ready(const Unit&) const {}
    __device__ __forceinline__ void done(const Unit&) const {}
};


typedef float f32x2c __attribute__((ext_vector_type(2))); typedef __bf16 bf16x2c __attribute__((ext_vector_type(2)));
__device__ __forceinline__ unsigned cvt_pk_bf16(float lo, float hi) { const f32x2c v = {lo, hi}; const bf16x2c b = __builtin_convertvector(v, bf16x2c); return __builtin_bit_cast(unsigned, b); }
__device__ __forceinline__ float silu_f(float x) { return x * __builtin_amdgcn_rcpf(1.0f + __expf(-x)); }
__device__ __forceinline__ f32x4 silu4(f32x4 v) { return (f32x4){silu_f(v[0]), silu_f(v[1]), silu_f(v[2]), silu_f(v[3])}; }
__device__ __forceinline__ u32x4 pack8(f32x4 v0, f32x4 v1) { u32x4 w; w.x = cvt_pk_bf16(v0[0], v0[1]); w.y = cvt_pk_bf16(v0[2], v0[3]); w.z = cvt_pk_bf16(v1[0], v1[1]); w.w = cvt_pk_bf16(v1[2], v1[3]); return w; }

struct EpiQKV {
    static constexpr int ID = 0;
    static constexpr bool PERM = true, AFTER_DRAIN = false;
    bf16_t* O; const float* rc; const float* rs;
    __device__ __forceinline__ void operator()(const f32x4 (&acc)[2][2][4][2], const Unit& u, int wr, int wc, int fr, int fq) const {
        const int colt = u.pn * BM, t = colt >> 10; const bool lat = u.pm < 32;
        const int col0 = colt + wc * 32 + 8 * fq;
        const bool rope = lat && (t == 2 || t == 5);
        const int i0 = (wc & 1) * 16 + 4 * fq;
#pragma unroll
        for (int ai = 0; ai < 2; ++ai) {
            f32x4 c4[4], s4[4];
#pragma unroll
            for (int m = 0; m < 4; ++m) { c4[m] = (f32x4){1.f, 1.f, 1.f, 1.f}; s4[m] = (f32x4){0.f, 0.f, 0.f, 0.f};
                if (rope) { const int tok = (u.pm * BM + ai * HALF + wr * 64 + m * 16 + fr) & 4095; const int pos = (wc >> 1) ? (tok & 63) : (tok >> 6); c4[m] = *(const f32x4*)(rc + pos * 32 + i0); s4[m] = *(const f32x4*)(rs + pos * 32 + i0); } }
#pragma unroll
            for (int m = 0; m < 4; ++m) {
                const int row = u.pm * BM + ai * HALF + wr * 64 + m * 16 + fr;
                bf16_t* rowp = O + ((size_t)(2 * u.pn) * 8704 + row) * 128 + wc * 32 + 8 * fq;
#pragma unroll
                for (int bj = 0; bj < 2; ++bj) {
                    f32x4 v0 = acc[ai][bj][m][0], v1 = acc[ai][bj][m][1];
                    if (rope) { const f32x4 a = v0 * c4[m] - v1 * s4[m], b = v1 * c4[m] + v0 * s4[m]; v0 = a; v1 = b; }
                    if (t == 2) { v0 = v0 * 0.08838834764831845f; v1 = v1 * 0.08838834764831845f; }
                    if (t == 6) { v0 = silu4(v0); v1 = silu4(v1); }
                    *(u32x4*)(rowp + (size_t)bj * 8704 * 128) = pack8(v0, v1);
                }
            }
        }
    }
};
struct EpiOut {
    static constexpr int ID = 1;
    static constexpr bool PERM = true, AFTER_DRAIN = false;
    const float* x; bf16_t* out; const float* mod;
    __device__ __forceinline__ void operator()(const f32x4 (&acc)[2][2][4][2], const Unit& u, int wr, int wc, int fr, int fq) const {
        const int b = u.pm >> 4; const float* g2 = mod + b * 12288 + 2 * 2048;
        const int col0 = u.pn * BM + wc * 32 + 8 * fq;
        f32x4 gv[2][2];
#pragma unroll
        for (int bj = 0; bj < 2; ++bj)
#pragma unroll
            for (int n = 0; n < 2; ++n) gv[bj][n] = *(const f32x4*)(g2 + col0 + bj * HALF + n * 4);
#pragma unroll
        for (int ai = 0; ai < 2; ++ai) {
            f32x4 xv[4][2][2];
#pragma unroll
            for (int m = 0; m < 4; ++m) { const size_t off = (size_t)(u.pm * BM + ai * HALF + wr * 64 + m * 16 + fr) * 2048 + col0;
#pragma unroll
                for (int bj = 0; bj < 2; ++bj)
#pragma unroll
                    for (int n = 0; n < 2; ++n) xv[m][bj][n] = __builtin_nontemporal_load((const f32x4*)(x + off + bj * HALF + n * 4)); }
#pragma unroll
            for (int m = 0; m < 4; ++m) { const size_t off = (size_t)(u.pm * BM + ai * HALF + wr * 64 + m * 16 + fr) * 2048 + col0;
#pragma unroll
                for (int bj = 0; bj < 2; ++bj) *(u32x4*)(out + off + bj * HALF) = pack8(xv[m][bj][0] + gv[bj][0] * acc[ai][bj][m][0], xv[m][bj][1] + gv[bj][1] * acc[ai][bj][m][1]); }
            __builtin_amdgcn_sched_barrier(0);
        }
    }
};
struct EpiGU {
    static constexpr int ID = 2;
    static constexpr bool PERM = true, AFTER_DRAIN = false;
    bf16_t* H;
    __device__ __forceinline__ void operator()(const f32x4 (&acc)[2][2][4][2], const Unit& u, int wr, int wc, int fr, int fq) const {
        const int col0 = u.pn * HALF + wc * 32 + 8 * fq;
#pragma unroll
        for (int ai = 0; ai < 2; ++ai)
#pragma unroll
            for (int m = 0; m < 4; ++m) {
                const int row = u.pm * BM + ai * HALF + wr * 64 + m * 16 + fr;
                const f32x4 h0 = silu4(acc[ai][0][m][0]) * acc[ai][1][m][0], h1 = silu4(acc[ai][0][m][1]) * acc[ai][1][m][1];
                *(u32x4*)(H + (size_t)row * 1024 + col0) = pack8(h0, h1);
            }
    }
};
struct EpiDown {
    static constexpr int ID = 3;
    static constexpr bool PERM = true, AFTER_DRAIN = false;
    bf16_t* Y; const float* gate;
    __device__ __forceinline__ void operator()(const f32x4 (&acc)[2][2][4][2], const Unit& u, int wr, int wc, int fr, int fq) const {
        const int col0 = u.pn * BM + wc * 32 + 8 * fq;
        float gt[2][4];
#pragma unroll
        for (int ai = 0; ai < 2; ++ai)
#pragma unroll
            for (int m = 0; m < 4; ++m) gt[ai][m] = gate[u.pm * BM + ai * HALF + wr * 64 + m * 16 + fr];
#pragma unroll
        for (int ai = 0; ai < 2; ++ai)
#pragma unroll
            for (int m = 0; m < 4; ++m) {
                const int row = u.pm * BM + ai * HALF + wr * 64 + m * 16 + fr;
#pragma unroll
                for (int bj = 0; bj < 2; ++bj) *(u32x4*)(Y + (size_t)row * 2048 + col0 + bj * HALF) = pack8(acc[ai][bj][m][0] * gt[ai][m], acc[ai][bj][m][1] * gt[ai][m]);
            }
    }
};
struct QkvOrder {
    StaticOrder so; int G, c;
    __host__ __device__ void init(int G_, int c_) { so.init(8192, 7168, G_, c_); G = G_; c = c_; }
    __host__ __device__ bool next(int i, Unit& u) const {
        const long L = (long)i * G + c;
        if (L < so.nwg) { const bool ok = so.next(i, u);
            if (u.pn == 12 || u.pn == 13) u.pn += 12; else if (u.pn == 24 || u.pn == 25) u.pn -= 12;
            return ok; }
        const int l = (int)(L - so.nwg); if (l >= 32) return false;
        u.pm = 32 + (l & 1); u.pn = l >> 1; return true;
    }
    __device__ __forceinline__ void a_ready(const Unit&) const {}
    __device__ __forceinline__ void done(const Unit&) const {}
};
template <class Epi, class Sched, bool ALIGN_EPI = false, bool SP2 = false, bool GATHER = false>
__device__ __forceinline__ void gemm_phase(PG8_LAS unsigned char* lds, const Gemm g, const Sched& S, const Epi& E) {
    int tid_ = threadIdx.x; asm volatile("" : "+v"(tid_));
    const int tid = tid_, wid = __builtin_amdgcn_readfirstlane(tid >> 6), lane = tid & 63, wr = wid >> 2, wc = wid & 3, fr = lane & 15, fq = lane >> 4;
    const int K = g.K, nt = K / BK;
    unsigned voffA[2], voffB[2];
#pragma unroll
    for (int i = 0; i < 2; ++i) { int R, C; stage_rc(tid * 16 + i * 8192, R, C); const int Rb = Epi::PERM ? ((R & ~31) + perm32(R & 31)) : R;
        voffA[i] = (unsigned)(R * K + C) * 2u; voffB[i] = (unsigned)(Rb * K + C) * 2u; }
    int Rr[2], Cc[2];
#pragma unroll
    for (int i = 0; i < 2; ++i) stage_rc(tid * 16 + i * 8192, Rr[i], Cc[i]);
    unsigned gcur[2][2], gnxt[2][2];
#pragma unroll
    for (int h = 0; h < 2; ++h)
#pragma unroll
        for (int i = 0; i < 2; ++i) { gcur[h][i] = voffA[i]; gnxt[h][i] = voffA[i]; }
#define PG8_GOFF(dst, pm_) do { _Pragma("unroll") for (int h_ = 0; h_ < 2; ++h_) _Pragma("unroll") for (int i_ = 0; i_ < 2; ++i_) { const int vr_ = (pm_) * BM + h_ * HALF + Rr[i_]; \
        const int ar_ = ((vr_ >> 9) & 1) * 4096 + g.gidx[vr_]; dst[h_][i_] = (unsigned)(ar_ * K + Cc[i_]) * 2u; } } while (0)
    const size_t kstep = (size_t)(BK * 2);
    const size_t hstep = (size_t)HALF * K * 2;
    const size_t tstep = 2 * hstep;
    const size_t hstepA = GATHER ? 0 : hstep, tstepA = GATHER ? 0 : tstep;
    const unsigned ldsw = (unsigned)wid * 1024u;
    const int aoff = lds_byte(wr * 64 + fr, fq * 8), boff = lds_byte(wc * 32 + fr, fq * 8);
#define PG8_SA(b, h) (((b) * 2 + (h)) * HTB)
#define PG8_SB(b, h) ((4 + (b) * 2 + (h)) * HTB)
#define PG8_STAGE(bufoff, gbase, voff) do { _Pragma("unroll") for (int _i = 0; _i < 2; ++_i) \
        __builtin_amdgcn_global_load_lds((const unsigned*)((const char*)(gbase) + (voff)[_i]), (PG8_LAS unsigned*)(lds + (bufoff) + ldsw + _i * 8192), 16, 0, 0); } while (0)
#define PG8_LDA(dst, b, h) do { _Pragma("unroll") for (int m = 0; m < 4; ++m) _Pragma("unroll") for (int k = 0; k < 2; ++k) dst[m][k] = *(const PG8_LAS bf16x8*)(lds + PG8_SA(b, h) + aoff + m * 2048 + k * 1024); } while (0)
#define PG8_LDB(dst, b, h) do { _Pragma("unroll") for (int n = 0; n < 2; ++n) _Pragma("unroll") for (int k = 0; k < 2; ++k) dst[n][k] = *(const PG8_LAS bf16x8*)(lds + PG8_SB(b, h) + boff + n * 2048 + k * 1024); } while (0)
#define PG8_MMA(ai, bj, At, Bt) do { __builtin_amdgcn_s_setprio(1); _Pragma("unroll") for (int m = 0; m < 4; ++m) _Pragma("unroll") for (int n = 0; n < 2; ++n) _Pragma("unroll") for (int k = 0; k < 2; ++k) \
        acc[ai][bj][m][n] = __builtin_amdgcn_mfma_f32_16x16x32_bf16(Bt[n][k], At[m][k], acc[ai][bj][m][n], 0, 0, 0); __builtin_amdgcn_s_setprio(0); } while (0)
#define PG8_WAIT_V(n) asm volatile("s_waitcnt vmcnt(" #n ")" ::: "memory")
#define PG8_WAIT_L(n) asm volatile("s_waitcnt lgkmcnt(" #n ")" ::: "memory")
#define PG8_BAR __builtin_amdgcn_s_barrier()
#define PG8_SCHED __builtin_amdgcn_sched_barrier(0)
    Unit cur, nxt; int ui = 0;
    if (!S.next(0, cur)) return;
    f32x4 acc[2][2][4][2];
#pragma unroll
    for (int a = 0; a < 2; ++a)
#pragma unroll
        for (int b = 0; b < 2; ++b)
#pragma unroll
            for (int m = 0; m < 4; ++m)
#pragma unroll
                for (int n = 0; n < 2; ++n) acc[a][b][m][n] = (f32x4){0.f, 0.f, 0.f, 0.f};
    bf16x8 At[4][2], B0[2][2], B1[2][2];
    if constexpr (GATHER) { PG8_GOFF(gcur, cur.pm); }
    const char* cA = (const char*)g.A + (size_t)cur.pm * tstepA; const char* cB = (const char*)g.Bt + g.bofs(cur.pm, cur.pn);
    S.a_ready(cur);
    if constexpr (SP2) {
        PG8_STAGE(PG8_SB(0, 0), cB, voffB); PG8_STAGE(PG8_SB(0, 1), cB + hstep, voffB); PG8_STAGE(PG8_SA(0, 0), cA, gcur[0]); PG8_STAGE(PG8_SA(0, 1), cA + hstepA, gcur[1]);
        if (wr == 1) PG8_BAR;
        PG8_WAIT_V(2); PG8_BAR;
        PG8_STAGE(PG8_SB(1, 0), cB + kstep, voffB); PG8_STAGE(PG8_SA(1, 0), cA + kstep, gcur[0]); PG8_STAGE(PG8_SB(1, 1), cB + hstep + kstep, voffB);
        PG8_WAIT_V(6); PG8_BAR;
    } else {
        PG8_STAGE(PG8_SB(0, 0), cB, voffB); PG8_STAGE(PG8_SA(0, 0), cA, gcur[0]); PG8_STAGE(PG8_SB(0, 1), cB + hstep, voffB); PG8_STAGE(PG8_SA(0, 1), cA + hstepA, gcur[1]);
        if (wr == 1) PG8_BAR;
        PG8_WAIT_V(4); PG8_BAR;
        PG8_STAGE(PG8_SB(1, 0), cB + kstep, voffB); PG8_STAGE(PG8_SA(1, 0), cA + kstep, gcur[0]); PG8_STAGE(PG8_SB(1, 1), cB + hstep + kstep, voffB);
        PG8_WAIT_V(6); PG8_BAR;
    }
    for (;;) {
        const bool has_next = S.next(ui + 1, nxt);
        if constexpr (GATHER) { if (has_next) { PG8_GOFF(gnxt, nxt.pm); } else { _Pragma("unroll") for (int h = 0; h < 2; ++h) _Pragma("unroll") for (int i = 0; i < 2; ++i) gnxt[h][i] = gcur[h][i]; } }
        const char* nA = has_next ? (const char*)g.A + (size_t)nxt.pm * tstepA : cA; const char* nB = has_next ? (const char*)g.Bt + g.bofs(nxt.pm, nxt.pn) : cB;
        for (int t = 0; t < nt; t += 2) {
            const bool last = (t == nt - 2);
            const char* a1 = cA + (size_t)(t + 1) * kstep;
            const char* a2 = last ? nA : cA + (size_t)(t + 2) * kstep; const char* b2 = last ? nB : cB + (size_t)(t + 2) * kstep;
            const char* a3 = a2 + kstep; const char* b3 = b2 + kstep;
            unsigned g2[2][2];
#pragma unroll
            for (int h = 0; h < 2; ++h)
#pragma unroll
                for (int i = 0; i < 2; ++i) g2[h][i] = (GATHER && last) ? gnxt[h][i] : gcur[h][i];
            if (last && has_next) S.a_ready(nxt);
            if constexpr (SP2) {
            PG8_LDB(B0, 0, 0); PG8_LDB(B1, 0, 1); PG8_SCHED; PG8_LDA(At, 0, 0); PG8_STAGE(PG8_SA(1, 1), a1 + hstepA, gcur[1]);
            PG8_WAIT_V(8); PG8_WAIT_L(0); PG8_BAR; PG8_MMA(0, 0, At, B0); PG8_MMA(0, 1, At, B1); PG8_BAR; PG8_SCHED;
            PG8_LDA(At, 0, 1); PG8_STAGE(PG8_SB(0, 0), b2, voffB); PG8_STAGE(PG8_SB(0, 1), b2 + hstep, voffB); PG8_STAGE(PG8_SA(0, 0), a2, g2[0]);
            PG8_WAIT_V(8); PG8_WAIT_L(0); PG8_BAR; PG8_MMA(1, 0, At, B0); PG8_MMA(1, 1, At, B1); PG8_BAR; PG8_SCHED;
            PG8_LDB(B0, 1, 0); PG8_LDB(B1, 1, 1); PG8_SCHED; PG8_LDA(At, 1, 0); PG8_STAGE(PG8_SA(0, 1), a2 + hstepA, g2[1]);
            PG8_WAIT_V(8); PG8_WAIT_L(0); PG8_BAR; PG8_MMA(0, 0, At, B0); PG8_MMA(0, 1, At, B1); PG8_BAR; PG8_SCHED;
            PG8_LDA(At, 1, 1); PG8_STAGE(PG8_SB(1, 0), b3, voffB); PG8_STAGE(PG8_SB(1, 1), b3 + hstep, voffB); PG8_STAGE(PG8_SA(1, 0), a3, g2[0]);
            PG8_WAIT_V(8); PG8_WAIT_L(0); PG8_BAR; PG8_MMA(1, 0, At, B0); PG8_MMA(1, 1, At, B1); PG8_BAR; PG8_SCHED;
            } else {
            PG8_LDB(B0, 0, 0); PG8_SCHED; PG8_LDA(At, 0, 0); PG8_STAGE(PG8_SA(1, 1), a1 + hstepA, gcur[1]);
            PG8_WAIT_L(8); PG8_BAR; PG8_WAIT_L(0); PG8_MMA(0, 0, At, B0); PG8_BAR; PG8_SCHED;
            PG8_LDB(B1, 0, 1); PG8_STAGE(PG8_SB(0, 0), b2, voffB);
            PG8_BAR; PG8_WAIT_L(0); PG8_MMA(0, 1, At, B1); PG8_BAR;
            PG8_LDA(At, 0, 1); PG8_STAGE(PG8_SA(0, 0), a2, g2[0]);
            PG8_BAR; PG8_WAIT_L(0); PG8_MMA(1, 0, At, B0); PG8_BAR; PG8_SCHED;
            PG8_STAGE(PG8_SB(0, 1), b2 + hstep, voffB);
            PG8_WAIT_V(6); PG8_BAR; PG8_MMA(1, 1, At, B1); PG8_BAR;
            PG8_LDB(B0, 1, 0); PG8_SCHED; PG8_LDA(At, 1, 0); PG8_STAGE(PG8_SA(0, 1), a2 + hstepA, g2[1]);
            PG8_WAIT_L(8); PG8_BAR; PG8_WAIT_L(0); PG8_MMA(0, 0, At, B0); PG8_BAR; PG8_SCHED;
            PG8_LDB(B1, 1, 1); PG8_STAGE(PG8_SB(1, 0), b3, voffB);
            PG8_BAR; PG8_WAIT_L(0); PG8_MMA(0, 1, At, B1); PG8_BAR;
            PG8_LDA(At, 1, 1); PG8_STAGE(PG8_SA(1, 0), a3, g2[0]);
            PG8_BAR; PG8_WAIT_L(0); PG8_MMA(1, 0, At, B0); PG8_BAR; PG8_SCHED;
            PG8_STAGE(PG8_SB(1, 1), b3 + hstep, voffB);
            PG8_WAIT_V(6); PG8_BAR; PG8_MMA(1, 1, At, B1); PG8_BAR;
            }
        }
        if constexpr (ALIGN_EPI) { if (wr == 0) PG8_BAR; }
#ifdef PROBE_EPI2
        if constexpr (((PROBE_EPI2) >> Epi::ID) & 1) { E(acc, cur, wr, wc, fr, fq); __builtin_amdgcn_sched_barrier(0); }
#endif
        if constexpr (!Epi::AFTER_DRAIN) { E(acc, cur, wr, wc, fr, fq); S.done(cur); }
        if (!has_next) break;
#pragma unroll
        for (int a = 0; a < 2; ++a)
#pragma unroll
            for (int b = 0; b < 2; ++b)
#pragma unroll
                for (int m = 0; m < 4; ++m)
#pragma unroll
                    for (int n = 0; n < 2; ++n) acc[a][b][m][n] = (f32x4){0.f, 0.f, 0.f, 0.f};
        cur = nxt; cA = nA; cB = nB; ++ui;
#pragma unroll
        for (int h = 0; h < 2; ++h)
#pragma unroll
            for (int i = 0; i < 2; ++i) gcur[h][i] = gnxt[h][i];
        if constexpr (ALIGN_EPI) { if (wr == 1) PG8_BAR; }
    }
    PG8_WAIT_V(0);
    if constexpr (!ALIGN_EPI) { if (wr == 0) PG8_BAR; }
    PG8_BAR;
    if constexpr (Epi::AFTER_DRAIN) { E.fused(acc, cur, wr, wc, fr, fq, lds, wid, lane); S.done(cur); }
#undef PG8_SA
#undef PG8_SB
#undef PG8_STAGE
#undef PG8_LDA
#undef PG8_LDB
#undef PG8_MMA
#undef PG8_WAIT_V
#undef PG8_WAIT_L
#undef PG8_BAR
#undef PG8_SCHED
#undef PG8_GOFF
}
}

constexpr int NWAVES = 8;
#ifndef MK_N_LAUNCHES
#define MK_N_LAUNCHES 1
#endif
constexpr int PER_PHASE = 13;
constexpr int N_LAUNCHES = MK_N_LAUNCHES;

constexpr int DM = 2048, NB = 2, SEQ = 4096, CTXL = 256, NEXP = 16, FF = 1024, CAP = 512;
constexpr int MLAT = NB * SEQ, MALL = MLAT + NB * CTXL, NIN = 7168, NMOD = 6 * DM;
constexpr float EPS = 1e-6f;
constexpr int MOD_KC = 8;

constexpr size_t MiB = 1u << 20, KiB = 1u << 10;
constexpr size_t WS_CTL = 0, CTL_ZERO_BYTES = 64 * KiB;
constexpr size_t WS_MODP = 1 * MiB;
constexpr size_t WS_MOD = 2 * MiB + 512 * KiB;
constexpr size_t WS_ROPE = 2 * MiB + 768 * KiB;
constexpr size_t WS_AFF = 3 * MiB;
constexpr size_t WS_SLOT = 3 * MiB + 512 * KiB;
constexpr size_t WS_IDX = 4 * MiB, WS_GATE = 4 * MiB + 64 * KiB;
constexpr size_t WS_WIN = 8 * MiB, WS_WOUT = 36 * MiB, WS_WGU = 44 * MiB, WS_WDN = 172 * MiB;
constexpr size_t WS_U = 236 * MiB;
constexpr size_t WS_QKV = 270 * MiB;
constexpr size_t WS_XE = 270 * MiB, WS_HID = 334 * MiB;
constexpr size_t WS_MIX = 389 * MiB;
constexpr size_t WS_KV = 421 * MiB;
constexpr size_t WS_YE = 421 * MiB;
constexpr size_t WS_ST = 489 * MiB;
constexpr size_t WS_HLAT = 521 * MiB;
constexpr size_t WS_END = 585 * MiB;
constexpr int CW_BAR = 1024;

constexpr int RING_BYTES = 131072;
constexpr int LDSCTL_OFF = 143360, MISC_OFF = LDSCTL_OFF + 320;
constexpr int LDS_BYTES = 147456;

#define GAS __attribute__((address_space(1)))
#define LAS __attribute__((address_space(3)))
typedef unsigned short bf16;
typedef unsigned v4u __attribute__((ext_vector_type(4)));
typedef unsigned v2u __attribute__((ext_vector_type(2)));
typedef float f32x4 __attribute__((ext_vector_type(4)));
typedef float f32x2 __attribute__((ext_vector_type(2)));
typedef float f32x16 __attribute__((ext_vector_type(16)));
typedef short bf16x8 __attribute__((ext_vector_type(8)));
typedef short s16x4 __attribute__((ext_vector_type(4)));
#define RLX_AGENT __ATOMIC_RELAXED, __HIP_MEMORY_SCOPE_AGENT
#define LDS_WAIT() asm volatile("s_waitcnt lgkmcnt(0)" ::: "memory")
#define VM_WAIT() asm volatile("s_waitcnt vmcnt(0)" ::: "memory")
#define SBAR() __builtin_amdgcn_sched_barrier(0)
typedef __bf16 bf16x2_t __attribute__((ext_vector_type(2)));
__device__ __forceinline__ unsigned cvtpk(float lo, float hi) { const f32x2 v = {lo, hi}; const bf16x2_t b = __builtin_convertvector(v, bf16x2_t); return __builtin_bit_cast(unsigned, b); }
__device__ __forceinline__ float bf2f(unsigned short b) { return __builtin_bit_cast(float, (unsigned)b << 16); }
__device__ __forceinline__ float silu_f(float x) { return x / (1.0f + __expf(-x)); }
__device__ __forceinline__ float log_sigmoid_f(float x) { return -log1pf(expf(-x)); }
#define DPP_ADD(v, ctrl) ((v) + __builtin_bit_cast(float, __builtin_amdgcn_update_dpp(0, __builtin_bit_cast(int, (v)), (ctrl), 0xf, 0xf, true)))
__device__ __forceinline__ float wave_sum(float v) {
    v = DPP_ADD(v, 0xB1); v = DPP_ADD(v, 0x4E); v = DPP_ADD(v, 0x141); v = DPP_ADD(v, 0x140);
    { auto r = __builtin_amdgcn_permlane16_swap(__float_as_uint(v), __float_as_uint(v), false, false); v = __uint_as_float(r[0]) + __uint_as_float(r[1]); }
    { auto r = __builtin_amdgcn_permlane32_swap(__float_as_uint(v), __float_as_uint(v), false, false); v = __uint_as_float(r[0]) + __uint_as_float(r[1]); }
    return v;
}
__device__ __forceinline__ int opq(int v) { asm volatile("" : "+v"(v)); return v; }
__device__ __forceinline__ size_t qkv_base(int t, int h) { return (size_t)((t * 8 + h) * MALL) * 128; }
__device__ __forceinline__ int crow(int r, int hi) { return (r & 3) + 8 * (r >> 2) + 4 * hi; }

#define XB_TMO      128
#define XB_XCNT(j)  (256  + 64 * (j))
#define XB_XSUB(j)  (1280 + 64 * (j))
#define XB_XGEN(j)  (2304 + 64 * (j))
#define XB_TOP      3328
#define XB_TOPGEN   3392
#define XCD_BAR_WORDS 3456
#define XB_SPIN_CAP (1u << 18)

__device__ __forceinline__ unsigned xb_ld(unsigned* p)              { return __hip_atomic_load(p, __ATOMIC_RELAXED, __HIP_MEMORY_SCOPE_AGENT); }
__device__ __forceinline__ unsigned xb_add(unsigned* p, unsigned v) { return __hip_atomic_fetch_add(p, v, __ATOMIC_RELAXED, __HIP_MEMORY_SCOPE_AGENT); }
__device__ __forceinline__ unsigned xb_xcc_id() { return (unsigned)__builtin_amdgcn_s_getreg((3 << 11) | 20) & 0xFu; }
#define XB_SPIN(cond, bar) do { unsigned _sp = 0; while (cond) { __builtin_amdgcn_s_sleep(1); \
    if ((++_sp & 255u) == 0u) { if (xb_ld(&(bar)[XB_TMO])) break; if (_sp > XB_SPIN_CAP) { atomicAdd(&(bar)[XB_TMO], 1u); break; } } } } while (0)

struct XcdBarrier {
    unsigned* bar; unsigned x;
    volatile LAS unsigned* st;
};

__device__ __forceinline__ XcdBarrier xcd_barrier_post(unsigned* bar, volatile LAS unsigned* st) {
    XcdBarrier b; b.bar = bar; b.x = xb_xcc_id(); b.st = st;
    if (threadIdx.x == 0) (void)xb_add(&bar[XB_XCNT(b.x)], 1u);
    return b;
}
__device__ __forceinline__ void xcd_barrier_complete(unsigned* bar, unsigned x, unsigned& nloc, unsigned& nx) {
    const unsigned G = gridDim.x * gridDim.y * gridDim.z;
    unsigned sum, cnt, mine, sp = 0u;
    for (;;) {
        sum = 0u; cnt = 0u; mine = 0u;
#pragma unroll
        for (unsigned j = 0; j < 16; ++j) { const unsigned c = xb_ld(&bar[XB_XCNT(j)]); sum += c; cnt += (c > 0u) ? 1u : 0u; mine = (j == x) ? c : mine; }
        if (sum == G) break;
        __builtin_amdgcn_s_sleep(1);
        if ((++sp & 255u) == 0u) { if (xb_ld(&bar[XB_TMO])) break; if (sp > XB_SPIN_CAP) { atomicAdd(&bar[XB_TMO], 1u); break; } }
    }
    nloc = mine > 0u ? mine : 1u; nx = cnt > 0u ? cnt : 1u;
}

__device__ __forceinline__ void xcd_barrier(const XcdBarrier& b) {
    asm volatile("s_waitcnt vmcnt(0)" ::: "memory");
    __syncthreads();
    if (threadIdx.x == 0) {
        unsigned* bar = b.bar;
        __builtin_amdgcn_s_waitcnt(0);
        unsigned nloc = b.st[0], nx = b.st[1];
        if (nloc == 0u) { xcd_barrier_complete(bar, b.x, nloc, nx); b.st[0] = nloc; b.st[1] = nx; }
        const unsigned old = xb_add(&bar[XB_XSUB(b.x)], 1u);
        const unsigned gen = old / nloc;
        if (old + 1u == (gen + 1u) * nloc) {
            __builtin_amdgcn_fence(__ATOMIC_RELEASE, "agent");
            asm volatile("s_waitcnt vmcnt(0)" ::: "memory");
            const unsigned og = xb_add(&bar[XB_TOP], 1u);
            const unsigned tg = og / nx;
            if (og + 1u == (tg + 1u) * nx) xb_add(&bar[XB_TOPGEN], 1u);
            else XB_SPIN(xb_ld(&bar[XB_TOPGEN]) == tg, bar);
            __builtin_amdgcn_fence(__ATOMIC_ACQUIRE, "agent");
            xb_add(&bar[XB_XGEN(b.x)], 1u);
            asm volatile("s_waitcnt vmcnt(0)" ::: "memory");
        } else {
            XB_SPIN(xb_ld(&bar[XB_XGEN(b.x)]) == gen, bar);
            __builtin_amdgcn_fence(__ATOMIC_ACQUIRE, "agent");
            asm volatile("s_waitcnt vmcnt(0)" ::: "memory");
        }
    }
    __syncthreads();
}

struct Args { const float* in[19]; float* out; unsigned char* ws; int ph_lo, ph_hi, li, pad; };
struct Ctx {
    const Args* a; unsigned char* lds;
    int wave;
    __device__ __forceinline__ int G() const { return (int)gridDim.x; }
    __device__ __forceinline__ int vcu() const { const int g = (int)gridDim.x, bx = (int)blockIdx.x; return (g % 8 == 0) ? (bx % 8) * (g / 8) + bx / 8 : bx; }
    __device__ __forceinline__ int gw() const { return vcu() * 8 + wave; }
    __device__ __forceinline__ int NGW() const { return (int)gridDim.x * 8; }
    __device__ __forceinline__ const float* x() const { return a->in[0]; } __device__ __forceinline__ const float* c() const { return a->in[1]; } __device__ __forceinline__ const float* ctxt() const { return a->in[2]; } __device__ __forceinline__ const float* c_ctx() const { return a->in[3]; } __device__ __forceinline__ const float* w_mod() const { return a->in[4]; } __device__ __forceinline__ const float* b_mod() const { return a->in[5]; } __device__ __forceinline__ const float* nmix() const { return a->in[6]; } __device__ __forceinline__ const float* nffn() const { return a->in[7]; } __device__ __forceinline__ const float* w_in() const { return a->in[8]; } __device__ __forceinline__ const float* rpb() const { return a->in[9]; } __device__ __forceinline__ const float* dec_f() const { return a->in[10]; } __device__ __forceinline__ const float* dec_b() const { return a->in[11]; } __device__ __forceinline__ const float* gn_w() const { return a->in[12]; } __device__ __forceinline__ const float* w_out() const { return a->in[13]; } __device__ __forceinline__ const float* w_router() const { return a->in[14]; } __device__ __forceinline__ const float* w_gate() const { return a->in[15]; } __device__ __forceinline__ const float* w_up() const { return a->in[16]; } __device__ __forceinline__ const float* w_down() const { return a->in[17]; } __device__ __forceinline__ const float* fin_w() const { return a->in[18]; }
    __device__ __forceinline__ float* out() const { return a->out; } __device__ __forceinline__ unsigned char* ws() const { return a->ws; }
};

__device__ __forceinline__ void sec_mark(const Ctx& C, int k) {
#ifdef PROBE_SEC
    if (k == PROBE_SEC || k == PROBE_SEC + 1) { if (threadIdx.x == 0) { volatile LAS unsigned* w = (volatile LAS unsigned*)((LAS unsigned char*)C.lds + MISC_OFF + 128); const unsigned t = (unsigned)__builtin_amdgcn_s_memrealtime();
        if (k == PROBE_SEC) w[0] = t; else w[1] += t - w[0]; } }
#endif
}
__device__ __forceinline__ void p0_modpart(const Ctx& C, int u0, int ustep) {
    const int TID_ = opq((int)threadIdx.x), LANE_ = TID_ & 63;
    float* sv = (float*)(C.lds + C.wave * 16384);
    float* modp = (float*)(C.ws() + WS_MODP);
    for (int unit = u0; unit < 96 * MOD_KC; unit += ustep) {
        const int nc = unit % 96, kc = unit / 96, n0 = nc * 128 + LANE_ * 2;
        f32x2 a0 = {0.f, 0.f}, a1 = {0.f, 0.f}, a2 = {0.f, 0.f};
        for (int sub = 0; sub < 2048 / MOD_KC / 256; ++sub) {
            const int k0 = kc * (2048 / MOD_KC) + sub * 256;
#pragma unroll
            for (int i = 0; i < 4; ++i) { const int kk = LANE_ + 64 * i, k = k0 + kk;
                sv[kk] = silu_f(C.c()[k]); sv[256 + kk] = silu_f(C.c()[2048 + k]); sv[512 + kk] = silu_f(C.c_ctx()[k]); }
            LDS_WAIT();
            const float* wp = C.w_mod() + (size_t)k0 * NMOD + n0;
            for (int kb = 0; kb < 256; kb += 32) {
                f32x2 w[32];
#pragma unroll
                for (int i = 0; i < 32; ++i) w[i] = __builtin_nontemporal_load((const f32x2*)(wp + (size_t)(kb + i) * NMOD));
#pragma unroll
                for (int i = 0; i < 32; ++i) { const float s0 = sv[kb + i], s1 = sv[256 + kb + i], s2 = sv[512 + kb + i]; a0 += w[i] * s0; a1 += w[i] * s1; a2 += w[i] * s2; }
            }
            LDS_WAIT();
        }
        *(f32x2*)(modp + (size_t)(kc * 3 + 0) * NMOD + n0) = a0; *(f32x2*)(modp + (size_t)(kc * 3 + 1) * NMOD + n0) = a1; *(f32x2*)(modp + (size_t)(kc * 3 + 2) * NMOD + n0) = a2;
    }
}
template <int MODE> __device__ __forceinline__ int orow_map(int n) {
    if (MODE == 1) { const int t = n >> 10; if (t == 2 || t == 5) { const int d = n & 127, a = d >> 6, nn = (d >> 5) & 1, i = d & 31; return (n & ~127) + 32 * (2 * a + (i >> 4)) + 8 * ((i >> 2) & 3) + 4 * nn + (i & 3); } return n; }
    if (MODE == 2) return (n >> 7) * 256 + (n & 127);
    if (MODE == 3) return (n >> 7) * 256 + 128 + (n & 127);
    return n;
}
__device__ __forceinline__ int orow_rt(int mode, int n) { return mode == 1 ? orow_map<1>(n) : mode == 2 ? orow_map<2>(n) : mode == 3 ? orow_map<3>(n) : n; }
constexpr int CONV_I_IN = 32 * 224, CONV_I_OUT = 32 * 64, CONV_I_GU = 16 * 1024, CONV_NITEMS = CONV_I_IN + CONV_I_OUT + 3 * CONV_I_GU, CONV_DEFER = 10752;
constexpr int CONV_P0_END = CONV_I_IN + 3072, CONV_P8_BEGIN = CONV_NITEMS - CONV_DEFER - 5120;
struct ConvDesc { const float* src; bf16* dst; int N, K, mode, n0; bool nts; };
__device__ __forceinline__ ConvDesc conv_desc(const Ctx& C, int it) {
    const float* W; bf16* WT; int K, N, mode, item; int r = it;
    if (r < CONV_I_IN) { W = C.w_in(); K = 2048; N = NIN; WT = (bf16*)(C.ws() + WS_WIN); mode = 1; item = r; }
    else if ((r -= CONV_I_IN) < CONV_I_OUT) { W = C.w_out(); K = 2048; N = 2048; WT = (bf16*)(C.ws() + WS_WOUT); mode = 0; item = r; }
    else if ((r -= CONV_I_OUT) < CONV_I_GU) { const int e = r >> 10; W = C.w_gate() + (size_t)e * 2048 * 1024; K = 2048; N = 1024; WT = (bf16*)(C.ws() + WS_WGU) + (size_t)e * 2048 * 2048; mode = 2; item = r & 1023; }
    else if ((r -= CONV_I_GU) < CONV_I_GU) { const int e = r >> 10; W = C.w_up() + (size_t)e * 2048 * 1024; K = 2048; N = 1024; WT = (bf16*)(C.ws() + WS_WGU) + (size_t)e * 2048 * 2048; mode = 3; item = r & 1023; }
    else { r -= CONV_I_GU; const int e = r >> 10; W = C.w_down() + (size_t)e * 1024 * 2048; K = 1024; N = 2048; WT = (bf16*)(C.ws() + WS_WDN) + (size_t)e * 2048 * 1024; mode = 0; item = r & 1023; }
    const int nblk = N / 32, kb = item / nblk, nb = item % nblk, k0 = 64 * kb, n0 = 32 * nb;
    ConvDesc d; d.src = W + (size_t)k0 * N + n0; d.dst = WT + k0; d.N = N; d.K = K; d.mode = mode; d.n0 = n0; d.nts = it < CONV_NITEMS - CONV_DEFER; return d;
}
template <bool NT> __device__ __forceinline__ void conv_load(const ConvDesc& d, float (&tv)[32], int lane) {
#pragma unroll
    for (int i = 0; i < 8; ++i) { const f32x4* p_ = (const f32x4*)(d.src + (size_t)(8 * i + (lane >> 3)) * d.N + 4 * (lane & 7)); const f32x4 t = NT ? __builtin_nontemporal_load(p_) : *p_; tv[4 * i] = t.x; tv[4 * i + 1] = t.y; tv[4 * i + 2] = t.z; tv[4 * i + 3] = t.w; }
}
__device__ __forceinline__ void conv_store(const ConvDesc& d, const float (&tv)[32], float* scr, int lane) {
#pragma unroll
    for (int i = 0; i < 8; ++i) *(f32x4*)((char*)scr + (8 * i + (lane >> 3)) * 128 + (((lane & 7) ^ i) * 16)) = (f32x4){tv[4 * i], tv[4 * i + 1], tv[4 * i + 2], tv[4 * i + 3]};
    LDS_WAIT();
    const int c = lane & 7;
#pragma unroll
    for (int j = 0; j < 4; ++j) { const int n = (lane >> 3) + 8 * j; const char* s = (const char*)scr + (8 * c) * 128 + (((n >> 2) ^ c) * 16) + (n & 3) * 4;
        v4u o; o.x = cvtpk(*(const float*)(s + 0 * 128), *(const float*)(s + 1 * 128)); o.y = cvtpk(*(const float*)(s + 2 * 128), *(const float*)(s + 3 * 128));
        o.z = cvtpk(*(const float*)(s + 4 * 128), *(const float*)(s + 5 * 128)); o.w = cvtpk(*(const float*)(s + 6 * 128), *(const float*)(s + 7 * 128));
        v4u* op_ = (v4u*)(d.dst + (size_t)orow_rt(d.mode, d.n0 + n) * d.K + 8 * c); if (d.nts) __builtin_nontemporal_store(o, op_); else *op_ = o; }
    LDS_WAIT();
}
template <bool NT> __device__ __forceinline__ void conv_run(const Ctx& C, int first, int last, int step, float* scr, int lane) {
    if (first >= last) return;
    ConvDesc d0 = conv_desc(C, first); float t0[32]; conv_load<NT>(d0, t0, lane);
    const int i1 = (first + step < last) ? first + step : first;
    ConvDesc d1 = conv_desc(C, i1); float t1[32]; conv_load<NT>(d1, t1, lane);
    for (int it = first; it < last; it += step) {
        const int nx = (it + 2 * step < last) ? it + 2 * step : it;
        const ConvDesc d2 = conv_desc(C, nx); float t2[32]; conv_load<NT>(d2, t2, lane);
        conv_store(d0, t0, scr, lane);
        d0 = d1; d1 = d2;
#pragma unroll
        for (int i = 0; i < 32; ++i) { t0[i] = t1[i]; t1[i] = t2[i]; }
    }
}
template <bool NT> __device__ __forceinline__ void conv_run_rot(const Ctx& C, int base, int last, int ncb, int cb, int rot, float* scr, int lane) {
    const int per = ncb * NWAVES; int n = (last - base + per - 1) / per;
#define CONV_RIDX(j) (base + (j) * per + ((cb + (j) * rot) % ncb) * NWAVES + C.wave)
    if (n > 0 && CONV_RIDX(n - 1) >= last) --n;
    if (n <= 0) return;
    ConvDesc d0 = conv_desc(C, CONV_RIDX(0)); float t0[32]; conv_load<NT>(d0, t0, lane);
    ConvDesc d1 = conv_desc(C, CONV_RIDX(n > 1 ? 1 : 0)); float t1[32]; conv_load<NT>(d1, t1, lane);
    for (int j = 0; j < n; ++j) {
        const int jn = (j + 2 < n) ? j + 2 : j;
        const ConvDesc d2 = conv_desc(C, CONV_RIDX(jn)); float t2[32]; conv_load<NT>(d2, t2, lane);
        conv_store(d0, t0, scr, lane);
        d0 = d1; d1 = d2;
#pragma unroll
        for (int i = 0; i < 32; ++i) { t0[i] = t1[i]; t1[i] = t2[i]; }
    }
#undef CONV_RIDX
}
__device__ __forceinline__ bool conv_split(const Ctx& C) { return (C.G() & 15) == 0; }
__device__ __forceinline__ void conv_p3(const Ctx& C, int cblk, int ncblk) {
    const int LANE_ = opq((int)threadIdx.x) & 63;
    conv_run_rot<true>(C, CONV_P0_END, CONV_P8_BEGIN, ncblk, cblk, 37, (float*)(C.lds + C.wave * 16384), LANE_);
}
__device__ __forceinline__ void conv_p8(const Ctx& C) {
    const int LANE_ = opq((int)threadIdx.x) & 63; const int bx = (int)blockIdx.x, G = C.G();
    const int first_blk = G > NB * NEXP ? NB * NEXP : 0; if (bx < first_blk) return;
    conv_run<true>(C, CONV_P8_BEGIN + (bx - first_blk) * NWAVES + C.wave, CONV_NITEMS - CONV_DEFER, (G - first_blk) * NWAVES, (float*)(C.lds + C.wave * 16384), LANE_);
}
__device__ __forceinline__ void conv_deferred(const Ctx& C, int nunits) {
    const int LANE_ = opq((int)threadIdx.x) & 63;
    const int G = C.G(), rounds = (nunits + G - 1) / G; int cfirst = nunits - (rounds - 1) * G; if (cfirst >= G) cfirst = 0;
    const int bx = (int)blockIdx.x; if (bx < cfirst) return;
    const int nw = (G - cfirst) * NWAVES, lw = (bx - cfirst) * NWAVES + C.wave;
    const bool pairs = ((G - cfirst) & 1) == 0 && (cfirst & 1) == 0 && CONV_DEFER % nw == 0 && CONV_DEFER / nw >= 2; const int odd = bx & 1;
    conv_run<false>(C, CONV_NITEMS - CONV_DEFER + lw, CONV_NITEMS - ((pairs && odd) ? nw : 0), nw, (float*)(C.lds + C.wave * 16384), LANE_);
    if (pairs && !odd) { const int gift = CONV_NITEMS - nw + lw + NWAVES; conv_run<false>(C, gift, gift + 1, 1, (float*)(C.lds + C.wave * 16384), LANE_); }
}
__device__ __forceinline__ void p0_prologue(const Ctx& C) {
    const int TID_ = opq((int)threadIdx.x), LANE_ = TID_ & 63;
    const int gw = C.gw(), r8 = gw & 7, g8 = gw >> 3, n8 = C.NGW() >> 3;
    const bool host = r8 < 3;
#ifndef PROBE_P0G
#define PROBE_P0G 1
#endif
#ifndef PROBE_P0C
#define PROBE_P0C 1
#endif
    if (host) { for (int pr_ = 0; pr_ < PROBE_P0G; ++pr_) p0_modpart(C, g8 * 3 + r8, n8 * 3); }
    const int tw = g8 * 5 + (r8 - 3), ntw = n8 * 5;
    float* scr = (float*)(C.lds + C.wave * 16384);
    if (!host) { for (int pr_ = 0; pr_ < PROBE_P0C; ++pr_) conv_run<true>(C, tw, conv_split(C) ? CONV_P0_END : CONV_P8_BEGIN, ntw, scr, LANE_); }
    if (blockIdx.x == 0) { float* rc = (float*)(C.ws() + WS_ROPE); float* rs = rc + 2048;
        for (int i = TID_; i < 2048; i += NWAVES * 64) { const int pos = i >> 5, f = i & 31; const float inv = powf(10000.0f, -(float)(2 * f) / 64.0f); const float ang = (float)pos * inv; rc[i] = cosf(ang); rs[i] = sinf(ang); } }
}

__device__ __forceinline__ void p1_rows(const Ctx& C) {
    const int TID_ = opq((int)threadIdx.x), LANE_ = TID_ & 63;
    float* tab = (float*)C.lds;
    const int m0 = C.gw(); f32x4 v[8];
    { const int mq = m0 < MALL ? m0 : 0; const float* src0 = mq < MLAT ? C.x() + (size_t)mq * DM : C.ctxt() + (size_t)(mq - MLAT) * DM;
#pragma unroll
      for (int j = 0; j < 8; ++j) v[j] = __builtin_nontemporal_load((const f32x4*)src0 + LANE_ + 64 * j); }
    const float* modp = (const float*)(C.ws() + WS_MODP);
#pragma unroll
    for (int hh = 0; hh < 2; ++hh) { f32x4 tv[3];
#pragma unroll
      for (int i = 0; i < 3; ++i) { const int q = TID_ + 512 * (3 * hh + i), r = q >> 10, n4 = (q & 1023) * 4; tv[i] = *(const f32x4*)(C.b_mod() + n4);
#pragma unroll
          for (int kc = 0; kc < MOD_KC; ++kc) tv[i] += *(const f32x4*)(modp + (size_t)(kc * 3 + r) * NMOD + n4); }
#pragma unroll
      for (int i = 0; i < 3; ++i) { const int q = TID_ + 512 * (3 * hh + i); *(f32x4*)(tab + q * 4) = tv[i]; } }
    { const int g = blockIdx.x * (NWAVES * 64) + TID_; float* mod = (float*)(C.ws() + WS_MOD);
      for (int q = g; q < 3 * NMOD; q += C.G() * NWAVES * 64) { const int r = q / NMOD, n = q % NMOD; float v = C.b_mod()[n];
#pragma unroll
          for (int kc = 0; kc < MOD_KC; ++kc) v += modp[(size_t)(kc * 3 + r) * NMOD + n];
          mod[q] = v; } }
    __syncthreads();
    bf16* U = (bf16*)(C.ws() + WS_U);
    f32x4 nwv[8];
#pragma unroll
    for (int j = 0; j < 8; ++j) nwv[j] = *(const f32x4*)(C.nmix() + (LANE_ + 64 * j) * 4);
    for (int m = m0; m < MALL; m += C.NGW()) {
        const int r = m < MLAT ? (m >> 12) : 2; const int mn = m + C.NGW();
        f32x4 vn[8];
        { const int mq = mn < MALL ? mn : m; const float* srcn = mq < MLAT ? C.x() + (size_t)mq * DM : C.ctxt() + (size_t)(mq - MLAT) * DM;
#pragma unroll
          for (int j = 0; j < 8; ++j) vn[j] = __builtin_nontemporal_load((const f32x4*)srcn + LANE_ + 64 * j); }
        float s = 0.f;
#pragma unroll
        for (int j = 0; j < 8; ++j) s += (v[j].x * v[j].x + v[j].y * v[j].y) + (v[j].z * v[j].z + v[j].w * v[j].w);
        const float rstd = 1.0f / sqrtf(wave_sum(s) * (1.0f / DM) + EPS);
#pragma unroll
        for (int j = 0; j < 8; ++j) { const int col = (LANE_ + 64 * j) * 4; const f32x4 nw = nwv[j], sh = *(const f32x4*)(tab + r * 4096 + col), sc = *(const f32x4*)(tab + r * 4096 + 2048 + col);
            const f32x4 u = (v[j] * rstd * nw) * (sc + 1.0f) + sh; v2u o; o.x = cvtpk(u.x, u.y); o.y = cvtpk(u.z, u.w); *(v2u*)(U + (size_t)m * DM + col) = o; }
#pragma unroll
        for (int j = 0; j < 8; ++j) v[j] = vn[j];
    }
    __syncthreads();
}

namespace na {
constexpr float SCALE = 0.088388347648318440f, THR = 8.f;
constexpr int LD = 128, KVBLK = 64, NT = 16;
constexpr int SHM_V = 16384, SHM_K = 16384, OFF_WS = 65536, OFF_TAB = 65536 + 2048;
#define KSWZ(row, colB) ((row) * 256 + ((colB) ^ (((row) & 7) << 4)))
__device__ __forceinline__ bf16x8 ld8(const bf16* p) { return *reinterpret_cast<const bf16x8*>(p); }
__device__ __forceinline__ void partialSM(f32x16& p0, f32x16& p1, float& m_reg, float& mn, float& alpha) {
  constexpr float C = SCALE * 1.4426950408889634f;
  float pmax = p0[0];
#pragma unroll
  for (int r = 1; r < 16; ++r) pmax = fmaxf(pmax, p0[r]);
#pragma unroll
  for (int r = 0; r < 16; ++r) pmax = fmaxf(pmax, p1[r]);
  { auto rr = __builtin_amdgcn_permlane32_swap(__float_as_uint(pmax), __float_as_uint(pmax), false, false);
    pmax = fmaxf(__uint_as_float(rr[0]), __uint_as_float(rr[1])); }
  if (__builtin_expect(__all(pmax - m_reg <= THR / SCALE), 1)) { mn = m_reg; alpha = 1.f; }
  else { mn = fmaxf(m_reg, pmax); alpha = __builtin_amdgcn_exp2f((m_reg - mn) * C); m_reg = mn; }
  float mnC = -mn * C;
#pragma unroll
  for (int r = 0; r < 16; ++r) p0[r] = fmaf(p0[r], C, mnC);
#pragma unroll
  for (int r = 0; r < 16; ++r) p1[r] = fmaf(p1[r], C, mnC);
#pragma unroll
  for (int r = 0; r < 16; ++r) p0[r] = __builtin_amdgcn_exp2f(p0[r]);
}
#define NA_PK4(P, BASE, OUT) do { unsigned a0 = cvtpk(P[BASE + 0], P[BASE + 1]), a1 = cvtpk(P[BASE + 2], P[BASE + 3]);   \
    unsigned b0 = cvtpk(P[BASE + 4], P[BASE + 5]), b1 = cvtpk(P[BASE + 6], P[BASE + 7]);                              \
    auto r0 = __builtin_amdgcn_permlane32_swap(a0, b0, false, false); auto r1 = __builtin_amdgcn_permlane32_swap(a1, b1, false, false); \
    v4u w = {r0[0], r1[0], r0[1], r1[1]}; OUT = *reinterpret_cast<bf16x8*>(&w); } while (0)
__device__ __forceinline__ void finishSM(f32x16& p0, f32x16& p1, float alpha, float& l_reg, bf16x8& pa0, bf16x8& pa1, bf16x8& pa2, bf16x8& pa3) {
#pragma unroll
  for (int r = 0; r < 16; ++r) p1[r] = __builtin_amdgcn_exp2f(p1[r]);
  float ps = 0;
#pragma unroll
  for (int r = 0; r < 16; ++r) ps += p0[r];
#pragma unroll
  for (int r = 0; r < 16; ++r) ps += p1[r];
  { auto rr = __builtin_amdgcn_permlane32_swap(__float_as_uint(ps), __float_as_uint(ps), false, false);
    ps = __uint_as_float(rr[0]) + __uint_as_float(rr[1]); }
  l_reg = l_reg * alpha + ps;
  NA_PK4(p0, 0, pa0); NA_PK4(p0, 8, pa1); NA_PK4(p1, 0, pa2); NA_PK4(p1, 8, pa3);
}
__device__ __forceinline__ void qkt(f32x16& p0, f32x16& p1, const bf16* Ks, const bf16x8* qr, int r32, int hi) {
  p0 = f32x16{}; p1 = f32x16{};
#pragma unroll
  for (int d0 = 0; d0 < 8; ++d0) { int cb = (d0 * 16 + hi * 8) * 2;
    bf16x8 b0 = *reinterpret_cast<const bf16x8*>((const char*)Ks + KSWZ(r32, cb));
    bf16x8 b1 = *reinterpret_cast<const bf16x8*>((const char*)Ks + KSWZ(32 + r32, cb));
    p0 = __builtin_amdgcn_mfma_f32_32x32x16_bf16(b0, qr[d0], p0, 0, 0, 0);
    p1 = __builtin_amdgcn_mfma_f32_32x32x16_bf16(b1, qr[d0], p1, 0, 0, 0); }
}
__device__ __forceinline__ int v_st(int k, int c) { const int kk = (k & ~0xC) | ((k & 4) << 1) | ((k & 8) >> 1); return ((kk >> 3) * 4 + (c >> 5)) * 512 + ((kk & 7) * 32 + (c & 31)) * 2; }
__device__ __forceinline__ int v_rd_base(int lane) { return ((lane & 3) << 3) | (((lane >> 2) & 3) << 6) | (((lane >> 4) & 1) << 5) | (((lane >> 5) & 1) << 8); }
constexpr int v_rd_off(int d0, int ks, int half) { return d0 * 512 + ks * 4096 + half * 2048; }
template <int OFF> __device__ __forceinline__ s16x4 tr_read(int vb) {
  s16x4 r; asm volatile("ds_read_b64_tr_b16 %0, %1 offset:%2" : "=&v"(r) : "v"(vb), "i"(OFF) : "memory"); return r;
}
template <int D0> __device__ __forceinline__ void pv_one(f32x16& od, int vb, bf16x8 pa0, bf16x8 pa1, bf16x8 pa2, bf16x8 pa3) {
  const s16x4 l0 = tr_read<v_rd_off(D0, 0, 0)>(vb), h0 = tr_read<v_rd_off(D0, 0, 1)>(vb), l1 = tr_read<v_rd_off(D0, 1, 0)>(vb), h1 = tr_read<v_rd_off(D0, 1, 1)>(vb);
  const s16x4 l2 = tr_read<v_rd_off(D0, 2, 0)>(vb), h2 = tr_read<v_rd_off(D0, 2, 1)>(vb), l3 = tr_read<v_rd_off(D0, 3, 0)>(vb), h3 = tr_read<v_rd_off(D0, 3, 1)>(vb);
  asm volatile("s_waitcnt lgkmcnt(0)" ::: "memory"); SBAR();
#define NA_PK(L, H) (bf16x8){L[0], L[1], L[2], L[3], H[0], H[1], H[2], H[3]}
  od = __builtin_amdgcn_mfma_f32_32x32x16_bf16(pa0, NA_PK(l0, h0), od, 0, 0, 0);
  od = __builtin_amdgcn_mfma_f32_32x32x16_bf16(pa1, NA_PK(l1, h1), od, 0, 0, 0);
  od = __builtin_amdgcn_mfma_f32_32x32x16_bf16(pa2, NA_PK(l2, h2), od, 0, 0, 0);
  od = __builtin_amdgcn_mfma_f32_32x32x16_bf16(pa3, NA_PK(l3, h3), od, 0, 0, 0);
}
__device__ __forceinline__ void pv_d0(f32x16* o, int vb, bf16x8 pa0, bf16x8 pa1, bf16x8 pa2, bf16x8 pa3) {
  pv_one<0>(o[0], vb, pa0, pa1, pa2, pa3); pv_one<1>(o[1], vb, pa0, pa1, pa2, pa3); pv_one<2>(o[2], vb, pa0, pa1, pa2, pa3); pv_one<3>(o[3], vb, pa0, pa1, pa2, pa3);
}
__device__ __forceinline__ void na_bias(f32x16& p0, f32x16& p1, int j, int kr_lo, int r, int rs, const float* trow, float pen_a, float pen_b, float pen_c) {
  if (j < 4) return;
  const int kr = kr_lo + j - 4; const bool inwin = (kr >= rs) && (kr < rs + 8); const float NEG = -1e30f;
  if (inwin) {
    const float* brow = trow + (kr - r + 7) * 128;
#pragma unroll
    for (int e = 0; e < 16; ++e) { const int k0 = (e & 3) + 8 * (e >> 2); p0[e] = (p0[e] + brow[k0]) + (e < 8 ? pen_a : pen_b); }
    SBAR();
#pragma unroll
    for (int e = 0; e < 16; ++e) { const int k0 = (e & 3) + 8 * (e >> 2); p1[e] = (p1[e] + brow[k0 + 32]) + (e < 8 ? pen_b : pen_c); }
  } else {
#pragma unroll
    for (int e = 0; e < 16; ++e) { p0[e] = NEG; p1[e] = NEG; }
  }
}
__device__ __forceinline__ void na_unit(const bf16* __restrict__ QKV, bf16* __restrict__ MIX, const float* __restrict__ rpb, int b, int h, int rg, char* lds) {
  const int tid = opq((int)threadIdx.x), wid = __builtin_amdgcn_readfirstlane(tid >> 6), lane = tid & 63, r32 = lane & 31, hi = lane >> 5;
  bf16* V_lds = (bf16*)lds; bf16* K_lds = (bf16*)(lds + 2 * SHM_V);
  float* ws = (float*)(lds + OFF_WS) + wid * 64; float* li_l = ws; float* al_l = ws + 32;
  float* tab = (float*)(lds + OFF_TAB);
  for (int i = tid; i < 2 * 15 * 128; i += 512) { const int t = i / 1920, q = i - t * 1920, ro = q >> 7, xx = (q & 127) - 48;
    const bool inr = t == 0 ? (xx >= 7 && xx <= 22) : (xx >= 0 && xx <= 30);
    tab[i] = inr ? rpb[h * 465 + ro * 31 + xx] * (1.f / SCALE) : (t == 0 ? -1e30f : 0.f); }
  const int r = 4 * rg + (wid >> 1), cq = 32 * (wid & 1) + r32;
  const int rs = min(max(r - 4, 0), 56), kr_lo = min(max(4 * rg - 4, 0), 52);
  const bool edgeL = cq < 8, edgeR = cq > 56; const float penL = edgeL ? -1e30f : 0.f, penR = edgeR ? -1e30f : 0.f;
  const float pen_a = penR, pen_b = penL + penR, pen_c = penL;
  const float* trow = tab + ((edgeL || edgeR) ? 1920 : 0) + 63 - cq + 4 * hi;
  const long rowc = MLAT + b * CTXL, rowl = (long)b * SEQ + kr_lo * 64;
#define NA_TROW(j) ((j) < 4 ? rowc + 64 * (j) : rowl + 64 * ((j) - 4))
  const bf16* Kh = QKV + qkv_base(0, h); const bf16* Vh = QKV + qkv_base(1, h);
  float m_reg = -1e30f, l_reg = 0; f32x16 o[4] = {}; bf16x8 qr[8];
  const bf16* Qw = QKV + qkv_base(4, h) + (long)(b * SEQ + rg * 256 + wid * 32 + r32) * LD + hi * 8;
#pragma unroll
  for (int d0 = 0; d0 < 8; ++d0) qr[d0] = ld8(Qw + d0 * 16);
  const int sr = tid >> 4, sc = (tid & 15) * 8, vst0 = v_st(sr, sc), vst1 = v_st(32 + sr, sc);
  const int vb0 = (int)(uintptr_t)V_lds + v_rd_base(lane);
  struct { bf16x8 vs0, vs1, ks0, ks1; } sr_[2];
#define NA_SLOAD(i, j) do { const long t0_ = NA_TROW(j); sr_[i].vs0 = ld8(&Vh[(t0_ + sr) * LD + sc]); sr_[i].vs1 = ld8(&Vh[(t0_ + 32 + sr) * LD + sc]); \
    sr_[i].ks0 = ld8(&Kh[(t0_ + sr) * LD + sc]); sr_[i].ks1 = ld8(&Kh[(t0_ + 32 + sr) * LD + sc]); } while (0)
#define NA_SWRITE(bb, i) do { *(bf16x8*)((char*)V_lds + (bb) * SHM_V + vst0) = sr_[i].vs0;          \
    *(bf16x8*)((char*)V_lds + (bb) * SHM_V + vst1) = sr_[i].vs1; int kc = sc * 2;               \
    *(bf16x8*)((char*)K_lds + (bb) * SHM_K + KSWZ(sr, kc)) = sr_[i].ks0;                       \
    *(bf16x8*)((char*)K_lds + (bb) * SHM_K + KSWZ(32 + sr, kc)) = sr_[i].ks1; } while (0)
#define NA_SWAIT() asm volatile("s_waitcnt vmcnt(4)" ::: "memory")
#define NA_RESC(a) do { if (__any((a) < 1.f)) { if (hi == 0) al_l[r32] = (a); asm volatile("s_waitcnt lgkmcnt(0)" ::: "memory"); \
    _Pragma("unroll") for (int d = 0; d < 4; ++d) _Pragma("unroll") for (int rr_ = 0; rr_ < 16; ++rr_) o[d][rr_] *= al_l[crow(rr_, hi)]; } } while (0)
#define NA_BIAS(P0, P1, j) do { SBAR(); na_bias(P0, P1, (j), kr_lo, r, rs, trow, pen_a, pen_b, pen_c); SBAR(); } while (0)
  f32x16 pA0, pA1, pB0, pB1; float mnA, mnB, alA, alB; bf16x8 pa0, pa1, pa2, pa3;
  constexpr int SE = 0, SO = 1;
  NA_SLOAD(SE, 0); asm volatile("s_waitcnt vmcnt(0)" ::: "memory"); NA_SWRITE(0, SE); __syncthreads();
  qkt(pA0, pA1, K_lds, qr, r32, hi); partialSM(pA0, pA1, m_reg, mnA, alA);
  NA_SLOAD(SO, 1); NA_SLOAD(SE, 2);
  NA_SWAIT(); NA_SWRITE(1, SO); __syncthreads();
  for (int j = 1; j + 1 < NT; j += 2) {
    SBAR(); qkt(pB0, pB1, (bf16*)((char*)K_lds + SHM_K), qr, r32, hi);
    finishSM(pA0, pA1, alA, l_reg, pa0, pa1, pa2, pa3); SBAR();
    NA_SLOAD(SO, j + 2); SBAR();
    pv_d0(o, vb0, pa0, pa1, pa2, pa3); NA_BIAS(pB0, pB1, j); partialSM(pB0, pB1, m_reg, mnB, alB);
    __syncthreads(); NA_SWAIT(); NA_SWRITE(0, SE);
    NA_RESC(alB); __syncthreads();
    SBAR(); qkt(pA0, pA1, K_lds, qr, r32, hi);
    finishSM(pB0, pB1, alB, l_reg, pa0, pa1, pa2, pa3); SBAR();
    if (j + 3 < NT) NA_SLOAD(SE, j + 3); SBAR();
    pv_d0(o, vb0 + SHM_V, pa0, pa1, pa2, pa3); NA_BIAS(pA0, pA1, j + 1); partialSM(pA0, pA1, m_reg, mnA, alA);
    __syncthreads(); NA_SWAIT(); NA_SWRITE(1, SO);
    NA_RESC(alA); __syncthreads();
  }
  SBAR(); qkt(pB0, pB1, (bf16*)((char*)K_lds + SHM_K), qr, r32, hi);
  finishSM(pA0, pA1, alA, l_reg, pa0, pa1, pa2, pa3); SBAR();
  pv_d0(o, vb0, pa0, pa1, pa2, pa3); NA_BIAS(pB0, pB1, NT - 1); partialSM(pB0, pB1, m_reg, mnB, alB);
  __syncthreads(); NA_RESC(alB);
  finishSM(pB0, pB1, alB, l_reg, pa0, pa1, pa2, pa3); SBAR();
  pv_d0(o, vb0 + SHM_V, pa0, pa1, pa2, pa3);
  if (hi == 0) li_l[r32] = l_reg; asm volatile("s_waitcnt lgkmcnt(0)" ::: "memory");
  float rli[16];
#pragma unroll
  for (int rr_ = 0; rr_ < 16; ++rr_) rli[rr_] = __builtin_amdgcn_rcpf(li_l[crow(rr_, hi)]);
  bf16* Ow = MIX + (long)(b * SEQ + rg * 256 + wid * 32) * DM + h * 128;
#pragma unroll
  for (int rr_ = 0; rr_ < 16; ++rr_) { const int orow = crow(rr_, hi);
#pragma unroll
    for (int d0 = 0; d0 < 4; d0 += 1) { const unsigned pk = cvtpk(o[d0][rr_] * rli[rr_], 0.f); Ow[(long)orow * DM + d0 * 32 + r32] = (bf16)(pk & 0xffffu); } }
  __syncthreads();
#undef NA_SLOAD
#undef NA_SWRITE
#undef NA_SWAIT
#undef NA_RESC
#undef NA_BIAS
#undef NA_TROW
}
}

namespace ret {
typedef const LAS char* lds_cptr;
typedef short v4i16_t __attribute__((ext_vector_type(4)));
__device__ __forceinline__ s16x4 vtr(lds_cptr p) { return __builtin_bit_cast(s16x4, __builtin_amdgcn_ds_read_tr16_b64_v4i16((LAS v4i16_t*)p)); }
__device__ __forceinline__ bf16x8 tr_frag(lds_cptr base, int pitchB, int t0, int c0, int lane) {
    const int g = lane >> 4, q = (lane & 15) >> 2, p = lane & 3;
    lds_cptr a = base + (t0 + 8 * (g >> 1) + q) * pitchB + (c0 + 16 * (g & 1) + 4 * p) * 2;
    const s16x4 lo = vtr(a), hi4 = vtr(a + 4 * pitchB);
    return (bf16x8){lo[0], lo[1], lo[2], lo[3], hi4[0], hi4[1], hi4[2], hi4[3]};
}
__device__ __forceinline__ bf16x8 scale_frag8(bf16x8 a, f32x4 w0, f32x4 w1) {
    const v4u x = __builtin_bit_cast(v4u, a); v4u o;
    o.x = cvtpk(__builtin_bit_cast(float, x.x << 16) * w0.x, __builtin_bit_cast(float, x.x & 0xffff0000u) * w0.y);
    o.y = cvtpk(__builtin_bit_cast(float, x.y << 16) * w0.z, __builtin_bit_cast(float, x.y & 0xffff0000u) * w0.w);
    o.z = cvtpk(__builtin_bit_cast(float, x.z << 16) * w1.x, __builtin_bit_cast(float, x.z & 0xffff0000u) * w1.y);
    o.w = cvtpk(__builtin_bit_cast(float, x.w << 16) * w1.z, __builtin_bit_cast(float, x.w & 0xffff0000u) * w1.w);
    return __builtin_bit_cast(bf16x8, o);
}
__device__ __forceinline__ bf16x8 scale_frag1(bf16x8 a, float w) { const f32x4 w4 = {w, w, w, w}; return scale_frag8(a, w4, w4); }

constexpr int KV_PITCH = 320;
constexpr int KV_OFF_K = 0, KV_OFF_V = 128 * KV_PITCH, KV_OFF_W = 2 * 128 * KV_PITCH;
__device__ __forceinline__ void kv_load(const Ctx& C, int b, int h, int c, int tid, v4u (&kx)[4], v4u (&vx)[4]) {
    const bf16* QKV = (const bf16*)(C.ws() + WS_QKV);
    const long rowbase = c < 2 ? (long)MLAT + b * CTXL + c * 128 : (long)b * SEQ + (c - 2) * 128;
#pragma unroll
    for (int i = 0; i < 4; ++i) { const int piece = tid + 512 * i, row = piece >> 4, cc = piece & 15;
        const size_t src = (size_t)(rowbase + row) * 128 + cc * 8;
        kx[i] = *(const v4u*)(QKV + qkv_base(2, h) + src); vx[i] = *(const v4u*)(QKV + qkv_base(3, h) + src); }
}
__device__ __forceinline__ void kv_item(const Ctx& C, int b, int h, int c, v4u (&kx)[4], v4u (&vx)[4], bool has_next, int nb, int nh, int nc) {
    const int TID_ = opq((int)threadIdx.x), LANE_ = TID_ & 63;
    bf16* KVB = (bf16*)(C.ws() + WS_KV);
    char* lds = (char*)C.lds; const int tid = TID_, lane = LANE_, wid = C.wave, r32 = lane & 31, hi = lane >> 5;
    float* wt = (float*)(lds + KV_OFF_W);
    if (tid < 256) { const int d = tid >> 7, t = tid & 127; const float lg = log_sigmoid_f(d ? C.dec_b()[h] : C.dec_f()[h]); wt[tid] = expf(lg * (float)(d ? t : 127 - t)); }
#pragma unroll
    for (int i = 0; i < 4; ++i) { const int piece = tid + 512 * i, row = piece >> 4, cc = piece & 15;
        *(v4u*)(lds + KV_OFF_K + row * KV_PITCH + cc * 16) = kx[i]; *(v4u*)(lds + KV_OFF_V + row * KV_PITCH + cc * 16) = vx[i]; }
    __syncthreads();
    if (has_next) kv_load(C, nb, nh, nc, tid, kx, vx);
    const lds_cptr Kb = (lds_cptr)(lds + KV_OFF_K), Vb = (lds_cptr)(lds + KV_OFF_V);
    const int dvb = wid & 3, dk0 = 2 * (wid >> 2);
    f32x16 acc[2][2] = {};
#pragma unroll
    for (int ks = 0; ks < 8; ++ks) {
        const bf16x8 v = tr_frag(Vb, KV_PITCH, 16 * ks, 32 * dvb, lane);
        const f32x4 wf0 = *(const f32x4*)(wt + 16 * ks + 8 * hi), wf1 = *(const f32x4*)(wt + 16 * ks + 8 * hi + 4);
        const f32x4 wb0 = *(const f32x4*)(wt + 128 + 16 * ks + 8 * hi), wb1 = *(const f32x4*)(wt + 128 + 16 * ks + 8 * hi + 4);
        const bf16x8 vf = scale_frag8(v, wf0, wf1), vb = scale_frag8(v, wb0, wb1);
#pragma unroll
        for (int d = 0; d < 2; ++d) { const bf16x8 kf = tr_frag(Kb, KV_PITCH, 16 * ks, 32 * (dk0 + d), lane);
            acc[0][d] = __builtin_amdgcn_mfma_f32_32x32x16_bf16(kf, vf, acc[0][d], 0, 0, 0);
            acc[1][d] = __builtin_amdgcn_mfma_f32_32x32x16_bf16(kf, vb, acc[1][d], 0, 0, 0); }
    }
    constexpr int KV_OPITCH = 272, KV_ODIR = 128 * KV_OPITCH;
    __syncthreads();
#pragma unroll
    for (int dir = 0; dir < 2; ++dir)
#pragma unroll
        for (int d = 0; d < 2; ++d) { char* dl = lds + dir * KV_ODIR + (32 * dvb + r32) * KV_OPITCH + (32 * (dk0 + d) + 4 * hi) * 2;
#pragma unroll
            for (int g = 0; g < 4; ++g) { v2u o; o.x = cvtpk(acc[dir][d][4 * g], acc[dir][d][4 * g + 1]); o.y = cvtpk(acc[dir][d][4 * g + 2], acc[dir][d][4 * g + 3]); *(v2u*)(dl + 16 * g) = o; } }
    __syncthreads();
#pragma unroll
    for (int dir = 0; dir < 2; ++dir) { bf16* dst = KVB + ((size_t)(((b * 8 + h) * 2 + dir) * 34 + c)) * 16384;
        v4u ov[4];
#pragma unroll
        for (int i = 0; i < 4; ++i) { const int piece = tid + 512 * i, row = piece >> 4, ch = piece & 15; ov[i] = *(const v4u*)(lds + dir * KV_ODIR + row * KV_OPITCH + ch * 16); }
#pragma unroll
        for (int i = 0; i < 4; ++i) { const int piece = tid + 512 * i, rowp = ((piece >> 4) + 37 * c) & 127; *(v4u*)(dst + (size_t)(rowp * 16 + (piece & 15)) * 8) = ov[i]; } }
    __syncthreads();
}

__device__ __forceinline__ void scan_phase(const Ctx& C) {
    const int TID_ = opq((int)threadIdx.x), LANE_ = TID_ & 63;
    const bf16* KVB = (const bf16*)(C.ws() + WS_KV); bf16* ST = (bf16*)(C.ws() + WS_ST);
    for (int g = blockIdx.x * (NWAVES * 64) + TID_; g < 32 * 4096; g += C.G() * NWAVES * 64) {
        const int grp = g >> 12, e4 = g & 4095, h = (grp >> 1) & 7, dir = grp & 1;
        const float G = expf(128.0f * log_sigmoid_f(dir ? C.dec_b()[h] : C.dec_f()[h]));
#define RROT(c_) (((((e4 >> 5) + 37 * (c_)) & 127) << 5) | (e4 & 31))
        const v2u* kv = (const v2u*)(KVB + (size_t)grp * 34 * 16384) + e4;
        bf16* st = ST + (size_t)grp * 32 * 16384;
        v2u kvr[34];
#pragma unroll
        for (int c = 0; c < 34; ++c) kvr[c] = kv[(size_t)c * 4096 + RROT(c) - e4];
#define KV4(c_) ((f32x4){__builtin_bit_cast(float, kvr[c_].x << 16), __builtin_bit_cast(float, kvr[c_].x & 0xffff0000u), __builtin_bit_cast(float, kvr[c_].y << 16), __builtin_bit_cast(float, kvr[c_].y & 0xffff0000u)})
        f32x4 S;
        if (dir == 0) {
            S = KV4(0) * G + KV4(1); { v2u o; o.x = cvtpk(S.x, S.y); o.y = cvtpk(S.z, S.w); *(v2u*)(st + RROT(0) * 4) = o; }
#pragma unroll
            for (int n = 0; n < 31; ++n) { S = S * G + KV4(n + 2); v2u o; o.x = cvtpk(S.x, S.y); o.y = cvtpk(S.z, S.w); *(v2u*)(st + (size_t)(n + 1) * 16384 + RROT(n + 1) * 4) = o; }
        } else {
            S = KV4(0) + KV4(1) * G; { v2u o; o.x = cvtpk(S.x, S.y); o.y = cvtpk(S.z, S.w); *(v2u*)(st + (size_t)31 * 16384 + RROT(31) * 4) = o; }
#pragma unroll
            for (int n = 31; n >= 1; --n) { S = S * G + KV4(n + 2); v2u o; o.x = cvtpk(S.x, S.y); o.y = cvtpk(S.z, S.w); *(v2u*)(st + (size_t)(n - 1) * 16384 + RROT(n - 1) * 4) = o; }
        }
#undef KV4
#undef RROT
    }
}

constexpr int RO_OFF_K = 0, RO_OFF_V = 32768, RO_OFF_SF = 65536, RO_OFF_SB = 98304, RO_OFF_ST = 131072, RO_OFF_FT = 131072 + 2048;
#define RO_DMA(gp, off) __builtin_amdgcn_global_load_lds((const unsigned*)(gp), (LAS unsigned*)(ldsl + (off)), 16, 0, 0)
__device__ __forceinline__ void ro_issue_s(const Ctx& C, LAS unsigned char* ldsl, int b, int h, int n, int wid, int lane_) {
    int lane = lane_; asm volatile("" : "+v"(lane));
    const bf16* ST = (const bf16*)(C.ws() + WS_ST);
    const char* Sf = (const char*)(ST + ((size_t)(((b * 8 + h) * 2 + 0) * 32 + n)) * 16384); const char* Sb = (const char*)(ST + ((size_t)(((b * 8 + h) * 2 + 1) * 32 + n)) * 16384);
#pragma unroll
    for (int i = 0; i < 4; ++i) { const int blk = 4 * wid + i, row = 4 * blk + (lane >> 4), ch = (lane & 15) ^ (row & 7); const int so = ((row + 37 * n) & 127) * 256 + ch * 16;
        RO_DMA(Sf + so, RO_OFF_SF + blk * 1024); RO_DMA(Sb + so, RO_OFF_SB + blk * 1024); }
}
__device__ __forceinline__ void ro_issue_kv(const Ctx& C, LAS unsigned char* ldsl, int b, int h, int n, int wid, int lane_) {
    int lane = lane_; asm volatile("" : "+v"(lane));
    const bf16* QKV = (const bf16*)(C.ws() + WS_QKV); const long rowbase = (long)b * SEQ + n * 128;
    const char* Kb = (const char*)(QKV + qkv_base(2, h) + rowbase * 128); const char* Vb = (const char*)(QKV + qkv_base(3, h) + rowbase * 128);
#pragma unroll
    for (int i = 0; i < 4; ++i) { const int blk = 4 * wid + i, row = 4 * blk + (lane >> 4), ch = (lane & 15) ^ (row & 7);
        RO_DMA(Kb + row * 256 + ch * 16, RO_OFF_K + blk * 1024); }
#pragma unroll
    for (int i = 0; i < 4; ++i) { const int blk = 4 * wid + i, img = blk >> 4, st = 2 * (blk & 15) + (lane >> 5), kk = (st >> 2) * 8 + ((lane & 31) >> 2);
        const int k = (kk & ~0xC) | ((kk & 4) << 1) | ((kk & 8) >> 1), key = 64 * img + k, c = (st & 3) * 32 + (lane & 3) * 8;
        RO_DMA(Vb + key * 256 + c * 2, RO_OFF_V + blk * 1024); }
}
__device__ __forceinline__ void ro_phase(const Ctx& C) {
    const int TID_ = opq((int)threadIdx.x), LANE_ = TID_ & 63;
    const bf16* QKV = (const bf16*)(C.ws() + WS_QKV); bf16* MIX = (bf16*)(C.ws() + WS_MIX);
    char* lds = (char*)C.lds; LAS unsigned char* ldsl = (LAS unsigned char*)C.lds;
    const int wid = __builtin_amdgcn_readfirstlane(TID_ >> 6), ib = wid & 3, dh = wid >> 2;
    sec_mark(C, 8);
    const int G = C.G(); int it = C.vcu();
    if (it >= 512) return;
    ro_issue_s(C, ldsl, it >> 8, (it >> 5) & 7, it & 31, wid, LANE_); ro_issue_kv(C, ldsl, it >> 8, (it >> 5) & 7, it & 31, wid, LANE_);
    sec_mark(C, 9);
    bf16x8 qr[8];
    { const int lane0 = LANE_, iq0 = 32 * ib + (lane0 & 31); const bf16* Qw = QKV + qkv_base(5, (it >> 5) & 7) + ((long)(it >> 8) * SEQ + (it & 31) * 128 + iq0) * 128 + (lane0 >> 5) * 8;
#pragma unroll
      for (int d0 = 0; d0 < 8; ++d0) qr[d0] = *(const bf16x8*)(Qw + d0 * 16); }
    for (; it < 512; it += G) {
    int tid = TID_; asm volatile("" : "+v"(tid));
    const int lane = tid & 63, r32 = lane & 31, hi = lane >> 5, iq = 32 * ib + r32;
    const int b = it >> 8, h = (it >> 5) & 7, n = it & 31, itn = it + G; const bool has_next = itn < 512;
    const long rowbase = (long)b * SEQ + n * 128;
    sec_mark(C, 0);
    const float L2E = 1.4426950408889634f; const float lf2 = log_sigmoid_f(C.dec_f()[h]) * L2E, lb2 = log_sigmoid_f(C.dec_b()[h]) * L2E;
    float* ftab = (float*)(lds + RO_OFF_FT);
    if (tid < 256) { const int x = tid - 127; ftab[tid] = x == 0 ? 2.0f : __builtin_amdgcn_exp2f(x < 0 ? lf2 * (float)(-x) : lb2 * (float)x); }
    asm volatile("s_waitcnt vmcnt(0)" ::: "memory");
    __syncthreads();
    sec_mark(C, 1);
    unsigned gsp[16];
#pragma unroll
    for (int e = 0; e < 16; ++e) { const bf16* gp = QKV + qkv_base(6, h) + (rowbase + 32 * ib + crow(e, hi)) * 128 + 32 * (2 * dh) + r32; gsp[e] = (unsigned)gp[0] | ((unsigned)gp[32] << 16); }
    f32x16 o[2];
    {
        f32x16 tf[2] = {}, tb2[2] = {};
#pragma unroll
        for (int ks = 0; ks < 8; ++ks) {
#pragma unroll
            for (int d = 0; d < 2; ++d) { const int so = KSWZ(32 * (2 * dh + d) + r32, (16 * ks + 8 * hi) * 2);
                const bf16x8 sf = *(const bf16x8*)(lds + RO_OFF_SF + so), sb = *(const bf16x8*)(lds + RO_OFF_SB + so);
                tf[d] = __builtin_amdgcn_mfma_f32_32x32x16_bf16(qr[ks], sf, tf[d], 0, 0, 0);
                tb2[d] = __builtin_amdgcn_mfma_f32_32x32x16_bf16(qr[ks], sb, tb2[d], 0, 0, 0); }
            if (ks & 1) SBAR(); }
        asm volatile("s_waitcnt lgkmcnt(0)" ::: "memory");
        __syncthreads();
        sec_mark(C, 2);
        if (has_next) ro_issue_s(C, ldsl, itn >> 8, (itn >> 5) & 7, itn & 31, wid, lane);
#pragma unroll
        for (int e = 0; e < 16; ++e) { const int qi = 32 * ib + crow(e, hi);
            const float cf = __builtin_amdgcn_exp2f(lf2 * (float)(qi + 1)), cb_ = __builtin_amdgcn_exp2f(lb2 * (float)(128 - qi));
#pragma unroll
            for (int d = 0; d < 2; ++d) o[d][e] = cf * tf[d][e] + cb_ * tb2[d][e]; }
    }
#pragma unroll
    for (int tile = 0; tile < 2; ++tile) {
        f32x16 p0 = {}, p1 = {};
        const char* Ks = lds + RO_OFF_K;
#pragma unroll
        for (int d0 = 0; d0 < 8; ++d0) { const int cb = (d0 * 16 + hi * 8) * 2;
            const bf16x8 k0 = *(const bf16x8*)(Ks + KSWZ(64 * tile + r32, cb)), k1 = *(const bf16x8*)(Ks + KSWZ(64 * tile + 32 + r32, cb));
            p0 = __builtin_amdgcn_mfma_f32_32x32x16_bf16(k0, qr[d0], p0, 0, 0, 0);
            p1 = __builtin_amdgcn_mfma_f32_32x32x16_bf16(k1, qr[d0], p1, 0, 0, 0); }
        SBAR();
        { int tb = (64 * tile + 4 * hi - iq + 127) * 4; asm volatile("" : "+v"(tb));
          const char* tp = (const char*)ftab + tb;
#pragma unroll
          for (int e = 0; e < 16; ++e) { const int k0 = (e & 3) + 8 * (e >> 2); p0[e] *= *(const float*)(tp + 4 * k0); p1[e] *= *(const float*)(tp + 4 * (k0 + 32)); } }
        SBAR();
        bf16x8 pa0, pa1, pa2, pa3;
        NA_PK4(p0, 0, pa0); NA_PK4(p0, 8, pa1); NA_PK4(p1, 0, pa2); NA_PK4(p1, 8, pa3);
        const int vb = (int)(uintptr_t)(lds + RO_OFF_V + tile * 16384) + na::v_rd_base(lane);
        if (dh == 0) { na::pv_one<0>(o[0], vb, pa0, pa1, pa2, pa3); na::pv_one<1>(o[1], vb, pa0, pa1, pa2, pa3); }
        else         { na::pv_one<2>(o[0], vb, pa0, pa1, pa2, pa3); na::pv_one<3>(o[1], vb, pa0, pa1, pa2, pa3); }
    }
    if (has_next) { const bf16* Qw = QKV + qkv_base(5, (itn >> 5) & 7) + ((long)(itn >> 8) * SEQ + (itn & 31) * 128 + iq) * 128 + hi * 8;
#pragma unroll
      for (int d0 = 0; d0 < 8; ++d0) qr[d0] = *(const bf16x8*)(Qw + d0 * 16); }
    sec_mark(C, 3);
    float* stats = (float*)(lds + RO_OFF_ST);
    {
      float v32[32];
#pragma unroll
      for (int e = 0; e < 16; ++e) { v32[e] = o[0][e] + o[1][e]; v32[16 + e] = o[0][e] * o[0][e] + o[1][e] * o[1][e]; }
#pragma unroll
      for (int L = 16; L >= 1; L >>= 1) { const bool up = (r32 & L) != 0;
#pragma unroll
          for (int i = 0; i < L; ++i) { const float keep = up ? v32[L + i] : v32[i], send = up ? v32[i] : v32[L + i]; v32[i] = keep + __shfl_xor(send, L); } }
      stats[((ib * 2 + dh) * 32 + crow(r32 & 15, hi)) * 2 + (r32 >> 4)] = v32[0]; }
    asm volatile("s_waitcnt lgkmcnt(0)" ::: "memory");
    __syncthreads();
    sec_mark(C, 4);
    if (has_next) ro_issue_kv(C, ldsl, itn >> 8, (itn >> 5) & 7, itn & 31, wid, lane);
    const float* gnw = C.gn_w() + h * 128 + 32 * (2 * dh) + r32; const float gw0 = gnw[0], gw1 = gnw[32];
#pragma unroll
    for (int e = 0; e < 16; ++e) { const int q = crow(e, hi); const float* sa = stats + ((ib * 2 + 0) * 32 + q) * 2; const float* sb = stats + ((ib * 2 + 1) * 32 + q) * 2;
        const float mean = (sa[0] + sb[0]) * (1.0f / 128.0f), var = (sa[1] + sb[1]) * (1.0f / 128.0f) - mean * mean, rstd = __builtin_amdgcn_rsqf(fmaxf(var, 0.f) + EPS);
        const long row = rowbase + 32 * ib + q;
#pragma unroll
        for (int d = 0; d < 2; ++d) { const int dv = 32 * (2 * dh + d) + r32;
            const float y = (o[d][e] - mean) * rstd * (d ? gw1 : gw0) * __builtin_bit_cast(float, d ? (gsp[e] & 0xffff0000u) : (gsp[e] << 16));
            MIX[row * DM + 1024 + h * 128 + dv] = (bf16)(cvtpk(y, 0.f) & 0xffffu); } }
    __syncthreads();
    sec_mark(C, 5);
    }
}
#undef RO_DMA
}

__device__ __forceinline__ void p7_rows(const Ctx& C) {
    const int TID_ = opq((int)threadIdx.x), LANE_ = TID_ & 63;
    float* wrT = (float*)C.lds;
    { f32x4 wv[16];
#pragma unroll
      for (int i = 0; i < 16; ++i) wv[i] = ((const f32x4*)C.w_router())[TID_ + 512 * i];
#pragma unroll
      for (int i = 0; i < 16; ++i) { const int q = TID_ + 512 * i, col = q >> 2, e0 = (q & 3) * 4;
          wrT[(e0 + 0) * DM + col] = wv[i].x; wrT[(e0 + 1) * DM + col] = wv[i].y; wrT[(e0 + 2) * DM + col] = wv[i].z; wrT[(e0 + 3) * DM + col] = wv[i].w; } }
    __syncthreads();
    const float* mod = (const float*)(C.ws() + WS_MOD); bf16* U2 = (bf16*)(C.ws() + WS_U); float* AFF = (float*)(C.ws() + WS_AFF);
    const bf16* HL = (const bf16*)(C.ws() + WS_HLAT);
    for (int m = 2 * C.gw(); m < MLAT; m += 2 * C.NGW()) {
        const int b = m >> 12, n = m & 4095;
        f32x4 va[8], vb[8]; float sa = 0.f, sb = 0.f;
        { v2u ha[8], hb[8];
#pragma unroll
          for (int j = 0; j < 8; ++j) { ha[j] = ((const v2u*)(HL + (size_t)m * DM))[LANE_ + 64 * j]; hb[j] = ((const v2u*)(HL + (size_t)(m + 1) * DM))[LANE_ + 64 * j]; }
#pragma unroll
          for (int j = 0; j < 8; ++j) { va[j] = (f32x4){__builtin_bit_cast(float, ha[j].x << 16), __builtin_bit_cast(float, ha[j].x & 0xffff0000u), __builtin_bit_cast(float, ha[j].y << 16), __builtin_bit_cast(float, ha[j].y & 0xffff0000u)};
                                        vb[j] = (f32x4){__builtin_bit_cast(float, hb[j].x << 16), __builtin_bit_cast(float, hb[j].x & 0xffff0000u), __builtin_bit_cast(float, hb[j].y << 16), __builtin_bit_cast(float, hb[j].y & 0xffff0000u)}; } }
#pragma unroll
        for (int j = 0; j < 8; ++j) { sa += (va[j].x * va[j].x + va[j].y * va[j].y) + (va[j].z * va[j].z + va[j].w * va[j].w); sb += (vb[j].x * vb[j].x + vb[j].y * vb[j].y) + (vb[j].z * vb[j].z + vb[j].w * vb[j].w); }
        const float ra = 1.0f / sqrtf(wave_sum(sa) * (1.0f / DM) + EPS), rb = 1.0f / sqrtf(wave_sum(sb) * (1.0f / DM) + EPS);
#pragma unroll
        for (int hq = 0; hq < 2; ++hq) {
            f32x4 nw[4], sh[4], sc[4];
#pragma unroll
            for (int jj = 0; jj < 4; ++jj) { const int col = (LANE_ + 64 * (4 * hq + jj)) * 4; nw[jj] = *(const f32x4*)(C.nffn() + col); sh[jj] = *(const f32x4*)(mod + b * NMOD + 3 * DM + col); sc[jj] = *(const f32x4*)(mod + b * NMOD + 4 * DM + col); }
#pragma unroll
            for (int jj = 0; jj < 4; ++jj) { const int j = 4 * hq + jj, col = (LANE_ + 64 * j) * 4;
                va[j] = (va[j] * ra * nw[jj]) * (sc[jj] + 1.0f) + sh[jj]; vb[j] = (vb[j] * rb * nw[jj]) * (sc[jj] + 1.0f) + sh[jj];
                v2u oa, ob; oa.x = cvtpk(va[j].x, va[j].y); oa.y = cvtpk(va[j].z, va[j].w); ob.x = cvtpk(vb[j].x, vb[j].y); ob.y = cvtpk(vb[j].z, vb[j].w);
                *(v2u*)(U2 + (size_t)m * DM + col) = oa; *(v2u*)(U2 + (size_t)(m + 1) * DM + col) = ob; }
            SBAR(); }
        float la[NEXP], lb[NEXP];
        int wo0 = LANE_ * 16, wo1 = LANE_ * 16 + 65536;
        asm volatile("" : "+v"(wo0), "+v"(wo1));
#pragma unroll
        for (int e = 0; e < NEXP; ++e) { f32x4 w[8];
#pragma unroll
            for (int j = 0; j < 8; ++j) w[j] = *(const f32x4*)((const char*)wrT + (e < 8 ? wo0 : wo1) + (e & 7) * 8192 + j * 1024);
            f32x2 a2 = {0.f, 0.f}, c2 = {0.f, 0.f};
#pragma unroll
            for (int j = 0; j < 8; ++j) { const f32x2 wl = {w[j].x, w[j].y}, wh = {w[j].z, w[j].w};
                a2 += (f32x2){va[j].x, va[j].y} * wl; a2 += (f32x2){va[j].z, va[j].w} * wh; c2 += (f32x2){vb[j].x, vb[j].y} * wl; c2 += (f32x2){vb[j].z, vb[j].w} * wh; }
            la[e] = a2.x + a2.y; lb[e] = c2.x + c2.y; if (e & 1) SBAR(); }
#pragma unroll
        for (int L = 8; L >= 1; L >>= 1) { const int B = L * 4; const bool up = (LANE_ & B) != 0;
#pragma unroll
            for (int i = 0; i < L; ++i) { const float ka = up ? la[L + i] : la[i], sa_ = up ? la[i] : la[L + i]; la[i] = ka + __shfl_xor(sa_, B);
                                          const float kb = up ? lb[L + i] : lb[i], sb_ = up ? lb[i] : lb[L + i]; lb[i] = kb + __shfl_xor(sb_, B); } }
        float ta = la[0], tb = lb[0]; ta += __shfl_xor(ta, 1); tb += __shfl_xor(tb, 1); ta += __shfl_xor(ta, 2); tb += __shfl_xor(tb, 2);
        float mxa = ta, mxb = tb;
#pragma unroll
        for (int B = 4; B < 64; B <<= 1) { mxa = fmaxf(mxa, __shfl_xor(mxa, B)); mxb = fmaxf(mxb, __shfl_xor(mxb, B)); }
        const float exa = expf(ta - mxa), exb = expf(tb - mxb); float sma = exa, smb = exb;
#pragma unroll
        for (int B = 4; B < 64; B <<= 1) { sma += __shfl_xor(sma, B); smb += __shfl_xor(smb, B); }
        if ((LANE_ & 3) == 0) { float* ap = AFF + (size_t)(b * NEXP + (LANE_ >> 2)) * SEQ + n; *(f32x2*)ap = (f32x2){exa / sma, exb / smb}; }
    }
    __syncthreads();
}

__device__ __forceinline__ void p8_topk(const Ctx& C, int b, int e) {
    const int TID_ = opq((int)threadIdx.x), LANE_ = TID_ & 63;
    unsigned* hist = (unsigned*)C.lds;
    unsigned* scal = hist + 256; unsigned* wtot = hist + 288;
    const float* aff = (const float*)(C.ws() + WS_AFF) + (size_t)(b * NEXP + e) * SEQ;
    int* SLOT = (int*)(C.ws() + WS_SLOT) + (size_t)(b * NEXP + e) * SEQ; int* IDX = (int*)(C.ws() + WS_IDX) + (e * 2 + b) * CAP; float* GATE = (float*)(C.ws() + WS_GATE) + (e * 2 + b) * CAP;
    const int tid = TID_, base = tid * 8;
    unsigned key[8]; { const v4u a = *(const v4u*)(aff + base), c2 = *(const v4u*)(aff + base + 4); key[0] = a.x; key[1] = a.y; key[2] = a.z; key[3] = a.w; key[4] = c2.x; key[5] = c2.y; key[6] = c2.z; key[7] = c2.w; }
    unsigned prefix = 0u, remaining = CAP;
#pragma unroll
    for (int pass = 0; pass < 4; ++pass) {
        const int shift = 24 - 8 * pass;
        if (tid < 256) hist[tid] = 0u;
        __syncthreads();
#pragma unroll
        for (int i = 0; i < 8; ++i) { const bool match = (pass == 0) || ((key[i] >> (shift + 8)) == (prefix >> (shift + 8))); if (match) atomicAdd(&hist[(key[i] >> shift) & 255u], 1u); }
        __syncthreads();
        {
          unsigned hcnt = 0u, suf = 0u;
          if (tid < 256) { hcnt = hist[tid]; suf = hcnt;
#pragma unroll
              for (int o = 1; o < 64; o <<= 1) { const unsigned t2 = __shfl_down(suf, o); if (LANE_ + o < 64) suf += t2; }
              if (LANE_ == 0) wtot[8 + C.wave] = suf; }
          __syncthreads();
          if (tid < 256) { for (int w = C.wave + 1; w < 4; ++w) suf += wtot[8 + w];
              if (suf >= remaining && suf - hcnt < remaining) { scal[0] = prefix | ((unsigned)tid << shift); scal[1] = remaining - (suf - hcnt); } }
        }
        __syncthreads();
        prefix = scal[0]; remaining = scal[1];
        __syncthreads();
    }
    unsigned cg = 0u, ce = 0u;
#pragma unroll
    for (int i = 0; i < 8; ++i) { cg += key[i] > prefix ? 1u : 0u; ce += key[i] == prefix ? 1u : 0u; }
    unsigned pk = cg | (ce << 16), inc = pk;
#pragma unroll
    for (int o = 1; o < 64; o <<= 1) { const unsigned t = __shfl_up(inc, o); if (LANE_ >= o) inc += t; }
    if (LANE_ == 63) wtot[C.wave] = inc;
    __syncthreads();
    unsigned woff = 0u;
    for (int w = 0; w < C.wave; ++w) woff += wtot[w];
    const unsigned excl = woff + inc - pk; unsigned rg_ = excl & 0xffffu, re_ = excl >> 16;
    const unsigned ngt = CAP - remaining;
#pragma unroll
    for (int i = 0; i < 8; ++i) { int slot = -1;
        if (key[i] > prefix) { slot = (int)rg_; ++rg_; }
        else if (key[i] == prefix) { if (re_ < remaining) slot = (int)(ngt + re_); ++re_; }
        SLOT[base + i] = slot;
        if (slot >= 0) { IDX[slot] = base + i; GATE[slot] = __builtin_bit_cast(float, key[i]); } }
    __syncthreads();
}

__device__ __forceinline__ void p9_gather(const Ctx& C) {
    const int TID_ = opq((int)threadIdx.x), LANE_ = TID_ & 63;
    const bf16* U2 = (const bf16*)(C.ws() + WS_U); bf16* XE = (bf16*)(C.ws() + WS_XE); const int* IDX = (const int*)(C.ws() + WS_IDX);
    for (int R = C.gw(); R < NEXP * NB * CAP; R += C.NGW()) {
        const int b = (R >> 9) & 1; const int tok = IDX[R];
        const v4u* src = (const v4u*)(U2 + (size_t)(b * SEQ + tok) * DM) + LANE_; v4u* dst = (v4u*)(XE + (size_t)R * DM) + LANE_;
        const v4u a0 = src[0], a1 = src[64], a2 = src[128], a3 = src[192];
        dst[0] = a0; dst[64] = a1; dst[128] = a2; dst[192] = a3;
    }
}

__device__ __forceinline__ void p12_final(const Ctx& C) {
    const int TID_ = opq((int)threadIdx.x), LANE_ = TID_ & 63;
    const float* mod = (const float*)(C.ws() + WS_MOD); const bf16* YE = (const bf16*)(C.ws() + WS_YE); const int* SLOT = (const int*)(C.ws() + WS_SLOT);
    const bf16* HL = (const bf16*)(C.ws() + WS_HLAT);
    v2u hv[8]; int sl;
    { const int mq = C.gw() < MLAT ? C.gw() : 0;
      sl = (LANE_ < NEXP) ? SLOT[(size_t)((mq >> 12) * NEXP + LANE_) * SEQ + (mq & 4095)] : -1;
#pragma unroll
      for (int j = 0; j < 8; ++j) hv[j] = __builtin_nontemporal_load((const v2u*)(HL + (size_t)mq * DM) + LANE_ + 64 * j); }
    for (int m = C.gw(); m < MLAT; m += C.NGW()) {
        const int b = m >> 12; float* row = C.out() + (size_t)m * DM; const int mn = m + C.NGW();
        v2u hvn[8]; int sln;
        { const int mq = mn < MLAT ? mn : m;
          sln = (LANE_ < NEXP) ? SLOT[(size_t)((mq >> 12) * NEXP + LANE_) * SEQ + (mq & 4095)] : -1;
#pragma unroll
          for (int j = 0; j < 8; ++j) hvn[j] = __builtin_nontemporal_load((const v2u*)(HL + (size_t)mq * DM) + LANE_ + 64 * j); }
        f32x4 acc[8];
#pragma unroll
        for (int j = 0; j < 8; ++j) acc[j] = (f32x4){0.f, 0.f, 0.f, 0.f};
        unsigned mk = (unsigned)__ballot(sl >= 0);
        while (mk) {
            const int e0 = __builtin_ctz(mk); mk &= mk - 1; const bool two = mk != 0u; const int e1 = two ? __builtin_ctz(mk) : e0; if (two) mk &= mk - 1;
            const int s0 = __builtin_amdgcn_readlane(sl, e0), s1 = __builtin_amdgcn_readlane(sl, e1);
            const v2u* y0 = (const v2u*)(YE + (size_t)((e0 * 2 + b) * CAP + s0) * DM) + LANE_; const v2u* y1 = (const v2u*)(YE + (size_t)((e1 * 2 + b) * CAP + s1) * DM) + LANE_;
            v2u a0[8], a1[8];
#pragma unroll
            for (int j = 0; j < 8; ++j) { a0[j] = __builtin_nontemporal_load(y0 + 64 * j); a1[j] = __builtin_nontemporal_load(y1 + 64 * j); }
            const float w1 = two ? 1.0f : 0.0f;
#pragma unroll
            for (int j = 0; j < 8; ++j) {
                acc[j].x += __builtin_bit_cast(float, a0[j].x << 16); acc[j].y += __builtin_bit_cast(float, a0[j].x & 0xffff0000u); acc[j].z += __builtin_bit_cast(float, a0[j].y << 16); acc[j].w += __builtin_bit_cast(float, a0[j].y & 0xffff0000u);
                acc[j].x += w1 * __builtin_bit_cast(float, a1[j].x << 16); acc[j].y += w1 * __builtin_bit_cast(float, a1[j].x & 0xffff0000u); acc[j].z += w1 * __builtin_bit_cast(float, a1[j].y << 16); acc[j].w += w1 * __builtin_bit_cast(float, a1[j].y & 0xffff0000u); }
        }
        f32x4 v[8]; float s2 = 0.f;
#pragma unroll
        for (int j = 0; j < 8; ++j) { const int col = (LANE_ + 64 * j) * 4; const f32x4 g5 = *(const f32x4*)(mod + b * NMOD + 5 * DM + col);
            const f32x4 hf = {__builtin_bit_cast(float, hv[j].x << 16), __builtin_bit_cast(float, hv[j].x & 0xffff0000u), __builtin_bit_cast(float, hv[j].y << 16), __builtin_bit_cast(float, hv[j].y & 0xffff0000u)};
            v[j] = hf + g5 * acc[j]; s2 += (v[j].x * v[j].x + v[j].y * v[j].y) + (v[j].z * v[j].z + v[j].w * v[j].w); }
        const float rstd = 1.0f / sqrtf(wave_sum(s2) * (1.0f / DM) + EPS);
        f32x4 fwv[8];
#pragma unroll
        for (int j = 0; j < 8; ++j) fwv[j] = *(const f32x4*)(C.fin_w() + (LANE_ + 64 * j) * 4);
#pragma unroll
        for (int j = 0; j < 8; ++j) __builtin_nontemporal_store(v[j] * rstd * fwv[j], (f32x4*)row + LANE_ + 64 * j);
#pragma unroll
        for (int j = 0; j < 8; ++j) hv[j] = hvn[j];
        sl = sln;
    }
}

__global__ void __launch_bounds__(NWAVES * 64, 2) fwd_megakernel(Args args) {
    extern __shared__ __attribute__((aligned(16))) unsigned char lds[];
    Ctx C;
    C.a = &args; C.lds = lds;
    C.wave = __builtin_amdgcn_readfirstlane((int)threadIdx.x >> 6);
    volatile LAS unsigned* MISC = (volatile LAS unsigned*)((LAS unsigned char*)lds + MISC_OFF);
    for (int u = threadIdx.x; u < (LDS_BYTES - LDSCTL_OFF) / 4; u += NWAVES * 64) ((LAS unsigned*)((LAS unsigned char*)lds + LDSCTL_OFF))[u] = 0u;
    __syncthreads();
    unsigned* ctl = (unsigned*)(args.ws + WS_CTL);
    XcdBarrier bar; bar.bar = ctl + CW_BAR; bar.x = 0; bar.st = nullptr;
    if (N_LAUNCHES == 1) bar = xcd_barrier_post(ctl + CW_BAR, MISC + 8);
#ifndef PROBE_BARX
#define PROBE_BARX 1
#endif
    int barno_ = 0;
#ifdef PROBE_BARK
#define BARK_MARK() do { if (barno_ == PROBE_BARK && threadIdx.x == 0) { const unsigned t_ = (unsigned)__builtin_amdgcn_s_memrealtime(); const int bx = (int)blockIdx.x; atomicMax(ctl + 8000, t_); if (PROBE_CLS) atomicMax(ctl + 8064, t_); } } while (0)
#else
#define BARK_MARK() do { } while (0)
#endif
#define GRID_BAR() do { if (N_LAUNCHES == 1) { BARK_MARK(); sec_mark(C, 100 + 2 * barno_); for (int bb_ = 0; bb_ < PROBE_BARX; ++bb_) xcd_barrier(bar); sec_mark(C, 101 + 2 * barno_); ++barno_; } } while (0)
#ifndef PHASE_MASK
#define PHASE_MASK 0x1fff
#endif
#define IN(k) ((((PHASE_MASK) >> (k)) & 1) && args.ph_lo <= (k) && (k) < args.ph_hi)
#define BOTH(k) (IN(k) && IN((k) + 1))
#ifndef PROBE_MASK
#define PROBE_MASK 0
#endif
#define REPS(k) ((((PROBE_MASK) >> (k)) & 1) ? 2 : 1)
    PG8_LAS unsigned char* ring = (PG8_LAS unsigned char*)lds;
#ifdef PROBE_STAMP
    unsigned long long t_start_ = __builtin_amdgcn_s_memrealtime(), t_mark_ = t_start_;
#define STAMP(k) do { if ((k) == PROBE_STAMP) t_mark_ = __builtin_amdgcn_s_memrealtime(); } while (0)
#else
#define STAMP(k) do { } while (0)
#endif

    if (IN(0)) for (int rep_ = 0; rep_ < REPS(0); ++rep_) { p0_prologue(C); if (BOTH(0) || rep_ + 1 < REPS(0)) GRID_BAR(); }
    STAMP(0);
    if (IN(1)) for (int rep_ = 0; rep_ < REPS(1); ++rep_) { p1_rows(C); if (BOTH(1) || rep_ + 1 < REPS(1)) GRID_BAR(); }
    STAMP(1);
    if (IN(2)) for (int rep_ = 0; rep_ < REPS(2); ++rep_) {
        pg8::Gemm g{(const pg8::bf16_t*)(args.ws + WS_U), (const pg8::bf16_t*)(args.ws + WS_WIN), MALL, NIN, DM, 0, 0, nullptr};
        pg8::QkvOrder S; S.init(C.G(), (int)blockIdx.x);
        pg8::EpiQKV E{(pg8::bf16_t*)(args.ws + WS_QKV), (const float*)(args.ws + WS_ROPE), (const float*)(args.ws + WS_ROPE) + 2048};
        pg8::gemm_phase<pg8::EpiQKV, pg8::QkvOrder, true, true>(ring, g, S, E);
#ifdef PROBE_GEND
        if (threadIdx.x == 0) { const unsigned t_ = (unsigned)__builtin_amdgcn_s_memrealtime(); const int bx = (int)blockIdx.x; atomicMax(ctl + 8000, t_); if (PROBE_CLS) atomicMax(ctl + 8064, t_); }
#endif
        conv_deferred(C, 928);
        if (BOTH(2) || rep_ + 1 < REPS(2)) GRID_BAR();
    }
    STAMP(2);
    if (IN(3)) for (int rep_ = 0; rep_ < REPS(3); ++rep_) {
        sec_mark(C, 20);
#ifndef NO_NA
        if (conv_split(C)) {
            const int bx = (int)blockIdx.x, G = C.G(), q = (bx & 7) * (G >> 4) + (bx >> 4);
#ifndef PROBE_NA2
#define PROBE_NA2 1
#endif
            if (((bx >> 3) & 1) == 0) { for (int nr_ = 0; nr_ < PROBE_NA2; ++nr_) for (int u = 2 * q; u < 256; u += G) { na::na_unit((const bf16*)(args.ws + WS_QKV), (bf16*)(args.ws + WS_MIX), C.rpb(), u >> 7, (u >> 4) & 7, u & 15, (char*)lds);
                                                                                na::na_unit((const bf16*)(args.ws + WS_QKV), (bf16*)(args.ws + WS_MIX), C.rpb(), (u + 1) >> 7, ((u + 1) >> 4) & 7, (u + 1) & 15, (char*)lds); } }
            else { conv_p3(C, q, G >> 1); __syncthreads(); }
        } else
        for (int u = C.vcu(); u < 256; u += C.G()) { const int bh = u >> 4; na::na_unit((const bf16*)(args.ws + WS_QKV), (bf16*)(args.ws + WS_MIX), C.rpb(), bh >> 3, bh & 7, u & 15, (char*)lds); }
#endif
        sec_mark(C, 21);
#ifndef NO_KV
        { v4u kx[4], vx[4]; const int G = C.G(), bx = (int)blockIdx.x;
          const bool bal = conv_split(C) && G == 256;
          const int extra = (bal && ((bx >> 3) & 1) == 1 && (bx >> 4) < 4) ? 512 + (bx & 7) * 4 + (bx >> 4) : 544;
          int it = C.vcu();
          if (it < 544) { const int bh = it / 34; ret::kv_load(C, bh >> 3, bh & 7, it % 34, opq((int)threadIdx.x), kx, vx); }
          while (it < 544) { const int in = !bal ? it + G : (it + G < 512 ? it + G : (it < 512 ? extra : 544));
              const int bh = it / 34, nbh = in / 34; ret::kv_item(C, bh >> 3, bh & 7, it % 34, kx, vx, in < 544, nbh >> 3, nbh & 7, in % 34); it = in; } }
#endif
        if (BOTH(3) || rep_ + 1 < REPS(3)) GRID_BAR();
    }
    STAMP(3);
    if (IN(4)) for (int rep_ = 0; rep_ < REPS(4); ++rep_) { ret::scan_phase(C); if (BOTH(4) || rep_ + 1 < REPS(4)) GRID_BAR(); }
    STAMP(4);
    if (IN(5)) for (int rep_ = 0; rep_ < REPS(5); ++rep_) {
        sec_mark(C, 6); ret::ro_phase(C); sec_mark(C, 7);
        if (BOTH(5) || rep_ + 1 < REPS(5)) GRID_BAR();
    }
    STAMP(5);
    if (IN(6)) for (int rep_ = 0; rep_ < REPS(6); ++rep_) {
        pg8::Gemm g{(const pg8::bf16_t*)(args.ws + WS_MIX), (const pg8::bf16_t*)(args.ws + WS_WOUT), MLAT, DM, DM, 0, 0, nullptr};
        pg8::StaticOrder S; S.init(MLAT, DM, C.G(), (int)blockIdx.x);
        pg8::EpiOut E{C.x(), (pg8::bf16_t*)(args.ws + WS_HLAT), (const float*)(args.ws + WS_MOD)};
        pg8::gemm_phase<pg8::EpiOut, pg8::StaticOrder, true, true>(ring, g, S, E);
        if (BOTH(6) || rep_ + 1 < REPS(6)) GRID_BAR();
    }
    STAMP(6);
    if (IN(7)) for (int rep_ = 0; rep_ < REPS(7); ++rep_) { p7_rows(C); if (BOTH(7) || rep_ + 1 < REPS(7)) GRID_BAR(); }
    STAMP(7);
    if (IN(8)) for (int rep_ = 0; rep_ < REPS(8); ++rep_) { sec_mark(C, 30); for (int it = blockIdx.x; it < NB * NEXP; it += C.G()) p8_topk(C, it >> 4, it & 15); conv_p8(C); sec_mark(C, 31); if (BOTH(8) || rep_ + 1 < REPS(8)) GRID_BAR(); }
    STAMP(8);
    if (IN(9)) for (int rep_ = 0; rep_ < REPS(9); ++rep_) {   }
    STAMP(9);
    if (IN(10)) for (int rep_ = 0; rep_ < REPS(10); ++rep_) {
        pg8::Gemm g{(const pg8::bf16_t*)(args.ws + WS_U), (const pg8::bf16_t*)(args.ws + WS_WGU), NEXP * NB * CAP, 2 * FF, DM, 2, (size_t)2048 * 2048 * 2, (const int*)(args.ws + WS_IDX)};
        pg8::StaticOrder S; S.init(NEXP * NB * CAP, 2 * FF, C.G(), (int)blockIdx.x);
        pg8::EpiGU E{(pg8::bf16_t*)(args.ws + WS_HID)};
        pg8::gemm_phase<pg8::EpiGU, pg8::StaticOrder, true, true, true>(ring, g, S, E);
        if (BOTH(10) || rep_ + 1 < REPS(10)) GRID_BAR();
    }
    STAMP(10);
    if (IN(11)) for (int rep_ = 0; rep_ < REPS(11); ++rep_) {
        pg8::Gemm g{(const pg8::bf16_t*)(args.ws + WS_HID), (const pg8::bf16_t*)(args.ws + WS_WDN), NEXP * NB * CAP, DM, FF, 2, (size_t)2048 * 1024 * 2, nullptr};
        pg8::StaticOrder S; S.init(NEXP * NB * CAP, DM, C.G(), (int)blockIdx.x);
        pg8::EpiDown E{(pg8::bf16_t*)(args.ws + WS_YE), (const float*)(args.ws + WS_GATE)};
        pg8::gemm_phase<pg8::EpiDown, pg8::StaticOrder, true, true>(ring, g, S, E);
        if (BOTH(11) || rep_ + 1 < REPS(11)) GRID_BAR();
    }
    STAMP(11);
    if (IN(12)) for (int rep_ = 0; rep_ < REPS(12); ++rep_) { p12_final(C); }
#ifdef PROBE_STAMP
    if (blockIdx.x == 0 && threadIdx.x == 0) { const unsigned long long t_end_ = __builtin_amdgcn_s_memrealtime(), wait_ = t_mark_ - t_start_;
        while (__builtin_amdgcn_s_memrealtime() - t_end_ < wait_) __builtin_amdgcn_s_sleep(8); }
#endif
#if defined(PROBE_BARK) || defined(PROBE_GEND)
    if (blockIdx.x == 0 && threadIdx.x == 0) { const unsigned all_ = __hip_atomic_load(ctl + 8000, __ATOMIC_RELAXED, __HIP_MEMORY_SCOPE_AGENT), cls_ = __hip_atomic_load(ctl + 8064, __ATOMIC_RELAXED, __HIP_MEMORY_SCOPE_AGENT);
        const unsigned long long t_end_ = __builtin_amdgcn_s_memrealtime(), wait_ = (unsigned long long)(all_ - cls_) * 8ull;
        while (__builtin_amdgcn_s_memrealtime() - t_end_ < wait_) __builtin_amdgcn_s_sleep(8); }
#endif
#ifdef PROBE_SEC
#ifndef PROBE_SECX
#define PROBE_SECX 4
#endif
#ifndef PROBE_SECBLK
#define PROBE_SECBLK 0
#endif
    if (blockIdx.x == PROBE_SECBLK && threadIdx.x == 0) { const unsigned long long t_end_ = __builtin_amdgcn_s_memrealtime(), wait_ = (unsigned long long)MISC[33] * PROBE_SECX;
        while (__builtin_amdgcn_s_memrealtime() - t_end_ < wait_) __builtin_amdgcn_s_sleep(8); }
#endif
#undef IN
#undef BOTH
#undef GRID_BAR
}

extern "C" void kernel_launch(void* const* d_in, const int* in_sizes, int n_in, void* d_out, int out_size, void* d_ws, size_t ws_size, hipStream_t stream) {
    static int grid = 0;
    if (grid == 0) {
        if (n_in != 19 || in_sizes[0] != MLAT * DM || out_size != MLAT * DM || ws_size < WS_END) { fprintf(stderr, "kernel_launch: built for 19 inputs, x/out of %d floats, >= %zu bytes of workspace; got n_in %d in0 %d out %d ws %zu; nothing launched\n", MLAT * DM, (size_t)WS_END, n_in, n_in > 0 ? in_sizes[0] : -1, out_size, ws_size); grid = -1; return; }
        int dev = 0, cus = 0, per_cu = 0;
        if (hipGetDevice(&dev) != hipSuccess || hipDeviceGetAttribute(&cus, hipDeviceAttributeMultiprocessorCount, dev) != hipSuccess) { fprintf(stderr, "kernel_launch: hipGetDevice / hipDeviceGetAttribute failed\n"); grid = -1; return; }
        if (hipFuncSetAttribute((const void*)fwd_megakernel, hipFuncAttributeMaxDynamicSharedMemorySize, LDS_BYTES) != hipSuccess) { fprintf(stderr, "kernel_launch: hipFuncSetAttribute(%d B LDS) failed\n", LDS_BYTES); grid = -1; return; }
        if (hipOccupancyMaxActiveBlocksPerMultiprocessor(&per_cu, (const void*)fwd_megakernel, NWAVES * 64, LDS_BYTES) != hipSuccess || per_cu < 1) { fprintf(stderr, "kernel_launch: occupancy query reports %d workgroups per CU\n", per_cu); per_cu = 1; }
        (void)hipGetLastError();
        grid = cus;
    }
    if (grid < 0) return;
    if (hipMemsetAsync((char*)d_ws + WS_CTL, 0, CTL_ZERO_BYTES, stream) != hipSuccess) { fprintf(stderr, "kernel_launch: hipMemsetAsync failed\n"); return; }
    Args a{};
    for (int i = 0; i < 19; ++i) a.in[i] = (const float*)d_in[i];
    a.out = (float*)d_out; a.ws = (unsigned char*)d_ws;
    if (N_LAUNCHES == 1) {
        a.ph_lo = 0; a.ph_hi = PER_PHASE; a.li = 0;
        void* kargs[] = {&a};
        hipError_t e = hipLaunchCooperativeKernel((const void*)fwd_megakernel, dim3(grid), dim3(NWAVES * 64), kargs, LDS_BYTES, stream);
        if (e != hipSuccess) { fprintf(stderr, "kernel_launch: cooperative launch failed: %s (grid %d)\n", hipGetErrorString(e), grid); (void)hipGetLastError(); }
    } else {
        for (int li = 0; li < PER_PHASE; ++li) { a.ph_lo = li; a.ph_hi = li + 1; a.li = li;
            hipLaunchKernelGGL(fwd_megakernel, dim3(grid), dim3(NWAVES * 64), LDS_BYTES, stream, a);
            const hipError_t le = hipPeekAtLastError(); if (le != hipSuccess) { fprintf(stderr, "kernel_launch: launch %d failed: %s\n", li, hipGetErrorName(le)); break; } }
    }
}
```
